# Optimizing an MI355X kernel written in HIP

```python
import jax
import jax.numpy as jnp
from jax import lax
import numpy as np

D_MODEL = 1024
BATCH = 8
SEQ = 2048
DEPTH = 1

RET_HEADS = 4
RET_DK = 128
RET_DV = 128
RET_CHUNK = 128
ROPE_BASE = 10000.0
MOBA_HEADS = 8
MOBA_DH = 64
MOBA_BLOCK = 256
MOBA_TOPK = 3
MOBA_QCHUNK = 32
RET_QK_WIDTH = RET_HEADS * RET_DK
RET_V_WIDTH = RET_HEADS * RET_DV
MOBA_WIDTH = MOBA_HEADS * MOBA_DH
MIX_WIDTH = RET_V_WIDTH + MOBA_WIDTH
IN_SPLIT_SIZES = (RET_QK_WIDTH, RET_QK_WIDTH, RET_V_WIDTH, RET_V_WIDTH, MOBA_WIDTH, MOBA_WIDTH, MOBA_WIDTH)
IN_COLS = sum(IN_SPLIT_SIZES)
N_EXPERTS = 256
TOP_K = 8
N_GROUPS = 8
TOPK_GROUPS = 4
EXPERT_FF = 256
SHARED_FF = 256
ROUTED_SCALE = 2.5
MOE_BLOCK = 128
N_MOD = 6
EPS = 1e-6

kernel_name = 'hymba_retnet_moba_moe_adaln'


def rms_norm(x, g=None):
    xf = x.astype(jnp.float32)
    y = xf * lax.rsqrt(jnp.mean(xf * xf, axis=-1, keepdims=True) + EPS)
    if g is not None:
        y = y * g.astype(jnp.float32)
    return y.astype(x.dtype)


def rotary(x, pos):
    half = x.shape[-1] // 2
    inv = ROPE_BASE ** (-jnp.arange(half, dtype=jnp.float32) / half)
    ang = pos[:, None] * inv[None, :]
    cos = jnp.cos(ang)[None, :, None, :].astype(x.dtype)
    sin = jnp.sin(ang)[None, :, None, :].astype(x.dtype)
    x1, x2 = x[..., :half], x[..., half:]
    return jnp.concatenate([x1 * cos - x2 * sin, x1 * sin + x2 * cos], axis=-1)


def swiglu(x, wg, wu, wd):
    return (jax.nn.silu(x @ wg) * (x @ wu)) @ wd


def retention(q, k, v, g):
    B_, S_, H, dk = q.shape
    dv = v.shape[-1]
    C = RET_CHUNK
    N = S_ // C
    dt = q.dtype
    pos = jnp.arange(S_, dtype=jnp.float32)
    q = rotary(q, pos)
    k = rotary(k, pos) * (dk ** -0.5)
    log_g = jnp.log1p(-jnp.exp2(-5.0 - jnp.arange(H, dtype=jnp.float32)))
    idx = jnp.arange(C, dtype=jnp.float32)
    diff = idx[:, None] - idx[None, :]
    decay_in = jnp.where(diff >= 0, jnp.exp(log_g[:, None, None] * jnp.maximum(diff, 0.0)), 0.0)
    q_decay = jnp.exp(log_g[:, None] * (idx + 1.0))
    k_decay = jnp.exp(log_g[:, None] * (C - 1.0 - idx))
    chunk_decay = jnp.exp(log_g * C)
    qc = q.reshape(B_, N, C, H, dk).transpose(0, 3, 1, 2, 4)
    kc = k.reshape(B_, N, C, H, dk).transpose(0, 3, 1, 2, 4)
    vc = v.reshape(B_, N, C, H, dv).transpose(0, 3, 1, 2, 4)
    scores = jnp.einsum('bhncd,bhnmd->bhncm', qc, kc) * decay_in[None, :, None].astype(dt)
    inner = jnp.einsum('bhncm,bhnme->bhnce', scores, vc)
    kv = jnp.einsum('bhnmd,bhnme->nbhde', kc * k_decay[None, :, None, :, None].astype(dt), vc)
    cd = chunk_decay[None, :, None, None].astype(dt)

    def step(state, kv_n):
        return state * cd + kv_n, state

    _, prev = lax.scan(step, jnp.zeros((B_, H, dk, dv), dt), kv)
    cross = jnp.einsum('bhncd,nbhde->bhnce', qc * q_decay[None, :, None, :, None].astype(dt), prev)
    o = (inner + cross).transpose(0, 2, 3, 1, 4).reshape(B_, S_, H, dv)
    o = rms_norm(o)
    return (jax.nn.silu(g) * o).reshape(B_, S_, H * dv)


def moba_attention(q, k, v, q_gain, k_gain):
    B_, S_, H, dh = q.shape
    L = MOBA_BLOCK
    NB = -(-S_ // L)
    Sp = NB * L
    pad = Sp - S_
    q = rms_norm(q, q_gain)
    k = rms_norm(k, k_gain)
    padw = ((0, 0), (0, 0), (0, pad), (0, 0))
    q = jnp.pad(q.transpose(0, 2, 1, 3), padw)
    k = jnp.pad(k.transpose(0, 2, 1, 3), padw)
    v = jnp.pad(v.transpose(0, 2, 1, 3), padw)
    kb = k.reshape(B_, H, NB, L, dh)
    vb = v.reshape(B_, H, NB, L, dh)
    k_mean = jnp.mean(kb.astype(jnp.float32), axis=3).astype(k.dtype)
    gate = jnp.einsum('bhsd,bhnd->bhsn', q, k_mean).astype(jnp.float32)
    q_blk = jnp.arange(Sp) // L
    past = jnp.arange(NB)[None, :] < q_blk[:, None]
    gate = jnp.where(past[None, None], gate, -jnp.inf)
    topk = min(MOBA_TOPK, NB)
    _, sel = lax.top_k(gate, topk)
    sel_valid = jnp.arange(topk)[None, :] < jnp.minimum(q_blk, topk)[:, None]
    scale = dh ** -0.5
    QC = MOBA_QCHUNK
    bi = jnp.arange(B_)[:, None, None, None]
    hi = jnp.arange(H)[None, :, None, None]

    def chunk(ci):
        s0 = ci * QC
        qc = lax.dynamic_slice_in_dim(q, s0, QC, axis=2)
        selc = lax.dynamic_slice_in_dim(sel, s0, QC, axis=2)
        validc = lax.dynamic_slice_in_dim(sel_valid, s0, QC, axis=0)
        own = s0 // L
        k_own = lax.dynamic_index_in_dim(kb, own, axis=2, keepdims=False)
        v_own = lax.dynamic_index_in_dim(vb, own, axis=2, keepdims=False)
        kg = kb[bi, hi, selc]
        vg = vb[bi, hi, selc]
        s_sel = jnp.einsum('bhqd,bhqkld->bhqkl', qc, kg).astype(jnp.float32) * scale
        s_sel = jnp.where(validc[None, None, :, :, None], s_sel, -jnp.inf)
        s_own = jnp.einsum('bhqd,bhld->bhql', qc, k_own).astype(jnp.float32) * scale
        qpos = s0 + jnp.arange(QC)
        kpos = own * L + jnp.arange(L)
        s_own = jnp.where((kpos[None, :] <= qpos[:, None])[None, None], s_own, -jnp.inf)
        logits = jnp.concatenate([s_sel.reshape(B_, H, QC, topk * L), s_own], axis=-1)
        p = jax.nn.softmax(logits, axis=-1).astype(v.dtype)
        p_sel = p[..., :topk * L].reshape(B_, H, QC, topk, L)
        p_own = p[..., topk * L:]
        return (jnp.einsum('bhqkl,bhqkld->bhqd', p_sel, vg)
                + jnp.einsum('bhql,bhld->bhqd', p_own, v_own))

    o = lax.map(chunk, jnp.arange(Sp // QC))
    o = o.transpose(1, 2, 0, 3, 4).reshape(B_, H, Sp, dh)[:, :, :S_]
    return o.transpose(0, 2, 1, 3).reshape(B_, S_, H * dh)


def moe_ffn(h, w_router, router_bias, w_gate, w_up, w_down, ws_gate, ws_up, ws_down):
    B_, S_, D = h.shape
    xf = h.reshape(-1, D)
    N = xf.shape[0]
    scores = jax.nn.sigmoid(jnp.einsum('nd,de->ne', xf, w_router).astype(jnp.float32))
    biased = scores + router_bias.astype(jnp.float32)
    grp = biased.reshape(N, N_GROUPS, N_EXPERTS // N_GROUPS)
    grp_score = jnp.sum(lax.top_k(grp, 2)[0], axis=-1)
    _, top_g = lax.top_k(grp_score, TOPK_GROUPS)
    gmask = jnp.any(top_g[:, :, None] == jnp.arange(N_GROUPS)[None, None, :], axis=1)
    emask = jnp.repeat(gmask, N_EXPERTS // N_GROUPS, axis=1)
    choice = jnp.where(emask, biased, -jnp.inf)
    _, top_e = lax.top_k(choice, TOP_K)
    w = jnp.take_along_axis(scores, top_e, axis=-1)
    w = w / jnp.sum(w, axis=-1, keepdims=True) * ROUTED_SCALE
    A = N * TOP_K
    flat_e = top_e.reshape(A)
    flat_t = jnp.repeat(jnp.arange(N, dtype=jnp.int32), TOP_K)
    flat_w = w.reshape(A)
    order = jnp.argsort(flat_e)
    se = flat_e[order]
    counts = jnp.bincount(flat_e, length=N_EXPERTS)
    padded = (counts + MOE_BLOCK - 1) // MOE_BLOCK * MOE_BLOCK
    pad_end = jnp.cumsum(padded)
    pad_start = pad_end - padded
    start = jnp.cumsum(counts) - counts
    dest = pad_start[se] + jnp.arange(A) - start[se]
    n_blocks = -(-A // MOE_BLOCK) + N_EXPERTS
    P = n_blocks * MOE_BLOCK
    buf_t = jnp.full((P,), N, jnp.int32).at[dest].set(flat_t[order])
    buf_w = jnp.zeros((P,), jnp.float32).at[dest].set(flat_w[order])
    blk_e = jnp.minimum(jnp.searchsorted(pad_end, jnp.arange(n_blocks) * MOE_BLOCK, side='right'), N_EXPERTS - 1)
    x_pad = jnp.concatenate([xf, jnp.zeros((1, D), xf.dtype)], axis=0)

    def expert_block(args):
        tok, wt, e = args
        xb = x_pad[tok]
        hid = jax.nn.silu(xb @ w_gate[e]) * (xb @ w_up[e])
        return (hid @ w_down[e]) * wt[:, None].astype(xb.dtype)

    out = lax.map(expert_block, (buf_t.reshape(n_blocks, MOE_BLOCK), buf_w.reshape(n_blocks, MOE_BLOCK), blk_e))
    routed = jax.ops.segment_sum(out.reshape(P, D), buf_t, num_segments=N + 1)[:N]
    shared = swiglu(xf, ws_gate, ws_up, ws_down)
    return (routed + shared).reshape(B_, S_, D)


def setup_inputs(seed: int = 0) -> dict:
    key = jax.random.key(seed)
    ks = jax.random.split(key, 18)
    D = D_MODEL

    def nrm(k, shape, scale):
        return jax.random.normal(k, shape, jnp.float32) * scale

    return {
        'x': nrm(ks[0], (BATCH, SEQ, D), 1.0),
        'c': nrm(ks[1], (BATCH, D), 1.0),
        'w_ada': nrm(ks[2], (DEPTH, D, N_MOD * D), 0.3 * D ** -0.5),
        'b_ada': nrm(ks[3], (DEPTH, N_MOD * D), 0.02),
        'g_mix': 1.0 + nrm(ks[4], (DEPTH, D), 0.02),
        'w_in': nrm(ks[5], (DEPTH, D, IN_COLS), D ** -0.5),
        'q_gain': 1.0 + nrm(ks[6], (DEPTH, MOBA_DH), 0.02),
        'k_gain': 1.0 + nrm(ks[7], (DEPTH, MOBA_DH), 0.02),
        'w_out': nrm(ks[8], (DEPTH, MIX_WIDTH, D), MIX_WIDTH ** -0.5),
        'g_ffn': 1.0 + nrm(ks[9], (DEPTH, D), 0.02),
        'w_router': nrm(ks[10], (DEPTH, D, N_EXPERTS), D ** -0.5),
        'router_bias': nrm(ks[11], (DEPTH, N_EXPERTS), 0.01),
        'w_gate': nrm(ks[12], (DEPTH, N_EXPERTS, D, EXPERT_FF), D ** -0.5),
        'w_up': nrm(ks[13], (DEPTH, N_EXPERTS, D, EXPERT_FF), D ** -0.5),
        'w_down': nrm(ks[14], (DEPTH, N_EXPERTS, EXPERT_FF, D), EXPERT_FF ** -0.5),
        'ws_gate': nrm(ks[15], (DEPTH, D, SHARED_FF), D ** -0.5),
        'ws_up': nrm(ks[16], (DEPTH, D, SHARED_FF), D ** -0.5),
        'ws_down': nrm(ks[17], (DEPTH, SHARED_FF, D), SHARED_FF ** -0.5),
    }


def reference(x, c, w_ada, b_ada, g_mix, w_in, q_gain, k_gain, w_out, g_ffn, w_router, router_bias,
              w_gate, w_up, w_down, ws_gate, ws_up, ws_down):
    B_, S_, D = x.shape
    split_at = np.cumsum(IN_SPLIT_SIZES)[:-1].tolist()
    for l in range(DEPTH):
        mod = jnp.einsum('bd,de->be', jax.nn.silu(c), w_ada[l]) + b_ada[l]
        sh_a, sc_a, gt_a, sh_f, sc_f, gt_f = [m[:, None, :] for m in jnp.split(mod, N_MOD, axis=-1)]
        h = rms_norm(x, g_mix[l]) * (1.0 + sc_a) + sh_a
        proj = jnp.einsum('bsd,dc->bsc', h, w_in[l])
        rq, rk, rv, rg, mq, mk, mv = jnp.split(proj, split_at, axis=-1)
        ret_out = retention(rq.reshape(B_, S_, RET_HEADS, RET_DK), rk.reshape(B_, S_, RET_HEADS, RET_DK),
                            rv.reshape(B_, S_, RET_HEADS, RET_DV), rg.reshape(B_, S_, RET_HEADS, RET_DV))
        moba_out = moba_attention(mq.reshape(B_, S_, MOBA_HEADS, MOBA_DH), mk.reshape(B_, S_, MOBA_HEADS, MOBA_DH),
                                  mv.reshape(B_, S_, MOBA_HEADS, MOBA_DH), q_gain[l], k_gain[l])
        mixed = jnp.einsum('bsc,cd->bsd', jnp.concatenate([ret_out, moba_out], axis=-1), w_out[l])
        x = x + gt_a * mixed
        h = rms_norm(x, g_ffn[l]) * (1.0 + sc_f) + sh_f
        x = x + gt_f * moe_ffn(h, w_router[l], router_bias[l], w_gate[l], w_up[l], w_down[l],
                               ws_gate[l], ws_up[l], ws_down[l])
    return x
```

```cpp
#include <hip/hip_runtime.h>
#include <stdint.h>
#include <stdio.h>

#ifndef MK_N_LAUNCHES
#define MK_N_LAUNCHES 1
#endif

#define DEVI __device__ __forceinline__
#define LAS __attribute__((address_space(3)))

typedef unsigned short bf16_t;
typedef short bf16x8 __attribute__((ext_vector_type(8)));
typedef float f32x4 __attribute__((ext_vector_type(4)));
typedef unsigned u32x4 __attribute__((ext_vector_type(4)));
typedef unsigned u32x2 __attribute__((ext_vector_type(2)));

constexpr int BATCH = 8, SEQ = 2048, DM = 1024, NTOK = BATCH * SEQ;
constexpr int INC = 3584;
constexpr int NEXP = 256, TOPK = 8, EFF = 256;
constexpr int NASSIGN = NTOK * TOPK;
constexpr int LIST_CAP = NTOK;
constexpr float EPS = 1e-6f;
constexpr int NTHREADS = 512, NWAVES = 8;
constexpr int NPHASE = 10;

constexpr int LDS_STAGE = 131072;
constexpr int LDS_MISC = LDS_STAGE;
constexpr int LDS_BYTES = LDS_STAGE + 4096 + 2048;
constexpr int LDS_ROWTAB = LDS_STAGE + 4096;
constexpr int MISC_BAR = 0, MISC_PRE = 64, MISC_SEL = 1280, MISC_KM = 1536, MISC_SCAL = 3400;

constexpr size_t al256(size_t x) { return (x + 255) & ~(size_t)255; }
constexpr size_t WS_CTL = 0;
constexpr size_t CTL_BYTES = 131072;
constexpr size_t WS_MOD = WS_CTL + CTL_BYTES;
constexpr size_t WS_ROPE = WS_MOD + al256((size_t)BATCH * 6144 * 4);
constexpr size_t WS_KMEAN = WS_ROPE + (size_t)2 * SEQ * 64 * 4;
constexpr size_t WS_WIN = WS_KMEAN + (size_t)8 * 8 * 8 * 64 * 4;
constexpr size_t WS_WOUT = WS_WIN + (size_t)INC * DM * 2;
constexpr size_t WS_WR = WS_WOUT + (size_t)DM * DM * 2;
constexpr size_t WS_WGU = WS_WR + (size_t)2 * NEXP * DM * 2;
constexpr size_t WS_WD = WS_WGU + (size_t)257 * 512 * DM * 2;
constexpr size_t WS_H1 = WS_WD + (size_t)257 * DM * 256 * 2;
constexpr size_t WS_H2LO = WS_H1 + (size_t)NTOK * DM * 2;
constexpr size_t WS_RQ = WS_H2LO + (size_t)NTOK * DM * 2;
constexpr size_t WS_RK = WS_RQ + (size_t)NTOK * 512 * 2;
constexpr size_t WS_RVT = WS_RK + (size_t)NTOK * 512 * 2;
constexpr size_t WS_RG = WS_RVT + (size_t)NTOK * 512 * 2;
constexpr size_t WS_MQ = WS_RG + (size_t)NTOK * 512 * 2;
constexpr size_t WS_MK = WS_MQ + (size_t)NTOK * 512 * 2;
constexpr size_t WS_MVT = WS_MK + (size_t)NTOK * 512 * 2;
constexpr size_t WS_MIX = WS_MVT + (size_t)NTOK * 512 * 2;
constexpr size_t WS_LOGIT = WS_MIX + (size_t)NTOK * DM * 2;
constexpr size_t WS_TOPW = WS_LOGIT + (size_t)NTOK * NEXP * 4;
constexpr size_t WS_LIST = WS_TOPW + (size_t)NASSIGN * 4;
constexpr size_t WS_Y = WS_LIST + (size_t)NEXP * LIST_CAP * 4;
constexpr size_t WS_STATS = WS_Y + (size_t)(NASSIGN + NTOK) * DM * 2;
constexpr size_t WS_END = WS_STATS + (size_t)64 * 4 * 256 * 4;

constexpr size_t WS_X1 = WS_WGU;


constexpr int CW_BAR = 0;
constexpr int CW_CNT = 4096;
constexpr int CW_QATT = 4096 + 64 * 256;
constexpr int CW_QMOE = CW_QATT + 64;
constexpr int CW_P4 = CW_QMOE + 128;

struct Params {
    const float* x; const float* c; const float* w_ada; const float* b_ada; const float* g_mix; const float* w_in;
    const float* q_gain; const float* k_gain; const float* w_out; const float* g_ffn; const float* w_router; const float* router_bias;
    const float* w_gate; const float* w_up; const float* w_down; const float* ws_gate; const float* ws_up; const float* ws_down;
    float* out; unsigned char* ws;
    int ph_lo, ph_hi;
    int prog[14];
};

DEVI unsigned pk2(float lo, float hi) { unsigned r; asm("v_cvt_pk_bf16_f32 %0, %1, %2" : "=v"(r) : "v"(lo), "v"(hi)); return r; }
DEVI float bf2f(unsigned short b) { return __uint_as_float((unsigned)b << 16); }
DEVI float bflo(unsigned u) { return __uint_as_float(u << 16); }
DEVI float bfhi(unsigned u) { return __uint_as_float(u & 0xffff0000u); }
DEVI float siluf(float v) { return v / (1.0f + __expf(-v)); }
DEVI float wave_sum(float v) {
#pragma unroll
    for (int o = 1; o < 64; o <<= 1) v += __shfl_xor(v, o);
    return v;
}
DEVI void glds16(const void* g, LAS unsigned char* l) {
    __builtin_amdgcn_global_load_lds((const __attribute__((address_space(1))) unsigned*)g, (LAS unsigned*)l, 16, 0, 0);
}
DEVI void glds16o(const void* base, unsigned off, LAS unsigned char* l) {
    __builtin_amdgcn_global_load_lds((const __attribute__((address_space(1))) unsigned*)((const __attribute__((address_space(1))) char*)base + off), (LAS unsigned*)l, 16, 0, 0);
}
DEVI bf16x8 lds128(LAS const unsigned char* p) { return *(LAS const bf16x8*)p; }
DEVI u32x2 lds64(LAS const unsigned char* p) { return *(LAS const u32x2*)p; }
#define VM_WAIT() asm volatile("s_waitcnt vmcnt(0)" ::: "memory")
DEVI const float* uniform_ptr(const float* p) {
    const unsigned long long v = (unsigned long long)p;
    const unsigned lo = __builtin_amdgcn_readfirstlane((unsigned)v), hi = __builtin_amdgcn_readfirstlane((unsigned)(v >> 32));
    return (const float*)(((unsigned long long)hi << 32) | lo);
}


#define XB_TMO      128
#define XB_XCNT(j)  (256  + 64 * (j))
#define XB_XSUB(j)  (1280 + 64 * (j))
#define XB_XGEN(j)  (2304 + 64 * (j))
#define XB_TOP      3328
#define XB_TOPGEN   3392
#define XCD_BAR_WORDS 3456
#define XB_SPIN_CAP (1u << 22)
DEVI unsigned xb_ld(unsigned* p) { return __hip_atomic_load(p, __ATOMIC_RELAXED, __HIP_MEMORY_SCOPE_AGENT); }
DEVI unsigned xb_add(unsigned* p, unsigned v) { return __hip_atomic_fetch_add(p, v, __ATOMIC_RELAXED, __HIP_MEMORY_SCOPE_AGENT); }
DEVI unsigned xb_xcc_id() { return (unsigned)__builtin_amdgcn_s_getreg((3 << 11) | 20) & 0xFu; }
#define XB_SPIN(cond, bar) do { unsigned _sp = 0; while (cond) { __builtin_amdgcn_s_sleep(1); \
    if ((++_sp & 255u) == 0u) { if (xb_ld(&(bar)[XB_TMO])) break; if (_sp > XB_SPIN_CAP) { atomicAdd(&(bar)[XB_TMO], 1u); break; } } } } while (0)
struct XcdBarrier { unsigned* bar; unsigned x; volatile LAS unsigned* st; };
DEVI XcdBarrier xcd_barrier_post(unsigned* bar, volatile LAS unsigned* st) {
    XcdBarrier b; b.bar = bar; b.x = xb_xcc_id(); b.st = st;
    if (threadIdx.x == 0) (void)xb_add(&bar[XB_XCNT(b.x)], 1u);
    return b;
}
DEVI void xcd_barrier_complete(unsigned* bar, unsigned x, unsigned& nloc, unsigned& nx) {
    const unsigned G = gridDim.x * gridDim.y * gridDim.z;
    unsigned sum, cnt, mine, sp = 0u;
    for (;;) {
        sum = 0u; cnt = 0u; mine = 0u;
#pragma unroll
        for (unsigned j = 0; j < 16; ++j) { const unsigned c = xb_ld(&bar[XB_XCNT(j)]); sum += c; cnt += (c > 0u) ? 1u : 0u; mine = (j == x) ? c : mine; }
        if (sum == G) break;
        __builtin_amdgcn_s_sleep(1);
        if ((++sp & 255u) == 0u) { if (xb_ld(&bar[XB_TMO])) break; if (sp > XB_SPIN_CAP) { atomicAdd(&bar[XB_TMO], 1u); break; } }
    }
    nloc = mine > 0u ? mine : 1u; nx = cnt > 0u ? cnt : 1u;
}
DEVI void xcd_barrier(const XcdBarrier& b) {
    asm volatile("s_waitcnt vmcnt(0)" ::: "memory");
    __syncthreads();
    if (threadIdx.x == 0) {
        unsigned* bar = b.bar;
        __builtin_amdgcn_s_waitcnt(0);
        unsigned nloc = b.st[0], nx = b.st[1];
        if (nloc == 0u) { xcd_barrier_complete(bar, b.x, nloc, nx); b.st[0] = nloc; b.st[1] = nx; }
        const unsigned old = xb_add(&bar[XB_XSUB(b.x)], 1u);
        const unsigned gen = old / nloc;
        if (old + 1u == (gen + 1u) * nloc) {
            __builtin_amdgcn_fence(__ATOMIC_RELEASE, "agent");
            asm volatile("s_waitcnt vmcnt(0)" ::: "memory");
            const unsigned og = xb_add(&bar[XB_TOP], 1u);
            const unsigned tg = og / nx;
            if (og + 1u == (tg + 1u) * nx) xb_add(&bar[XB_TOPGEN], 1u);
            else XB_SPIN(xb_ld(&bar[XB_TOPGEN]) == tg, bar);
            __builtin_amdgcn_fence(__ATOMIC_ACQUIRE, "agent");
            xb_add(&bar[XB_XGEN(b.x)], 1u);
            asm volatile("s_waitcnt vmcnt(0)" ::: "memory");
        } else {
            XB_SPIN(xb_ld(&bar[XB_XGEN(b.x)]) == gen, bar);
            __builtin_amdgcn_fence(__ATOMIC_ACQUIRE, "agent");
            asm volatile("s_waitcnt vmcnt(0)" ::: "memory");
        }
    }
    __syncthreads();
}

template <bool SWAP, int BH = 1>
DEVI void mma_step(f32x4 (&acc)[4][8], LAS const unsigned char* Ab, LAS const unsigned char* Bb, const int fr, const int fq) {
#pragma unroll
    for (int kk = 0; kk < 2; ++kk) {
        const int co = ((kk * 4 + fq) ^ (fr & 7)) * 16;
        bf16x8 a[4];
#pragma unroll
        for (int mt = 0; mt < 4; ++mt) a[mt] = lds128(Ab + mt * 2048 + co);
#pragma unroll
        for (int h = 0; h < BH; ++h) {
            constexpr int NB = 8 / BH;
            bf16x8 b[NB];
#pragma unroll
            for (int nt = 0; nt < NB; ++nt) b[nt] = lds128(Bb + (h * NB + nt) * 2048 + co);
#pragma unroll
            for (int nt = 0; nt < NB; ++nt)
#pragma unroll
                for (int mt = 0; mt < 4; ++mt) {
                    if (SWAP) acc[mt][h * NB + nt] = __builtin_amdgcn_mfma_f32_16x16x32_bf16(b[nt], a[mt], acc[mt][h * NB + nt], 0, 0, 0);
                    else acc[mt][h * NB + nt] = __builtin_amdgcn_mfma_f32_16x16x32_bf16(a[mt], b[nt], acc[mt][h * NB + nt], 0, 0, 0);
                }
            __builtin_amdgcn_sched_barrier(0);
        }
    }
}

template <int NSEG, bool SWAP = true>
DEVI void gemm_tile(f32x4 (&acc)[4][8], LAS unsigned char* lds, const bf16_t* A0, const bf16_t* A1, const bf16_t* A2,
                    const bf16_t* B0, const bf16_t* B1, const bf16_t* B2,
                    const int (&aoff)[4], const int (&boff)[4], const int K, const int tid, const int nra = 4) {
    const int w = tid >> 6, lane = tid & 63, fr = lane & 15, fq = lane >> 4, wm = w >> 1, wn = w & 1;
    const int lch = ((tid & 7) ^ ((tid >> 3) & 7)) * 8;
    const int kper = K >> 6;
#pragma unroll
    for (int mt = 0; mt < 4; ++mt)
#pragma unroll
        for (int nt = 0; nt < 8; ++nt) acc[mt][nt] = (f32x4){0.f, 0.f, 0.f, 0.f};
    auto stage = [&](int buf, const bf16_t* Ab, const bf16_t* Bb, int ks) {
        const int k0 = ks * 64 + lch;
        LAS unsigned char* base = lds + buf * 65536 + tid * 16;
#pragma unroll
        for (int i = 0; i < 4; ++i) if (i < nra) glds16o(Ab, (unsigned)(aoff[i] + k0) * 2u, base + i * 8192);
#pragma unroll
        for (int i = 0; i < 4; ++i) glds16o(Bb, (unsigned)(boff[i] + k0) * 2u, base + 32768 + i * 8192);
    };
    stage(0, A0, B0, 0);
    int buf = 0;
#pragma unroll
    for (int seg = 0; seg < NSEG; ++seg) {
        const bf16_t* Ac = (seg == 0) ? A0 : (seg == 1) ? A1 : A2;
        const bf16_t* Bc = (seg == 0) ? B0 : (seg == 1) ? B1 : B2;
        const bf16_t* An = (seg == 0) ? A1 : A2;
        const bf16_t* Bn = (seg == 0) ? B1 : B2;
#pragma unroll 1
        for (int ks = 0; ks < kper; ++ks) {
            VM_WAIT();
            __syncthreads();
            if (ks + 1 < kper) stage(buf ^ 1, Ac, Bc, ks + 1);
            else if (seg + 1 < NSEG) stage(buf ^ 1, An, Bn, 0);
            if (wm < nra) mma_step<SWAP>(acc, lds + buf * 65536 + (64 * wm + fr) * 128, lds + buf * 65536 + 32768 + (128 * wn + fr) * 128, fr, fq);
            buf ^= 1;
        }
    }
}

DEVI void wf32_load_b(f32x4 (&breg)[8], const float* wbase_in, const int ldb, const int ks, const int t) {
    const float* wbase = uniform_ptr(wbase_in);
    const unsigned toff = (unsigned)((8 * (t & 7)) * ldb + 4 * ((t >> 3) & 7)) * 4u;
    const float* s = wbase + (size_t)(ks * 64) * ldb;
#pragma unroll
    for (int i = 0; i < 8; ++i) breg[i] = *(const __attribute__((address_space(1))) f32x4*)((const __attribute__((address_space(1))) char*)(s + (size_t)i * ldb) + toff);
}
DEVI void gemm_tile_wf32(f32x4 (&acc)[4][8], f32x4 (&breg)[8], LAS unsigned char* lds, const bf16_t* A0, const float* wbase_in, const int ldb,
                         const float* nbase, const int nldb, const int (&aoff)[4], const int K, int& tid) {
    const int kper = K >> 6;
#pragma unroll
    for (int mt = 0; mt < 4; ++mt)
#pragma unroll
        for (int nt = 0; nt < 8; ++nt) acc[mt][nt] = (f32x4){0.f, 0.f, 0.f, 0.f};
    auto stage_a = [&](int buf, int ks, int t) {
        const int lch = ((t & 7) ^ ((t >> 3) & 7)) * 8;
        const int k0 = ks * 64 + lch;
        LAS unsigned char* base = lds + buf * 65536 + t * 16;
#pragma unroll
        for (int i = 0; i < 4; ++i) glds16o(A0, (unsigned)(aoff[i] + k0) * 2u, base + i * 8192);
    };
    auto write_b = [&](int buf, int t) {
        const int kg = t & 7, n4 = t >> 3;
        LAS unsigned char* base = lds + buf * 65536 + 32768 + (4 * n4) * 128;
#pragma unroll
        for (int j = 0; j < 4; ++j) {
            u32x4 o;
            o.x = pk2(breg[0][j], breg[1][j]); o.y = pk2(breg[2][j], breg[3][j]); o.z = pk2(breg[4][j], breg[5][j]); o.w = pk2(breg[6][j], breg[7][j]);
            *(LAS u32x4*)(base + j * 128 + ((kg ^ ((4 * n4 + j) & 7)) * 16)) = o;
        }
    };
    stage_a(0, 0, tid);
    write_b(0, tid);
    int buf = 0;
#pragma unroll 1
    for (int ks = 0; ks < kper; ++ks) {
        asm volatile("" : "+v"(tid));
        VM_WAIT();
        __syncthreads();
        const bool more = ks + 1 < kper;
        if (more) stage_a(buf ^ 1, ks + 1, tid);
        wf32_load_b(breg, more ? wbase_in : nbase, more ? ldb : nldb, more ? ks + 1 : 0, tid);
        {
            const int w = tid >> 6, lane = tid & 63, fr = lane & 15, fq = lane >> 4, wm = w >> 1, wn = w & 1;
            mma_step<true, 2>(acc, lds + buf * 65536 + (64 * wm + fr) * 128, lds + buf * 65536 + 32768 + (128 * wn + fr) * 128, fr, fq);
        }
        if (more) write_b(buf ^ 1, tid);
        buf ^= 1;
    }
}

constexpr int EPI_RS = 272, EPI_WAVE = 32 * EPI_RS;
DEVI void epi_transpose(LAS unsigned char* wl, const u32x2 (&pk)[2][8], u32x4 (&rows8)[8], const int lane) {
    const int fr = lane & 15, fq = lane >> 4;
#pragma unroll
    for (int m2 = 0; m2 < 2; ++m2)
#pragma unroll
        for (int nt = 0; nt < 8; ++nt) *(LAS u32x2*)(wl + (16 * m2 + fr) * EPI_RS + (16 * nt + 4 * fq) * 2) = pk[m2][nt];
    asm volatile("s_waitcnt lgkmcnt(0)" ::: "memory");
#pragma unroll
    for (int j = 0; j < 8; ++j) rows8[j] = *(LAS const u32x4*)(wl + (4 * j + fq) * EPI_RS + fr * 16);
    asm volatile("s_waitcnt lgkmcnt(0)" ::: "memory");
}

constexpr int EPV_RS = 144, EPV_WAVE = 64 * EPV_RS;
DEVI void epi_transpose_vt(LAS unsigned char* wl, const u32x2 (&pk)[4][4], u32x4 (&rows8)[8], const int lane) {
    const int fr = lane & 15, fq = lane >> 4;
#pragma unroll
    for (int mt = 0; mt < 4; ++mt)
#pragma unroll
        for (int n4 = 0; n4 < 4; ++n4) *(LAS u32x2*)(wl + (16 * n4 + fr) * EPV_RS + (32 * (mt >> 1) + 8 * fq + 4 * (mt & 1)) * 2) = pk[mt][n4];
    asm volatile("s_waitcnt lgkmcnt(0)" ::: "memory");
#pragma unroll
    for (int j = 0; j < 8; ++j) rows8[j] = *(LAS const u32x4*)(wl + (8 * j + (lane >> 3)) * EPV_RS + (lane & 7) * 16);
    asm volatile("s_waitcnt lgkmcnt(0)" ::: "memory");
}
constexpr int EPF_RS = 528, EPF_WAVE = 16 * EPF_RS;
DEVI void epi_transpose_f32(LAS unsigned char* wl, const f32x4 (&v)[8], f32x4 (&o)[8], const int lane) {
    const int fr = lane & 15, fq = lane >> 4;
#pragma unroll
    for (int nt = 0; nt < 8; ++nt) *(LAS f32x4*)(wl + fr * EPF_RS + (16 * nt + 4 * fq) * 4) = v[nt];
    asm volatile("s_waitcnt lgkmcnt(0)" ::: "memory");
#pragma unroll
    for (int j = 0; j < 8; ++j) o[j] = *(LAS const f32x4*)(wl + (2 * j + (lane >> 5)) * EPF_RS + (lane & 31) * 16);
    asm volatile("s_waitcnt lgkmcnt(0)" ::: "memory");
}

DEVI void transpose_item(const float* W, int N, int k0, int n0, bf16_t* dst_row0  , bf16_t* dst_lo_row0, int K, LAS float* scr, int lane) {
#pragma unroll 8
    for (int i = 0; i < 32; ++i) { const int kk = 2 * i + (lane >> 5); scr[kk * 33 + (lane & 31)] = W[(size_t)(k0 + kk) * N + n0 + (lane & 31)]; }
    asm volatile("s_waitcnt lgkmcnt(0)" ::: "memory");
    const int c = lane & 7;
#pragma unroll
    for (int j = 0; j < 4; ++j) {
        const int n = (lane >> 3) + 8 * j; const LAS float* s = scr + (8 * c) * 33 + n;
        float v[8];
#pragma unroll
        for (int q = 0; q < 8; ++q) v[q] = s[q * 33];
        unsigned ow[4];
#pragma unroll
        for (int q = 0; q < 4; ++q) ow[q] = pk2(v[2 * q], v[2 * q + 1]);
        u32x4 o; o.x = ow[0]; o.y = ow[1]; o.z = ow[2]; o.w = ow[3];
        *(u32x4*)(dst_row0 + (size_t)n * K + k0 + 8 * c) = o;
        if (dst_lo_row0) {
            unsigned lw[4];
#pragma unroll
            for (int q = 0; q < 4; ++q) lw[q] = pk2(v[2 * q] - bflo(ow[q]), v[2 * q + 1] - bfhi(ow[q]));
            u32x4 ol; ol.x = lw[0]; ol.y = lw[1]; ol.z = lw[2]; ol.w = lw[3];
            *(u32x4*)(dst_lo_row0 + (size_t)n * K + k0 + 8 * c) = ol;
        }
    }
    asm volatile("s_waitcnt lgkmcnt(0)" ::: "memory");
}

DEVI void phase0(const Params& p, LAS unsigned char* lds, int tid, int vcu, int G) {
    unsigned char* ws = p.ws;
    const int w = tid >> 6, lane = tid & 63;
    {
        LAS float* sc = (LAS float*)lds;
        LAS float* red = (LAS float*)(lds + 32768);
        float* mod = (float*)(ws + WS_MOD);
        for (int item = vcu; item < 192; item += G) {
            for (int i = tid; i < BATCH * DM; i += NTHREADS) sc[i] = siluf(p.c[i]);
            __syncthreads();
            const int cc = tid & 31, g = tid >> 5, col = item * 32 + cc;
            float a[8];
#pragma unroll
            for (int b = 0; b < 8; ++b) a[b] = 0.f;
            const float* wp = p.w_ada + (size_t)(g * 64) * 6144 + col;
#pragma unroll 1
            for (int k0 = 0; k0 < 64; k0 += 16) {
                float wv[16];
#pragma unroll
                for (int i = 0; i < 16; ++i) wv[i] = wp[(size_t)(k0 + i) * 6144];
#pragma unroll
                for (int i = 0; i < 16; ++i)
#pragma unroll
                    for (int b = 0; b < 8; ++b) a[b] += sc[b * DM + g * 64 + k0 + i] * wv[i];
            }
#pragma unroll
            for (int b = 0; b < 8; ++b) red[(g * 8 + b) * 32 + cc] = a[b];
            __syncthreads();
            if (tid < 256) {
                const int b = tid >> 5, c2 = tid & 31;
                float s = 0.f;
#pragma unroll
                for (int gg = 0; gg < 16; ++gg) s += red[(gg * 8 + b) * 32 + c2];
                mod[b * 6144 + item * 32 + c2] = s + p.b_ada[item * 32 + c2];
            }
            __syncthreads();
        }
    }
    {
        float* kmz = (float*)(ws + WS_KMEAN);
        for (int i = vcu * NTHREADS + tid; i < 8 * 8 * 8 * 64; i += G * NTHREADS) kmz[i] = 0.f;
        float* cosT = (float*)(ws + WS_ROPE); float* sinT = cosT + SEQ * 64;
        for (int i = vcu * NTHREADS + tid; i < SEQ * 64; i += G * NTHREADS) {
            const int pos = i >> 6, j = i & 63;
            const float inv = powf(10000.0f, -(float)j / 64.0f);
            const float ang = (float)pos * inv;
            cosT[i] = cosf(ang); sinT[i] = sinf(ang);
        }
    }
    {
        LAS float* scr = (LAS float*)(lds + w * 8448);
        const int gw = vcu * NWAVES + w, NGW = G * NWAVES;
        constexpr int I_IN = 16 * (INC / 32), I_OUT = 16 * 32, I_R = 16 * 8;
        constexpr int I_TOTAL = I_IN + I_OUT + I_R;
        bf16_t* win = (bf16_t*)(ws + WS_WIN); bf16_t* wout = (bf16_t*)(ws + WS_WOUT); bf16_t* wr = (bf16_t*)(ws + WS_WR);
        for (int it = gw; it < I_TOTAL; it += NGW) {
            int r = it;
            if (r < I_IN) { const int nb = INC / 32, kb = r / nb, n0 = (r % nb) * 32; transpose_item(p.w_in, INC, kb * 64, n0, win + (size_t)n0 * DM, nullptr, DM, scr, lane); continue; } r -= I_IN;
            if (r < I_OUT) { const int kb = r / 32, n0 = (r % 32) * 32; transpose_item(p.w_out, DM, kb * 64, n0, wout + (size_t)n0 * DM, nullptr, DM, scr, lane); continue; } r -= I_OUT;
            { const int kb = r / 8, n0 = (r % 8) * 32; transpose_item(p.w_router, NEXP, kb * 64, n0, wr + (size_t)n0 * DM, wr + (size_t)(NEXP + n0) * DM, DM, scr, lane); }
        }
    }
}

template <bool LO>
DEVI void rownorm_phase(const float* X, const float* g, const float* mod, int sh_off, int sc_off, bf16_t* Hhi, bf16_t* Hlo, int tid, int vcu, int G) {
    const int w = tid >> 6, lane = tid & 63;
    const int gw = vcu * NWAVES + w, NGW = G * NWAVES;
    for (int row = gw; row < NTOK; row += NGW) {
        const int b = row >> 11;
        const f32x4* xr = (const f32x4*)(X + (size_t)row * DM) + lane;
        f32x4 v[4]; float s = 0.f;
#pragma unroll
        for (int j = 0; j < 4; ++j) { v[j] = xr[64 * j]; s += (v[j].x * v[j].x + v[j].y * v[j].y) + (v[j].z * v[j].z + v[j].w * v[j].w); }
        const float rstd = rsqrtf(wave_sum(s) * (1.0f / DM) + EPS);
#pragma unroll
        for (int j = 0; j < 4; ++j) {
            const int col = 4 * lane + 256 * j;
            const f32x4 gg = *(const f32x4*)(g + col);
            const f32x4 sc = *(const f32x4*)(mod + b * 6144 + sc_off + col);
            const f32x4 sh = *(const f32x4*)(mod + b * 6144 + sh_off + col);
            f32x4 h = v[j] * rstd * gg * (sc + 1.0f) + sh;
            u32x2 o; o.x = pk2(h.x, h.y); o.y = pk2(h.z, h.w);
            *(u32x2*)(Hhi + (size_t)row * DM + col) = o;
            if (LO) {
                u32x2 ol; ol.x = pk2(h.x - bflo(o.x), h.y - bfhi(o.x)); ol.y = pk2(h.z - bflo(o.y), h.w - bfhi(o.y));
                *(u32x2*)(Hlo + (size_t)row * DM + col) = ol;
            }
        }
    }
}

DEVI void phase2(const Params& p, LAS unsigned char* lds, int tid, int vcu, int G) {
    unsigned char* ws = p.ws;
    const bf16_t* H = (const bf16_t*)(ws + WS_H1); const bf16_t* WT = (const bf16_t*)(ws + WS_WIN);
    const float* cosT = (const float*)(ws + WS_ROPE); const float* sinT = cosT + SEQ * 64;
    for (int it = vcu; it < 768 + 256; it += G) {
        asm volatile("" : "+v"(tid));
        const int w = tid >> 6, lane = tid & 63, fr = lane & 15, fq = lane >> 4;
        const bool halfm = it >= 768;
        const int id = halfm ? 768 + ((it - 768) >> 1) : it, rh = halfm ? ((it - 768) & 1) : 0, nra = halfm ? 2 : 4;
        const int pm = id / 14, pn = id % 14;
        int aoff[4], boff[4];
#pragma unroll
        for (int i = 0; i < 4; ++i) { aoff[i] = (pm * 256 + 128 * rh + (i & (nra - 1)) * 64 + (tid >> 3)) * DM; boff[i] = (pn * 256 + i * 64 + (tid >> 3)) * DM; }
        f32x4 acc[4][8];
        const int cat = pn >> 1, half = pn & 1;
        const int wm = w >> 1, wn = w & 1;
        const bool wact = wm < nra;
        if (cat == 2 || cat == 6) gemm_tile<1, false>(acc, lds, H, H, H, WT, WT, WT, aoff, boff, DM, tid, nra);
        else gemm_tile<1, true>(acc, lds, H, H, H, WT, WT, WT, aoff, boff, DM, tid, nra);
        const int b = pm >> 3, s0 = (pm & 7) * 256 + 128 * rh + 64 * wm;
        const bool isk = (cat == 5);
        LAS float* red = (LAS float*)(lds + 98304);
        __syncthreads();
        if (!wact) {
        } else if (cat == 2 || cat == 6) {
            bf16_t* dst = (bf16_t*)(ws + (cat == 2 ? WS_RVT : WS_MVT));
            LAS unsigned char* wl = lds + w * EPV_WAVE;
#pragma unroll
            for (int hf = 0; hf < 2; ++hf) {
                u32x2 pk[4][4];
#pragma unroll
                for (int mt = 0; mt < 4; ++mt)
#pragma unroll
                    for (int n4 = 0; n4 < 4; ++n4) { const f32x4 v = acc[mt][4 * hf + n4]; pk[mt][n4].x = pk2(v.x, v.y); pk[mt][n4].y = pk2(v.z, v.w); }
                u32x4 rows8[8];
                epi_transpose_vt(wl, pk, rows8, lane);
                const size_t rowbase = (size_t)b * 512 + 256 * half + 128 * wn + 64 * hf + (lane >> 3);
#pragma unroll
                for (int j = 0; j < 8; ++j) *(u32x4*)(dst + (rowbase + 8 * j) * SEQ + s0 + 8 * (lane & 7)) = rows8[j];
            }
        } else {
            LAS unsigned char* wl = lds + w * EPI_WAVE;
            const float* gain = isk ? p.k_gain : p.q_gain;
#pragma unroll
            for (int hf = 0; hf < 2; ++hf) {
                u32x2 pk[2][8];
                if (cat <= 1) {
                    const float lgh = log2f(1.0f - exp2f(-5.0f - (float)(2 * half + wn)));
                    const float sclb = (cat == 1) ? 0.08838834764831845f : 1.0f, lgs = (cat == 1) ? -lgh : lgh;
#pragma unroll
                    for (int m2 = 0; m2 < 2; ++m2) {
                        const int s = s0 + 32 * hf + 16 * m2 + fr;
                        const float scl = sclb * exp2f(lgs * (float)(s - 1024));
#pragma unroll
                        for (int np = 0; np < 4; ++np) {
                            const f32x4 cs = *(const f32x4*)(cosT + s * 64 + 16 * np + 4 * fq) * scl;
                            const f32x4 sn = *(const f32x4*)(sinT + s * 64 + 16 * np + 4 * fq) * scl;
                            const f32x4 x1 = acc[2 * hf + m2][np], x2 = acc[2 * hf + m2][np + 4];
                            const f32x4 o1 = x1 * cs - x2 * sn, o2 = x1 * sn + x2 * cs;
                            pk[m2][np].x = pk2(o1.x, o1.y); pk[m2][np].y = pk2(o1.z, o1.w);
                            pk[m2][np + 4].x = pk2(o2.x, o2.y); pk[m2][np + 4].y = pk2(o2.z, o2.w);
                        }
                    }
                } else if (cat == 3) {
#pragma unroll
                    for (int m2 = 0; m2 < 2; ++m2)
#pragma unroll
                        for (int nt = 0; nt < 8; ++nt) { const f32x4 v = acc[2 * hf + m2][nt]; pk[m2][nt].x = pk2(siluf(v.x), siluf(v.y)); pk[m2][nt].y = pk2(siluf(v.z), siluf(v.w)); }
                } else {
#pragma unroll
                    for (int hh = 0; hh < 2; ++hh) {
                        float rstd[2];
#pragma unroll
                        for (int m2 = 0; m2 < 2; ++m2) {
                            float ss = 0.f;
#pragma unroll
                            for (int np = 0; np < 4; ++np) { const f32x4 v = acc[2 * hf + m2][4 * hh + np]; ss += (v.x * v.x + v.y * v.y) + (v.z * v.z + v.w * v.w); }
                            ss += __shfl_xor(ss, 16); ss += __shfl_xor(ss, 32);
                            rstd[m2] = rsqrtf(ss * (1.0f / 64.0f) + EPS);
                        }
#pragma unroll
                        for (int np = 0; np < 4; ++np) {
                            const f32x4 gn = *(const f32x4*)(gain + 16 * np + 4 * fq) * (isk ? 1.0f : 0.125f * 1.4426950408889634f);
                            f32x4 cs = (f32x4){0.f, 0.f, 0.f, 0.f};
#pragma unroll
                            for (int m2 = 0; m2 < 2; ++m2) {
                                const f32x4 v = acc[2 * hf + m2][4 * hh + np] * rstd[m2] * gn;
                                cs += v;
                                pk[m2][4 * hh + np].x = pk2(v.x, v.y); pk[m2][4 * hh + np].y = pk2(v.z, v.w);
                            }
                            if (isk) {
#pragma unroll
                                for (int r = 0; r < 4; ++r) {
                                    float v = cs[r];
                                    v += __shfl_xor(v, 1); v += __shfl_xor(v, 2); v += __shfl_xor(v, 4); v += __shfl_xor(v, 8);
                                    if (fr == 0) { LAS float* rp = red + wm * 256 + 128 * wn + 64 * hh + 16 * np + 4 * fq + r; if (hf == 0) *rp = v; else *rp += v; }
                                }
                            }
                        }
                    }
                }
                u32x4 rows8[8];
                epi_transpose(wl, pk, rows8, lane);
#pragma unroll
                for (int j = 0; j < 8; ++j) {
                    const int s = s0 + 32 * hf + 4 * j + fq;
                    bf16_t* d;
                    if (cat <= 1) d = (bf16_t*)(ws + (cat == 0 ? WS_RQ : WS_RK)) + ((size_t)((b * 4 + 2 * half + wn) * SEQ + s)) * 128 + 8 * fr;
                    else if (cat == 3) d = (bf16_t*)(ws + WS_RG) + ((size_t)b * SEQ + s) * 512 + 256 * half + 128 * wn + 8 * fr;
                    else d = (bf16_t*)(ws + (isk ? WS_MK : WS_MQ)) + ((size_t)((b * 8 + 4 * half + 2 * wn + (fr >> 3)) * SEQ + s)) * 64 + 8 * (fr & 7);
                    *(u32x4*)d = rows8[j];
                }
            }
        }
        if (isk) {
            __syncthreads();
            if (tid < 256) {
                float* km = (float*)(ws + WS_KMEAN) + ((size_t)((b * 8 + 4 * half + (tid >> 6)) * 8 + (pm & 7))) * 64 + (tid & 63);
                if (halfm) atomicAdd(km, (red[tid] + red[256 + tid]) * (1.0f / 256.0f));
                else *km = ((red[tid] + red[256 + tid]) + (red[512 + tid] + red[768 + tid])) * (1.0f / 256.0f);
            }
        }
        __syncthreads();
    }
}

template <int D, bool MOBA>
DEVI void attn_unit(const Params& p, LAS unsigned char* lds, int b, int h, int qb, int tid) {
    unsigned char* ws = p.ws;
    constexpr int H = MOBA ? 8 : 4, KK = D / 32, DT = D / 16, RB = D * 2, TILE = 64 * RB, MASK = (D == 64) ? 7 : 15, ROUNDS = TILE / 8192;
    const int w = tid >> 6, lane = tid & 63, fr = lane & 15, fq = lane >> 4;
    const bf16_t* Q = (const bf16_t*)(ws + (MOBA ? WS_MQ : WS_RQ));
    const bf16_t* Kp = (const bf16_t*)(ws + (MOBA ? WS_MK : WS_RK));
    const bf16_t* VT = (const bf16_t*)(ws + (MOBA ? WS_MVT : WS_RVT));
    const size_t qk_base = (size_t)(b * H + h) * SEQ * D, vt_base = (size_t)(b * H + h) * D * SEQ;
    const int q0 = qb * 256 + 32 * w;
    const int ntiles = 4 * (qb + 1);
    auto tile_ks = [&](int i) -> int {
        if (MOBA) { const int kb = (i < 4) ? qb : ((i - 4) >> 2); return kb * 256 + (i & 3) * 64; }
        return i * 64;
    };
    auto stage = [&](int buf, int i) {
        const int ks = tile_ks(i);
        LAS unsigned char* base = lds + buf * (2 * TILE);
#pragma unroll
        for (int r = 0; r < ROUNDS; ++r) {
            int row, lchunk;
            if (D == 64) { row = tid >> 3; lchunk = (tid & 7) ^ (row & 7); }
            else { row = r * 32 + (tid >> 4); lchunk = (tid & 15) ^ (row & 15); }
            glds16(Kp + qk_base + (size_t)(ks + row) * D + lchunk * 8, base + r * 8192 + tid * 16);
            const int d = r * 64 + (tid >> 3), lc2 = (tid & 7) ^ ((d >> 1) & 7);
            glds16(VT + vt_base + (size_t)d * SEQ + ks + lc2 * 8, base + TILE + r * 8192 + tid * 16);
        }
    };
    stage(0, 0); stage(1, 1);
    LAS unsigned char* misc = lds + LDS_MISC;
    unsigned selm[2] = {0u, 0u};
    if (MOBA) {
        LAS float* km = (LAS float*)(misc + MISC_KM);
        LAS unsigned char* sel = misc + MISC_SEL;
        const float* kmg = (const float*)(ws + WS_KMEAN) + (size_t)((b * 8 + h) * 8) * 64;
        if (tid < 448 && (tid >> 6) < qb) km[tid] = kmg[tid];
        __syncthreads();
        if (tid < 256) {
            unsigned m = 0u;
            if (qb <= 3) m = (1u << qb) - 1u;
            else {
                float t0 = -INFINITY, t1 = -INFINITY, t2 = -INFINITY; int i0 = 0, i1 = 0, i2 = 0;
                const u32x4* qr = (const u32x4*)(Q + qk_base + (size_t)(qb * 256 + tid) * 64);
                u32x4 qv[8];
#pragma unroll
                for (int c = 0; c < 8; ++c) qv[c] = qr[c];
#pragma unroll 1
                for (int kb = 0; kb < qb; ++kb) {
                    const LAS f32x4* kr = (const LAS f32x4*)(km + kb * 64);
                    float g = 0.f;
#pragma unroll
                    for (int c = 0; c < 8; ++c) {
                        const f32x4 k0 = kr[2 * c], k1 = kr[2 * c + 1];
                        g += bflo(qv[c].x) * k0.x + bfhi(qv[c].x) * k0.y + bflo(qv[c].y) * k0.z + bfhi(qv[c].y) * k0.w
                           + bflo(qv[c].z) * k1.x + bfhi(qv[c].z) * k1.y + bflo(qv[c].w) * k1.z + bfhi(qv[c].w) * k1.w;
                    }
                    if (g > t0) { t2 = t1; i2 = i1; t1 = t0; i1 = i0; t0 = g; i0 = kb; }
                    else if (g > t1) { t2 = t1; i2 = i1; t1 = g; i1 = kb; }
                    else if (g > t2) { t2 = g; i2 = kb; }
                }
                m = (1u << i0) | (1u << i1) | (1u << i2);
            }
            sel[tid] = (unsigned char)m;
        }
        __syncthreads();
        selm[0] = sel[32 * w + fr]; selm[1] = sel[32 * w + 16 + fr];
    }
    bf16x8 qf[2][KK];
#pragma unroll
    for (int qt = 0; qt < 2; ++qt)
#pragma unroll
        for (int kk = 0; kk < KK; ++kk) qf[qt][kk] = *(const bf16x8*)(Q + qk_base + (size_t)(q0 + 16 * qt + fr) * D + kk * 32 + fq * 8);
    f32x4 o[DT][2];
#pragma unroll
    for (int dt = 0; dt < DT; ++dt) { o[dt][0] = (f32x4){0.f, 0.f, 0.f, 0.f}; o[dt][1] = (f32x4){0.f, 0.f, 0.f, 0.f}; }
    float mrun[2] = {-INFINITY, -INFINITY}, lrun[2] = {0.f, 0.f};
    float mfix = 0.f; bool usefix = false;
    if (MOBA) {
        float gq = fabsf(p.q_gain[lane]), gk = fabsf(p.k_gain[lane]);
#pragma unroll
        for (int o = 1; o < 64; o <<= 1) { gq = fmaxf(gq, __shfl_xor(gq, o)); gk = fmaxf(gk, __shfl_xor(gk, o)); }
        const float smax = 8.0f * gq * gk * 1.02f;
        mfix = smax * 1.4426950408889634f;
        usefix = __builtin_amdgcn_readfirstlane((int)(smax < 40.0f)) != 0;
    }
    const int npairs = ntiles >> 1;
    for (int jp = 0; jp < npairs; ++jp) {
        VM_WAIT();
        __syncthreads();
        if (jp + 1 < npairs) { stage(((jp + 1) & 1) * 2, 2 * jp + 2); stage(((jp + 1) & 1) * 2 + 1, 2 * jp + 3); }
#pragma unroll 1
      for (int hp = 0; hp < 2; ++hp) {
        const int i = 2 * jp + hp;
        const int ks = tile_ks(i);
        const int kb = ks >> 8;
        const bool own = (kb == qb);
        if (ks > q0 + 31) continue;
        LAS const unsigned char* Kb = lds + ((jp & 1) * 2 + hp) * (2 * TILE);
        LAS const unsigned char* Vb = Kb + TILE;
        float bi0 = 0.f, bi1 = 0.f;
        if (MOBA) {
            const float bsel = usefix ? -mfix : 0.f;
            bi0 = (own || ((selm[0] >> kb) & 1u)) ? bsel : -1.0e30f;
            bi1 = (own || ((selm[1] >> kb) & 1u)) ? bsel : -1.0e30f;
        }
        f32x4 s[2][4];
#pragma unroll
        for (int kt = 0; kt < 4; ++kt) {
            s[0][kt] = (f32x4){bi0, bi0, bi0, bi0}; s[1][kt] = (f32x4){bi1, bi1, bi1, bi1};
#pragma unroll
            for (int kk = 0; kk < KK; ++kk) {
                const bf16x8 kf = lds128(Kb + (16 * kt + fr) * RB + (((kk * 4 + fq) ^ (fr & MASK)) * 16));
                s[0][kt] = __builtin_amdgcn_mfma_f32_16x16x32_bf16(kf, qf[0][kk], s[0][kt], 0, 0, 0);
                s[1][kt] = __builtin_amdgcn_mfma_f32_16x16x32_bf16(kf, qf[1][kk], s[1][kt], 0, 0, 0);
            }
        }
        unsigned pw[2][2][4];
        if (MOBA) {
            const bool diag = own && (ks + 63 > q0);
            if (usefix) {
#pragma unroll
                for (int qt = 0; qt < 2; ++qt) {
                    const int qpos = q0 + 16 * qt + fr;
                    float ls = 0.f;
                    if (diag) {
#pragma unroll
                        for (int kt = 0; kt < 4; ++kt) {
                            float pv[4];
#pragma unroll
                            for (int r = 0; r < 4; ++r) { pv[r] = __builtin_amdgcn_exp2f((ks + 16 * kt + 4 * fq + r <= qpos) ? s[qt][kt][r] : -INFINITY); ls += pv[r]; }
                            pw[qt][kt >> 1][(kt & 1) * 2 + 0] = pk2(pv[0], pv[1]);
                            pw[qt][kt >> 1][(kt & 1) * 2 + 1] = pk2(pv[2], pv[3]);
                        }
                    } else {
#pragma unroll
                        for (int kt = 0; kt < 4; ++kt) {
                            float pv[4];
#pragma unroll
                            for (int r = 0; r < 4; ++r) { pv[r] = __builtin_amdgcn_exp2f(s[qt][kt][r]); ls += pv[r]; }
                            pw[qt][kt >> 1][(kt & 1) * 2 + 0] = pk2(pv[0], pv[1]);
                            pw[qt][kt >> 1][(kt & 1) * 2 + 1] = pk2(pv[2], pv[3]);
                        }
                    }
                    lrun[qt] += ls;
                }
            } else
#pragma unroll
            for (int qt = 0; qt < 2; ++qt) {
                const int qpos = q0 + 16 * qt + fr;
                float sv[4][4]; float mx = -INFINITY;
                if (diag) {
#pragma unroll
                    for (int kt = 0; kt < 4; ++kt)
#pragma unroll
                        for (int r = 0; r < 4; ++r) {
                            const int kpos = ks + 16 * kt + 4 * fq + r;
                            sv[kt][r] = (kpos <= qpos) ? s[qt][kt][r] : -INFINITY;
                            mx = fmaxf(mx, sv[kt][r]);
                        }
                } else {
#pragma unroll
                    for (int kt = 0; kt < 4; ++kt)
#pragma unroll
                        for (int r = 0; r < 4; ++r) { sv[kt][r] = s[qt][kt][r]; mx = fmaxf(mx, sv[kt][r]); }
                }
                mx = fmaxf(mx, __shfl_xor(mx, 16)); mx = fmaxf(mx, __shfl_xor(mx, 32));
                const float mnew = fmaxf(mrun[qt], mx);
                const float msub = (mnew == -INFINITY) ? 0.f : mnew;
                if (__builtin_amdgcn_ballot_w64(mnew != mrun[qt]) != 0ull) {
                    const float alpha = (mnew == -INFINITY) ? 1.0f : __builtin_amdgcn_exp2f(mrun[qt] - mnew);
                    lrun[qt] *= alpha;
#pragma unroll
                    for (int dt = 0; dt < DT; ++dt) o[dt][qt] *= alpha;
                }
                mrun[qt] = mnew;
                float ls = 0.f;
#pragma unroll
                for (int kt = 0; kt < 4; ++kt) {
                    float pv[4];
#pragma unroll
                    for (int r = 0; r < 4; ++r) { pv[r] = __builtin_amdgcn_exp2f(sv[kt][r] - msub); ls += pv[r]; }
                    pw[qt][kt >> 1][(kt & 1) * 2 + 0] = pk2(pv[0], pv[1]);
                    pw[qt][kt >> 1][(kt & 1) * 2 + 1] = pk2(pv[2], pv[3]);
                }
                lrun[qt] += ls;
            }
        } else {
#pragma unroll
            for (int qt = 0; qt < 2; ++qt) {
                const int qpos = q0 + 16 * qt + fr;
#pragma unroll
                for (int kt = 0; kt < 4; ++kt) {
                    float pv[4];
#pragma unroll
                    for (int r = 0; r < 4; ++r) {
                        const int kpos = ks + 16 * kt + 4 * fq + r;
                        pv[r] = (kpos <= qpos) ? s[qt][kt][r] : 0.f;
                    }
                    pw[qt][kt >> 1][(kt & 1) * 2 + 0] = pk2(pv[0], pv[1]);
                    pw[qt][kt >> 1][(kt & 1) * 2 + 1] = pk2(pv[2], pv[3]);
                }
            }
        }
#pragma unroll
        for (int sh = 0; sh < 2; ++sh) {
            bf16x8 pb[2];
#pragma unroll
            for (int qt = 0; qt < 2; ++qt) { u32x4 t; t.x = pw[qt][sh][0]; t.y = pw[qt][sh][1]; t.z = pw[qt][sh][2]; t.w = pw[qt][sh][3]; pb[qt] = __builtin_bit_cast(bf16x8, t); }
#pragma unroll
            for (int dt = 0; dt < DT; ++dt) {
                const bf16x8 vf = lds128(Vb + (16 * dt + fr) * 128 + (((4 * sh + fq) ^ ((fr >> 1) & 7)) * 16));
                o[dt][0] = __builtin_amdgcn_mfma_f32_16x16x32_bf16(vf, pb[0], o[dt][0], 0, 0, 0);
                o[dt][1] = __builtin_amdgcn_mfma_f32_16x16x32_bf16(vf, pb[1], o[dt][1], 0, 0, 0);
            }
        }
      }
    }
    bf16_t* mix = (bf16_t*)(ws + WS_MIX);
#pragma unroll
    for (int qt = 0; qt < 2; ++qt) {
        const size_t tok = (size_t)b * SEQ + q0 + 16 * qt + fr;
        if (MOBA) {
            float l = lrun[qt]; l += __shfl_xor(l, 16); l += __shfl_xor(l, 32);
            const float inv = 1.0f / l;
#pragma unroll
            for (int dt = 0; dt < DT; ++dt) {
                const f32x4 v = o[dt][qt] * inv;
                u32x2 ov; ov.x = pk2(v.x, v.y); ov.y = pk2(v.z, v.w);
                *(u32x2*)(mix + tok * DM + 512 + h * 64 + 16 * dt + 4 * fq) = ov;
            }
        } else {
            float ss = 0.f;
#pragma unroll
            for (int dt = 0; dt < DT; ++dt) { const f32x4 v = o[dt][qt]; ss += (v.x * v.x + v.y * v.y) + (v.z * v.z + v.w * v.w); }
            ss += __shfl_xor(ss, 16); ss += __shfl_xor(ss, 32);
            const float rstd = rsqrtf(ss * (1.0f / 128.0f) + EPS);
            const bf16_t* rg = (const bf16_t*)(ws + WS_RG);
#pragma unroll
            for (int dt = 0; dt < DT; ++dt) {
                const u32x2 gv = *(const u32x2*)(rg + tok * 512 + h * 128 + 16 * dt + 4 * fq);
                const f32x4 v = o[dt][qt] * rstd;
                u32x2 ov; ov.x = pk2(v.x * bflo(gv.x), v.y * bfhi(gv.x)); ov.y = pk2(v.z * bflo(gv.y), v.w * bfhi(gv.y));
                *(u32x2*)(mix + tok * DM + h * 128 + 16 * dt + 4 * fq) = ov;
            }
        }
    }
}

DEVI void phase3(const Params& p, LAS unsigned char* lds, int tid, unsigned* ctl) {
    LAS int* scal = (LAS int*)(lds + LDS_MISC + MISC_SCAL);
    for (;;) {
        asm volatile("" : "+v"(tid));
        __syncthreads();
        if (tid == 0) scal[0] = (int)atomicAdd(&ctl[CW_QATT], 1u);
        __syncthreads();
        const int u = scal[0];
        if (u >= 768) break;
        if (u < 256) {
            const int qb = 7 - (u >> 5), bh = u & 31;
            attn_unit<128, false>(p, lds, bh >> 2, bh & 3, qb, tid);
        } else {
            const int v = u - 256, qb = 7 - (v >> 6), bh = v & 63;
            attn_unit<64, true>(p, lds, bh >> 3, bh & 7, qb, tid);
        }
    }
}

template <bool FUSE>
DEVI void phase4(const Params& p, LAS unsigned char* lds, int tid, int vcu, int G, unsigned* ctl) {
    unsigned char* ws = p.ws;
    const bf16_t* A = (const bf16_t*)(ws + WS_MIX); const bf16_t* WT = (const bf16_t*)(ws + WS_WOUT);
    const float* mod = (const float*)(ws + WS_MOD);
    float* x1 = (float*)(ws + WS_X1);
    for (int id = vcu; id < 256; id += G) {
        asm volatile("" : "+v"(tid));
        const int w = tid >> 6, lane = tid & 63, fr = lane & 15, fq = lane >> 4;
        const int pm = id >> 2, pn = id & 3;
        int aoff[4], boff[4];
#pragma unroll
        for (int i = 0; i < 4; ++i) { aoff[i] = (pm * 256 + i * 64 + (tid >> 3)) * DM; boff[i] = (pn * 256 + i * 64 + (tid >> 3)) * DM; }
        f32x4 acc[4][8];
        gemm_tile<1>(acc, lds, A, A, A, WT, WT, WT, aoff, boff, DM, tid);
        const int b = pm >> 3, wm = w >> 1, wn = w & 1;
        __syncthreads();
        LAS unsigned char* wl = lds + w * EPF_WAVE;
        LAS float* rowss = (LAS float*)(lds + 98304);
#pragma unroll
        for (int mt = 0; mt < 4; ++mt) {
            f32x4 o[8];
            epi_transpose_f32(wl, acc[mt], o, lane);
            const int col = pn * 256 + 128 * wn + 4 * (lane & 31);
            const f32x4 gt = *(const f32x4*)(mod + b * 6144 + 2048 + col);
#pragma unroll
            for (int j = 0; j < 8; ++j) {
                const int row = 64 * wm + 16 * mt + 2 * j + (lane >> 5);
                const size_t tok = (size_t)pm * 256 + row;
                const f32x4 xv = *(const f32x4*)(p.x + tok * DM + col);
                const f32x4 v = xv + gt * o[j];
                *(f32x4*)(x1 + tok * DM + col) = v;
                if (FUSE) {
                    float ss = (v.x * v.x + v.y * v.y) + (v.z * v.z + v.w * v.w);
                    ss += __shfl_xor(ss, 1); ss += __shfl_xor(ss, 2); ss += __shfl_xor(ss, 4); ss += __shfl_xor(ss, 8); ss += __shfl_xor(ss, 16);
                    if ((lane & 31) == 0) rowss[wn * 256 + row] = ss;
                }
            }
        }
        if (FUSE) {
            __attribute__((address_space(1))) float* stats = (__attribute__((address_space(1))) float*)(ws + WS_STATS) + (size_t)pm * 1024;
            __syncthreads();
            if (tid < 256) __hip_atomic_store(stats + pn * 256 + tid, rowss[tid] + rowss[256 + tid], __ATOMIC_RELAXED, __HIP_MEMORY_SCOPE_AGENT);
            asm volatile("s_waitcnt vmcnt(0)" ::: "memory");
            __syncthreads();
            if (tid == 0) {
                unsigned* cw = ctl + CW_P4 + 64 * pm;
                (void)xb_add(cw, 1u);
                unsigned sp = 0;
                while (xb_ld(cw) < 4u && ++sp < (1u << 20)) __builtin_amdgcn_s_sleep(1);
                __builtin_amdgcn_fence(__ATOMIC_ACQUIRE, "agent");
                asm volatile("s_waitcnt vmcnt(0)" ::: "memory");
            }
            __syncthreads();
            if (tid < 256) {
                float s = 0.f;
#pragma unroll
                for (int q = 0; q < 4; ++q) s += __hip_atomic_load(stats + q * 256 + tid, __ATOMIC_RELAXED, __HIP_MEMORY_SCOPE_AGENT);
                rowss[512 + tid] = rsqrtf(s * (1.0f / DM) + EPS);
            }
            __syncthreads();
            bf16_t* Hhi = (bf16_t*)(ws + WS_H1); bf16_t* Hlo = (bf16_t*)(ws + WS_H2LO);
            const int col = pn * 256 + 128 * wn + 4 * (lane & 31);
            const f32x4 gg = *(const f32x4*)(p.g_ffn + col);
            const f32x4 sc = *(const f32x4*)(mod + b * 6144 + 4096 + col) + 1.0f;
            const f32x4 sh = *(const f32x4*)(mod + b * 6144 + 3072 + col);
#pragma unroll 4
            for (int rr = 0; rr < 32; ++rr) {
                const int row = 64 * wm + 2 * rr + (lane >> 5);
                const size_t tok = (size_t)pm * 256 + row;
                const f32x4 v = *(const f32x4*)(x1 + tok * DM + col);
                const f32x4 h = v * rowss[512 + row] * gg * sc + sh;
                u32x2 o; o.x = pk2(h.x, h.y); o.y = pk2(h.z, h.w);
                *(u32x2*)(Hhi + tok * DM + col) = o;
                u32x2 ol; ol.x = pk2(h.x - bflo(o.x), h.y - bfhi(o.x)); ol.y = pk2(h.z - bflo(o.y), h.w - bfhi(o.y));
                *(u32x2*)(Hlo + tok * DM + col) = ol;
            }
            asm volatile("s_waitcnt vmcnt(0)" ::: "memory");
            __syncthreads();
            {
                const bf16_t* Wh = (const bf16_t*)(ws + WS_WR); const bf16_t* Wl = Wh + (size_t)NEXP * DM;
#pragma unroll
                for (int i = 0; i < 4; ++i) { aoff[i] = (pm * 256 + i * 64 + (tid >> 3)) * DM + 256 * pn; boff[i] = (i * 64 + (tid >> 3)) * DM + 256 * pn; }
                gemm_tile<3>(acc, lds, Hlo, Hhi, Hhi, Wh, Wl, Wh, aoff, boff, 256, tid);
                float* dst = (float*)(ws + WS_RQ) + (size_t)pn * NTOK * NEXP;
#pragma unroll
                for (int mt = 0; mt < 4; ++mt) {
                    const size_t tok = (size_t)pm * 256 + 64 * wm + 16 * mt + fr;
#pragma unroll
                    for (int nt = 0; nt < 8; ++nt) *(f32x4*)(dst + tok * NEXP + 128 * wn + 16 * nt + 4 * fq) = acc[mt][nt];
                }
            }
        }
        __syncthreads();
    }
}

constexpr int RR = 8;
DEVI float wave_max(float v) {
#pragma unroll
    for (int o = 1; o < 64; o <<= 1) v = fmaxf(v, __shfl_xor(v, o));
    return v;
}
DEVI void route_rows(const Params& p, unsigned char* ws, unsigned* ctl, int tok0, int lane) {
    const float* part = (const float*)(ws + WS_RQ);
    const f32x4 b4 = *(const f32x4*)(p.router_bias + 4 * lane);
    float sc[RR][4], ch[RR][4];
#pragma unroll
    for (int q = 0; q < RR; ++q) {
        const size_t off = (size_t)(tok0 + q) * NEXP + 4 * lane;
        f32x4 l4 = *(const f32x4*)(part + off);
#pragma unroll
        for (int j = 1; j < 4; ++j) l4 += *(const f32x4*)(part + (size_t)j * NTOK * NEXP + off);
        float bi[4];
#pragma unroll
        for (int j = 0; j < 4; ++j) { sc[q][j] = 1.0f / (1.0f + __expf(-l4[j])); bi[j] = sc[q][j] + b4[j]; }
        float t1 = fmaxf(bi[0], bi[1]), t2 = fminf(bi[0], bi[1]);
        { const float a1 = fmaxf(bi[2], bi[3]), a2 = fminf(bi[2], bi[3]); const float n1 = fmaxf(t1, a1), n2 = fmaxf(fminf(t1, a1), fmaxf(t2, a2)); t1 = n1; t2 = n2; }
#pragma unroll
        for (int o = 1; o < 8; o <<= 1) {
            const float a1 = __shfl_xor(t1, o), a2 = __shfl_xor(t2, o);
            const float n1 = fmaxf(t1, a1), n2 = fmaxf(fminf(t1, a1), fmaxf(t2, a2)); t1 = n1; t2 = n2;
        }
        const float gs = t1 + t2; const int g = lane >> 3;
        int rank = 0;
#pragma unroll
        for (int j = 0; j < 8; ++j) { const float o = __uint_as_float(__builtin_amdgcn_readlane(__float_as_uint(gs), 8 * j)); rank += (o > gs || (o == gs && j < g)) ? 1 : 0; }
        const bool gsel = rank < 4;
#pragma unroll
        for (int j = 0; j < 4; ++j) ch[q][j] = gsel ? bi[j] : -INFINITY;
    }
    int me[RR]; float mw[RR], wsum[RR];
#pragma unroll
    for (int q = 0; q < RR; ++q) { me[q] = 0; mw[q] = 0.f; wsum[q] = 0.f; }
#pragma unroll
    for (int k = 0; k < 8; ++k) {
        float M[RR];
#pragma unroll
        for (int q = 0; q < RR; ++q) M[q] = fmaxf(fmaxf(ch[q][0], ch[q][1]), fmaxf(ch[q][2], ch[q][3]));
#pragma unroll
        for (int o = 1; o < 64; o <<= 1) {
#pragma unroll
            for (int q = 0; q < RR; ++q) M[q] = fmaxf(M[q], __shfl_xor(M[q], o));
        }
#pragma unroll
        for (int q = 0; q < RR; ++q) {
            const bool h0 = ch[q][0] == M[q], h1 = ch[q][1] == M[q], h2 = ch[q][2] == M[q], h3 = ch[q][3] == M[q];
            const unsigned long long bal = __builtin_amdgcn_ballot_w64(h0 || h1 || h2 || h3);
            const int wl = __builtin_amdgcn_readfirstlane((int)__builtin_ctzll(bal));
            const int sub = h0 ? 0 : (h1 ? 1 : (h2 ? 2 : 3));
            const float myscore = h0 ? sc[q][0] : (h1 ? sc[q][1] : (h2 ? sc[q][2] : sc[q][3]));
            const int wsub = __builtin_amdgcn_readlane(sub, wl);
            const float wsel = __uint_as_float(__builtin_amdgcn_readlane(__float_as_uint(myscore), wl));
            if (lane == wl) {
                if (sub == 0) ch[q][0] = -INFINITY; else if (sub == 1) ch[q][1] = -INFINITY; else if (sub == 2) ch[q][2] = -INFINITY; else ch[q][3] = -INFINITY;
            }
            wsum[q] += wsel;
            if (lane == k) { me[q] = 4 * wl + wsub; mw[q] = wsel; }
        }
    }
    if (lane < 8) {
        unsigned rk[RR];
#pragma unroll
        for (int q = 0; q < RR; ++q) rk[q] = __hip_atomic_fetch_add(&ctl[CW_CNT + 64 * me[q]], 1u, __ATOMIC_RELAXED, __HIP_MEMORY_SCOPE_AGENT);
#pragma unroll
        for (int q = 0; q < RR; ++q) {
            const int aid = (tok0 + q) * 8 + lane;
            ((float*)(ws + WS_TOPW))[aid] = mw[q] * (2.5f / wsum[q]);
            ((int*)(ws + WS_LIST))[(size_t)me[q] * LIST_CAP + rk[q]] = aid;
        }
    }
}

DEVI void phase6(const Params& p, LAS unsigned char* lds, int tid, int vcu, int G) {
    unsigned char* ws = p.ws;
    const bf16_t* Hh = (const bf16_t*)(ws + WS_H1); const bf16_t* Hl = (const bf16_t*)(ws + WS_H2LO);
    const bf16_t* Wh = (const bf16_t*)(ws + WS_WR); const bf16_t* Wl = Wh + (size_t)NEXP * DM;
    float* part = (float*)(ws + WS_RQ);
    for (int id = vcu; id < 4 * (NTOK / 256); id += G) {
        asm volatile("" : "+v"(tid));
        const int w = tid >> 6, lane = tid & 63, fr = lane & 15, fq = lane >> 4;
        const int pm = id >> 2, kq = id & 3;
        int aoff[4], boff[4];
#pragma unroll
        for (int i = 0; i < 4; ++i) { aoff[i] = (pm * 256 + i * 64 + (tid >> 3)) * DM + 256 * kq; boff[i] = (i * 64 + (tid >> 3)) * DM + 256 * kq; }
        f32x4 acc[4][8];
        gemm_tile<3>(acc, lds, Hl, Hh, Hh, Wh, Wl, Wh, aoff, boff, 256, tid);
        float* dst = part + (size_t)kq * NTOK * NEXP;
        const int wm = w >> 1, wn = w & 1;
#pragma unroll
        for (int mt = 0; mt < 4; ++mt) {
            const size_t tok = (size_t)pm * 256 + 64 * wm + 16 * mt + fr;
#pragma unroll
            for (int nt = 0; nt < 8; ++nt) *(f32x4*)(dst + tok * NEXP + 128 * wn + 16 * nt + 4 * fq) = acc[mt][nt];
        }
        __syncthreads();
    }
}

DEVI void phase_route(const Params& p, int tid, int vcu, int G, unsigned* ctl) {
    const int w = tid >> 6, lane = tid & 63;
    const int gw = vcu * NWAVES + w, NGW = G * NWAVES;
    for (int t0 = gw * RR; t0 < NTOK; t0 += NGW * RR) route_rows(p, p.ws, ctl, t0, lane);
}

DEVI void phase7(const Params& p, LAS unsigned char* lds, int tid, int vcu, int G, unsigned* ctl) {
    unsigned char* ws = p.ws;
    LAS int* pre = (LAS int*)(lds + LDS_MISC + MISC_PRE);
    LAS int* cnts = (LAS int*)lds;
    LAS int* scan = (LAS int*)(lds + 1024);
    if (tid < NEXP) { const int c = (int)xb_ld(&ctl[CW_CNT + 64 * tid]); cnts[tid] = c; scan[tid] = (c + 255) >> 8; }
    __syncthreads();
#pragma unroll 1
    for (int o = 1; o < NEXP; o <<= 1) {
        int v = 0;
        if (tid < NEXP && tid >= o) v = scan[tid - o];
        __syncthreads();
        if (tid < NEXP) scan[tid] += v;
        __syncthreads();
    }
    if (tid < NEXP) pre[tid + 1] = scan[tid];
    if (tid == 0) pre[0] = 0;
    __syncthreads();
    if (tid == 0) pre[NEXP + 1] = pre[NEXP] + NTOK / 256;
    __syncthreads();
    const int U = pre[NEXP + 1];
    LAS int* cntm = (LAS int*)(lds + LDS_MISC + MISC_KM);
    if (tid < NEXP) cntm[tid] = cnts[tid];
    __syncthreads();
    const bf16_t* Hh = (const bf16_t*)(ws + WS_H1);
    bf16_t* Hs = (bf16_t*)(ws + WS_MIX) + (size_t)blockIdx.x * 256 * 256;
    bf16_t* Y = (bf16_t*)(ws + WS_Y);
    const int* list = (const int*)(ws + WS_LIST); const float* topw = (const float*)(ws + WS_TOPW);
    auto unit_expert = [&](int uu) -> int { int lo = 0, hi = NEXP + 1; while (hi - lo > 1) { const int mid = (lo + hi) >> 1; if (pre[mid] <= uu) lo = mid; else hi = mid; } return lo; };
    auto stage1_base = [&](int ee, int ww) -> const float* {
        const float* Wg = (ee < NEXP) ? p.w_gate + (size_t)ee * DM * EFF : p.ws_gate;
        const float* Wu = (ee < NEXP) ? p.w_up + (size_t)ee * DM * EFF : p.ws_up;
        const int R = 32 * ww, within = R & 127;
        return ((within < 64) ? Wg : Wu) + 64 * (R >> 7) + (within & 63);
    };
    f32x4 breg[8];
    if (vcu < U) wf32_load_b(breg, stage1_base(unit_expert(vcu), tid >> 6), EFF, 0, tid);
    for (int u = vcu; u < U; u += G) {
        asm volatile("" : "+v"(tid));
        const int w = tid >> 6, lane = tid & 63, fr = lane & 15, fq = lane >> 4;
        const int e = unit_expert(u), mtile = u - pre[e];
        const int cnt = (e < NEXP) ? cntm[e] : NTOK;
        const int rbase = mtile * 256;
        int aoff[4];
#pragma unroll
        for (int i = 0; i < 4; ++i) {
            int r = rbase + i * 64 + (tid >> 3); r = r < cnt ? r : cnt - 1;
            const int tok = (e < NEXP) ? (list[(size_t)e * LIST_CAP + r] >> 3) : r;
            aoff[i] = tok * DM;
        }
        {
            LAS int* taid = (LAS int*)(lds + LDS_ROWTAB); LAS float* tw = (LAS float*)(lds + LDS_ROWTAB + 1024);
            if (tid < 256) {
                const int r = rbase + tid; int a = -1; float wv = 0.f;
                if (r < cnt) { if (e < NEXP) { a = list[(size_t)e * LIST_CAP + r]; wv = topw[a]; } else { a = NASSIGN + r; wv = 1.0f; } }
                taid[tid] = a; tw[tid] = wv;
            }
        }
        f32x4 acc[4][8];
        const float* Wdn = (e < NEXP) ? p.w_down + (size_t)e * EFF * DM : p.ws_down;
        const float* b1 = stage1_base(e, w);
        const float* b2 = Wdn + 32 * w;
        const float* bnext = (u + G < U) ? stage1_base(unit_expert(u + G), w) : b1;
#pragma unroll 1
        for (int nh = 0; nh < 2; ++nh) {
            const float* bcol = b1 + nh * 128;
            const float* nb = (nh == 0) ? b1 + 128 : b2;
            gemm_tile_wf32(acc, breg, lds, Hh, bcol, EFF, nb, (nh == 0) ? EFF : DM, aoff, DM, tid);
            const int w = tid >> 6, lane = tid & 63, fr = lane & 15, fq = lane >> 4, wm = w >> 1, wn = w & 1;
#pragma unroll
            for (int mt = 0; mt < 4; ++mt)
#pragma unroll
                for (int nt = 0; nt < 4; ++nt) {
                    const f32x4 g = acc[mt][nt], uu = acc[mt][nt + 4];
                    u32x2 o; o.x = pk2(siluf(g.x) * uu.x, siluf(g.y) * uu.y); o.y = pk2(siluf(g.z) * uu.z, siluf(g.w) * uu.w);
                    *(u32x2*)(Hs + (size_t)(64 * wm + 16 * mt + fr) * 256 + nh * 128 + 64 * wn + 16 * nt + 4 * fq) = o;
                    if (nt == 3) __builtin_amdgcn_sched_barrier(0);
                }
            __syncthreads();
        }
#pragma unroll 1
        for (int nq = 0; nq < 4; ++nq) {
#pragma unroll
            for (int i = 0; i < 4; ++i) aoff[i] = (i * 64 + (tid >> 3)) * 256;
            gemm_tile_wf32(acc, breg, lds, Hs, b2 + nq * 256, DM, (nq < 3) ? b2 + (nq + 1) * 256 : bnext, (nq < 3) ? DM : EFF, aoff, EFF, tid);
            const int w = tid >> 6, lane = tid & 63, fr = lane & 15, fq = lane >> 4, wm = w >> 1, wn = w & 1;
            __syncthreads();
            LAS unsigned char* wl = lds + w * EPI_WAVE;
#pragma unroll
            for (int hf = 0; hf < 2; ++hf) {
                u32x2 pk[2][8];
#pragma unroll
                for (int m2 = 0; m2 < 2; ++m2) {
                    const float wrow = ((LAS const float*)(lds + LDS_ROWTAB + 1024))[64 * wm + 32 * hf + 16 * m2 + fr];
#pragma unroll
                    for (int nt = 0; nt < 8; ++nt) { const f32x4 v = acc[2 * hf + m2][nt] * wrow; pk[m2][nt].x = pk2(v.x, v.y); pk[m2][nt].y = pk2(v.z, v.w); }
                }
                u32x4 rows8[8];
                epi_transpose(wl, pk, rows8, lane);
#pragma unroll
                for (int j = 0; j < 8; ++j) {
                    const int aid = ((LAS const int*)(lds + LDS_ROWTAB))[64 * wm + 32 * hf + 4 * j + fq];
                    if (aid >= 0) *(u32x4*)(Y + (size_t)aid * DM + nq * 256 + 128 * wn + 8 * fr) = rows8[j];
                }
            }
            __syncthreads();
        }
    }
}

DEVI void phase8(const Params& p, int tid, int vcu, int G) {
    unsigned char* ws = p.ws;
    const int w = tid >> 6, lane = tid & 63;
    const int gw = vcu * NWAVES + w, NGW = G * NWAVES;
    const bf16_t* Y = (const bf16_t*)(ws + WS_Y); const float* mod = (const float*)(ws + WS_MOD);
    for (int tok = gw; tok < NTOK; tok += NGW) {
        const int b = tok >> 11;
#pragma unroll
        for (int j = 0; j < 2; ++j) {
            const int col = 512 * j + 8 * lane;
            float a[8];
#pragma unroll
            for (int q = 0; q < 8; ++q) a[q] = 0.f;
#pragma unroll
            for (int k = 0; k < 9; ++k) {
                const size_t row = (k < 8) ? ((size_t)tok * 8 + k) : ((size_t)NASSIGN + tok);
                const u32x4 v = *(const u32x4*)(Y + row * DM + col);
                a[0] += bflo(v.x); a[1] += bfhi(v.x); a[2] += bflo(v.y); a[3] += bfhi(v.y); a[4] += bflo(v.z); a[5] += bfhi(v.z); a[6] += bflo(v.w); a[7] += bfhi(v.w);
            }
            float* o = p.out + (size_t)tok * DM + col;
            const float* xi = (const float*)(ws + WS_X1) + (size_t)tok * DM + col;
            const float* gt = mod + b * 6144 + 5120 + col;
            const f32x4 x0 = *(const f32x4*)xi, x1 = *(const f32x4*)(xi + 4);
            const f32x4 g0 = *(const f32x4*)gt, g1 = *(const f32x4*)(gt + 4);
            *(f32x4*)o = x0 + g0 * (f32x4){a[0], a[1], a[2], a[3]};
            *(f32x4*)(o + 4) = x1 + g1 * (f32x4){a[4], a[5], a[6], a[7]};
        }
    }
}

__global__ void __launch_bounds__(NTHREADS) hymba_fwd(Params p_in) {
    extern __shared__ __attribute__((aligned(16))) unsigned char smem[];
    LAS unsigned char* lds = (LAS unsigned char*)smem;
    int tid = threadIdx.x;
    const int G = gridDim.x;
    const int bx = blockIdx.x;
    const int vcu = (G % 8 == 0) ? (bx % 8) * (G / 8) + bx / 8 : bx;
    unsigned* ctl = (unsigned*)(p_in.ws + WS_CTL);
    if (tid < 4) ((LAS unsigned*)(lds + LDS_MISC + MISC_BAR))[tid] = 0u;
    __syncthreads();
    XcdBarrier bar; bar.bar = ctl + CW_BAR; bar.x = 0; bar.st = nullptr;
    const bool multi = (p_in.ph_hi - p_in.ph_lo) > 1;
    if (multi) bar = xcd_barrier_post(ctl + CW_BAR, (volatile LAS unsigned*)(lds + LDS_MISC + MISC_BAR));
    const float* mod = nullptr;
    Params p = p_in;
#pragma unroll 1
    for (int pi = p_in.ph_lo; pi < p_in.ph_hi; ++pi) {
        if (pi > p_in.ph_lo) xcd_barrier(bar);
        int ph = p_in.prog[0];
#pragma unroll
        for (int q = 1; q < 14; ++q) ph = (pi == q) ? p_in.prog[q] : ph;
        {
            int t = threadIdx.x; asm volatile("" : "+v"(t)); tid = t;
            unsigned char* wsl = p_in.ws; asm volatile("" : "+s"(wsl)); p.ws = wsl;
            float* ol = p_in.out; asm volatile("" : "+s"(ol)); p.out = ol;
            mod = (const float*)(wsl + WS_MOD);
        }
        switch (ph) {
#if !defined(ONLY_PH) || ONLY_PH == 0
        case 0: phase0(p, lds, tid, vcu, G); break;
#endif
#if !defined(ONLY_PH) || ONLY_PH == 1
        case 1: rownorm_phase<false>(p.x, p.g_mix, mod, 0, 1024, (bf16_t*)(p.ws + WS_H1), nullptr, tid, vcu, G); break;
#endif
#if !defined(ONLY_PH) || ONLY_PH == 2
        case 2: phase2(p, lds, tid, vcu, G); break;
#endif
#if !defined(ONLY_PH) || ONLY_PH == 3
        case 3: phase3(p, lds, tid, ctl + pi); break;
#endif
#if !defined(ONLY_PH) || ONLY_PH == 4
        case 4: phase4<false>(p, lds, tid, vcu, G, ctl); break;
        case 11: phase4<true>(p, lds, tid, vcu, G, ctl); break;
#endif
#if !defined(ONLY_PH) || ONLY_PH == 5
        case 5: rownorm_phase<true>((const float*)(p.ws + WS_X1), p.g_ffn, mod, 3072, 4096, (bf16_t*)(p.ws + WS_H1), (bf16_t*)(p.ws + WS_H2LO), tid, vcu, G); break;
#endif
#if !defined(ONLY_PH) || ONLY_PH == 6
        case 6: phase6(p, lds, tid, vcu, G); break;
#endif
#if !defined(ONLY_PH) || ONLY_PH == 7
        case 7: phase_route(p, tid, vcu, G, ctl); break;
#endif
#if !defined(ONLY_PH) || ONLY_PH == 8
        case 8: phase7(p, lds, tid, vcu, G, ctl); break;
#endif
#if !defined(ONLY_PH) || ONLY_PH == 9
        case 9: phase8(p, tid, vcu, G); break;
#endif
        default: break;
        }
    }
}

extern "C" void kernel_launch(void* const* d_in, const int* in_sizes, int n_in, void* d_out, int out_size, void* d_ws, size_t ws_size, hipStream_t stream) {
    static int grid = 0;
    if (grid == 0) {
        if (n_in != 18 || out_size != NTOK * DM || ws_size < WS_END) {
            fprintf(stderr, "kernel_launch: unexpected shapes (n_in %d, out %d, ws %zu, need %zu)\n", n_in, out_size, ws_size, (size_t)WS_END); grid = -1; return;
        }
        int dev = 0, cus = 0, per_cu = 0;
        hipGetDevice(&dev);
        hipDeviceGetAttribute(&cus, hipDeviceAttributeMultiprocessorCount, dev);
        hipFuncSetAttribute((const void*)hymba_fwd, hipFuncAttributeMaxDynamicSharedMemorySize, LDS_BYTES);
        hipOccupancyMaxActiveBlocksPerMultiprocessor(&per_cu, (const void*)hymba_fwd, NTHREADS, LDS_BYTES);
        if (per_cu < 1) { fprintf(stderr, "kernel_launch: occupancy query says %d blocks/CU\n", per_cu); grid = -1; return; }
        grid = cus < 256 ? cus : 256;
        (void)hipGetLastError();
    }
    if (grid < 0) return;
    hipMemsetAsync((char*)d_ws + WS_CTL, 0, CTL_BYTES, stream);
    Params p{};
    p.x = (const float*)d_in[0]; p.c = (const float*)d_in[1]; p.w_ada = (const float*)d_in[2]; p.b_ada = (const float*)d_in[3];
    p.g_mix = (const float*)d_in[4]; p.w_in = (const float*)d_in[5]; p.q_gain = (const float*)d_in[6]; p.k_gain = (const float*)d_in[7];
    p.w_out = (const float*)d_in[8]; p.g_ffn = (const float*)d_in[9]; p.w_router = (const float*)d_in[10]; p.router_bias = (const float*)d_in[11];
    p.w_gate = (const float*)d_in[12]; p.w_up = (const float*)d_in[13]; p.w_down = (const float*)d_in[14];
    p.ws_gate = (const float*)d_in[15]; p.ws_up = (const float*)d_in[16]; p.ws_down = (const float*)d_in[17];
    p.out = (float*)d_out; p.ws = (unsigned char*)d_ws;
    int np = 0;
    for (int ph = 0; ph < NPHASE; ++ph) {
        if (grid == 256 && ph == 4) { p.prog[np++] = 11; continue; }
        if (grid == 256 && (ph == 5 || ph == 6)) continue;
        p.prog[np++] = ph;
#ifdef PROBE_DUP
        if (ph == PROBE_DUP) p.prog[np++] = ph;
#endif
    }
#if MK_N_LAUNCHES == 1
    p.ph_lo = 0; p.ph_hi = np;
    hipLaunchKernelGGL(hymba_fwd, dim3(grid), dim3(NTHREADS), LDS_BYTES, stream, p);
#else
    for (int pi = 0; pi < np; ++pi) {
        p.ph_lo = pi; p.ph_hi = pi + 1;
        hipLaunchKernelGGL(hymba_fwd, dim3(grid), dim3(NTHREADS), LDS_BYTES, stream, p);
    }
#endif
}
```

```cpp
#include <hip/hip_runtime.h>
#include <stdint.h>
#include <stdio.h>

#ifndef MK_N_LAUNCHES
#define MK_N_LAUNCHES 1
#endif

#define DEVI __device__ __forceinline__
#define LAS __attribute__((address_space(3)))

typedef unsigned short bf16_t;
typedef short bf16x8 __attribute__((ext_vector_type(8)));
typedef float f32x4 __attribute__((ext_vector_type(4)));
typedef unsigned u32x4 __attribute__((ext_vector_type(4)));
typedef unsigned u32x2 __attribute__((ext_vector_type(2)));

constexpr int BATCH = 8, SEQ = 2048, DM = 1024, NTOK = BATCH * SEQ;
constexpr int INC = 3584;
constexpr int NEXP = 256, TOPK = 8, EFF = 256;
constexpr int NASSIGN = NTOK * TOPK;
constexpr int LIST_CAP = NTOK;
constexpr float EPS = 1e-6f;
constexpr int NTHREADS = 512, NWAVES = 8;
constexpr int NPHASE = 10;

constexpr int LDS_STAGE = 131072;
constexpr int LDS_MISC = LDS_STAGE;
constexpr int LDS_BYTES = LDS_STAGE + 4096 + 2048;
constexpr int LDS_ROWTAB = LDS_STAGE + 4096;
constexpr int MISC_BAR = 0, MISC_PRE = 64, MISC_SEL = 1280, MISC_KM = 1536, MISC_SCAL = 3400;

constexpr size_t al256(size_t x) { return (x + 255) & ~(size_t)255; }
constexpr size_t WS_CTL = 0;
constexpr size_t CTL_BYTES = 131072;
constexpr size_t WS_MOD = WS_CTL + CTL_BYTES;
constexpr size_t WS_ROPE = WS_MOD + al256((size_t)BATCH * 6144 * 4);
constexpr size_t WS_KMEAN = WS_ROPE + (size_t)2 * SEQ * 64 * 4;
constexpr size_t WS_WIN = WS_KMEAN + (size_t)8 * 8 * 8 * 64 * 4;
constexpr size_t WS_WOUT = WS_WIN + (size_t)INC * DM * 2;
constexpr size_t WS_WR = WS_WOUT + (size_t)DM * DM * 2;
constexpr size_t WS_WGU = WS_WR + (size_t)2 * NEXP * DM * 2;
constexpr size_t WS_WD = WS_WGU + (size_t)257 * 512 * DM * 2;
constexpr size_t WS_H1 = WS_WD + (size_t)257 * DM * 256 * 2;
constexpr size_t WS_H2LO = WS_H1 + (size_t)NTOK * DM * 2;
constexpr size_t WS_RQ = WS_H2LO + (size_t)NTOK * DM * 2;
constexpr size_t WS_RK = WS_RQ + (size_t)NTOK * 512 * 2;
constexpr size_t WS_RVT = WS_RK + (size_t)NTOK * 512 * 2;
constexpr size_t WS_RG = WS_RVT + (size_t)NTOK * 512 * 2;
constexpr size_t WS_MQ = WS_RG + (size_t)NTOK * 512 * 2;
constexpr size_t WS_MK = WS_MQ + (size_t)NTOK * 512 * 2;
constexpr size_t WS_MVT = WS_MK + (size_t)NTOK * 512 * 2;
constexpr size_t WS_MIX = WS_MVT + (size_t)NTOK * 512 * 2;
constexpr size_t WS_LOGIT = WS_MIX + (size_t)NTOK * DM * 2;
constexpr size_t WS_TOPW = WS_LOGIT + (size_t)NTOK * NEXP * 4;
constexpr size_t WS_LIST = WS_TOPW + (size_t)NASSIGN * 4;
constexpr size_t WS_Y = WS_LIST + (size_t)NEXP * LIST_CAP * 4;
constexpr size_t WS_STATS = WS_Y + (size_t)(NASSIGN + NTOK) * DM * 2;
constexpr size_t WS_END = WS_STATS + (size_t)64 * 4 * 256 * 4;

constexpr size_t WS_X1 = WS_WGU;


constexpr int CW_BAR = 0;
constexpr int CW_CNT = 4096;
constexpr int CW_QATT = 4096 + 64 * 256;
constexpr int CW_QMOE = CW_QATT + 64;
constexpr int CW_P4 = CW_QMOE + 128;

struct Params {
    const float* x; const float* c; const float* w_ada; const float* b_ada; const float* g_mix; const float* w_in;
    const float* q_gain; const float* k_gain; const float* w_out; const float* g_ffn; const float* w_router; const float* router_bias;
    const float* w_gate; const float* w_up; const float* w_down; const float* ws_gate; const float* ws_up; const float* ws_down;
    float* out; unsigned char* ws;
    int ph_lo, ph_hi;
    int prog[14];
};

DEVI unsigned pk2(float lo, float hi) { unsigned r; asm("v_cvt_pk_bf16_f32 %0, %1, %2" : "=v"(r) : "v"(lo), "v"(hi)); return r; }
DEVI float bf2f(unsigned short b) { return __uint_as_float((unsigned)b << 16); }
DEVI float bflo(unsigned u) { return __uint_as_float(u << 16); }
DEVI float bfhi(unsigned u) { return __uint_as_float(u & 0xffff0000u); }
DEVI float siluf(float v) { return v / (1.0f + __expf(-v)); }
DEVI float wave_sum(float v) {
#pragma unroll
    for (int o = 1; o < 64; o <<= 1) v += __shfl_xor(v, o);
    return v;
}
DEVI void glds16(const void* g, LAS unsigned char* l) {
    __builtin_amdgcn_global_load_lds((const __attribute__((address_space(1))) unsigned*)g, (LAS unsigned*)l, 16, 0, 0);
}
DEVI void glds16o(const void* base, unsigned off, LAS unsigned char* l) {
    __builtin_amdgcn_global_load_lds((const __attribute__((address_space(1))) unsigned*)((const __attribute__((address_space(1))) char*)base + off), (LAS unsigned*)l, 16, 0, 0);
}
DEVI bf16x8 lds128(LAS const unsigned char* p) { return *(LAS const bf16x8*)p; }
DEVI u32x2 lds64(LAS const unsigned char* p) { return *(LAS const u32x2*)p; }
#define VM_WAIT() asm volatile("s_waitcnt vmcnt(0)" ::: "memory")
DEVI const float* uniform_ptr(const float* p) {
    const unsigned long long v = (unsigned long long)p;
    const unsigned lo = __builtin_amdgcn_readfirstlane((unsigned)v), hi = __builtin_amdgcn_readfirstlane((unsigned)(v >> 32));
    return (const float*)(((unsigned long long)hi << 32) | lo);
}


#define XB_TMO      128
#define XB_XCNT(j)  (256  + 64 * (j))
#define XB_XSUB(j)  (1280 + 64 * (j))
#define XB_XGEN(j)  (2304 + 64 * (j))
#define XB_TOP      3328
#define XB_TOPGEN   3392
#define XCD_BAR_WORDS 3456
#define XB_SPIN_CAP (1u << 22)
DEVI unsigned xb_ld(unsigned* p) { return __hip_atomic_load(p, __ATOMIC_RELAXED, __HIP_MEMORY_SCOPE_AGENT); }
DEVI unsigned xb_add(unsigned* p, unsigned v) { return __hip_atomic_fetch_add(p, v, __ATOMIC_RELAXED, __HIP_MEMORY_SCOPE_AGENT); }
DEVI unsigned xb_xcc_id() { return (unsigned)__builtin_amdgcn_s_getreg((3 << 11) | 20) & 0xFu; }
#define XB_SPIN(cond, bar) do { unsigned _sp = 0; while (cond) { __builtin_amdgcn_s_sleep(1); \
    if ((++_sp & 255u) == 0u) { if (xb_ld(&(bar)[XB_TMO])) break; if (_sp > XB_SPIN_CAP) { atomicAdd(&(bar)[XB_TMO], 1u); break; } } } } while (0)
struct XcdBarrier { unsigned* bar; unsigned x; volatile LAS unsigned* st; };
DEVI XcdBarrier xcd_barrier_post(unsigned* bar, volatile LAS unsigned* st) {
    XcdBarrier b; b.bar = bar; b.x = xb_xcc_id(); b.st = st;
    if (threadIdx.x == 0) (void)xb_add(&bar[XB_XCNT(b.x)], 1u);
    return b;
}
DEVI void xcd_barrier_complete(unsigned* bar, unsigned x, unsigned& nloc, unsigned& nx) {
    const unsigned G = gridDim.x * gridDim.y * gridDim.z;
    unsigned sum, cnt, mine, sp = 0u;
    for (;;) {
        sum = 0u; cnt = 0u; mine = 0u;
#pragma unroll
        for (unsigned j = 0; j < 16; ++j) { const unsigned c = xb_ld(&bar[XB_XCNT(j)]); sum += c; cnt += (c > 0u) ? 1u : 0u; mine = (j == x) ? c : mine; }
        if (sum == G) break;
        __builtin_amdgcn_s_sleep(1);
        if ((++sp & 255u) == 0u) { if (xb_ld(&bar[XB_TMO])) break; if (sp > XB_SPIN_CAP) { atomicAdd(&bar[XB_TMO], 1u); break; } }
    }
    nloc = mine > 0u ? mine : 1u; nx = cnt > 0u ? cnt : 1u;
}
DEVI void xcd_barrier(const XcdBarrier& b) {
    asm volatile("s_waitcnt vmcnt(0)" ::: "memory");
    __syncthreads();
    if (threadIdx.x == 0) {
        unsigned* bar = b.bar;
        __builtin_amdgcn_s_waitcnt(0);
        unsigned nloc = b.st[0], nx = b.st[1];
        if (nloc == 0u) { xcd_barrier_complete(bar, b.x, nloc, nx); b.st[0] = nloc; b.st[1] = nx; }
        const unsigned old = xb_add(&bar[XB_XSUB(b.x)], 1u);
        const unsigned gen = old / nloc;
        if (old + 1u == (gen + 1u) * nloc) {
            __builtin_amdgcn_fence(__ATOMIC_RELEASE, "agent");
            asm volatile("s_waitcnt vmcnt(0)" ::: "memory");
            const unsigned og = xb_add(&bar[XB_TOP], 1u);
            const unsigned tg = og / nx;
            if (og + 1u == (tg + 1u) * nx) xb_add(&bar[XB_TOPGEN], 1u);
            else XB_SPIN(xb_ld(&bar[XB_TOPGEN]) == tg, bar);
            __builtin_amdgcn_fence(__ATOMIC_ACQUIRE, "agent");
            xb_add(&bar[XB_XGEN(b.x)], 1u);
            asm volatile("s_waitcnt vmcnt(0)" ::: "memory");
        } else {
            XB_SPIN(xb_ld(&bar[XB_XGEN(b.x)]) == gen, bar);
            __builtin_amdgcn_fence(__ATOMIC_ACQUIRE, "agent");
            asm volatile("s_waitcnt vmcnt(0)" ::: "memory");
        }
    }
    __syncthreads();
}

template <bool SWAP, int BH = 1>
DEVI void mma_step(f32x4 (&acc)[4][8], LAS const unsigned char* Ab, LAS const unsigned char* Bb, const int fr, const int fq) {
#pragma unroll
    for (int kk = 0; kk < 2; ++kk) {
        const int co = ((kk * 4 + fq) ^ (fr & 7)) * 16;
        bf16x8 a[4];
#pragma unroll
        for (int mt = 0; mt < 4; ++mt) a[mt] = lds128(Ab + mt * 2048 + co);
#pragma unroll
        for (int h = 0; h < BH; ++h) {
            constexpr int NB = 8 / BH;
            bf16x8 b[NB];
#pragma unroll
            for (int nt = 0; nt < NB; ++nt) b[nt] = lds128(Bb + (h * NB + nt) * 2048 + co);
#pragma unroll
            for (int nt = 0; nt < NB; ++nt)
#pragma unroll
                for (int mt = 0; mt < 4; ++mt) {
                    if (SWAP) acc[mt][h * NB + nt] = __builtin_amdgcn_mfma_f32_16x16x32_bf16(b[nt], a[mt], acc[mt][h * NB + nt], 0, 0, 0);
                    else acc[mt][h * NB + nt] = __builtin_amdgcn_mfma_f32_16x16x32_bf16(a[mt], b[nt], acc[mt][h * NB + nt], 0, 0, 0);
                }
            __builtin_amdgcn_sched_barrier(0);
        }
    }
}

template <int NSEG, bool SWAP = true>
DEVI void gemm_tile(f32x4 (&acc)[4][8], LAS unsigned char* lds, const bf16_t* A0, const bf16_t* A1, const bf16_t* A2,
                    const bf16_t* B0, const bf16_t* B1, const bf16_t* B2,
                    const int (&aoff)[4], const int (&boff)[4], const int K, const int tid, const int nra = 4) {
    const int w = tid >> 6, lane = tid & 63, fr = lane & 15, fq = lane >> 4, wm = w >> 1, wn = w & 1;
    const int lch = ((tid & 7) ^ ((tid >> 3) & 7)) * 8;
    const int kper = K >> 6;
#pragma unroll
    for (int mt = 0; mt < 4; ++mt)
#pragma unroll
        for (int nt = 0; nt < 8; ++nt) acc[mt][nt] = (f32x4){0.f, 0.f, 0.f, 0.f};
    auto stage = [&](int buf, const bf16_t* Ab, const bf16_t* Bb, int ks) {
        const int k0 = ks * 64 + lch;
        LAS unsigned char* base = lds + buf * 65536 + tid * 16;
#pragma unroll
        for (int i = 0; i < 4; ++i) if (i < nra) glds16o(Ab, (unsigned)(aoff[i] + k0) * 2u, base + i * 8192);
#pragma unroll
        for (int i = 0; i < 4; ++i) glds16o(Bb, (unsigned)(boff[i] + k0) * 2u, base + 32768 + i * 8192);
    };
    stage(0, A0, B0, 0);
    int buf = 0;
#pragma unroll
    for (int seg = 0; seg < NSEG; ++seg) {
        const bf16_t* Ac = (seg == 0) ? A0 : (seg == 1) ? A1 : A2;
        const bf16_t* Bc = (seg == 0) ? B0 : (seg == 1) ? B1 : B2;
        const bf16_t* An = (seg == 0) ? A1 : A2;
        const bf16_t* Bn = (seg == 0) ? B1 : B2;
#pragma unroll 1
        for (int ks = 0; ks < kper; ++ks) {
            VM_WAIT();
            __syncthreads();
            if (ks + 1 < kper) stage(buf ^ 1, Ac, Bc, ks + 1);
            else if (seg + 1 < NSEG) stage(buf ^ 1, An, Bn, 0);
            if (wm < nra) mma_step<SWAP>(acc, lds + buf * 65536 + (64 * wm + fr) * 128, lds + buf * 65536 + 32768 + (128 * wn + fr) * 128, fr, fq);
            buf ^= 1;
        }
    }
}

DEVI void wf32_load_b(f32x4 (&breg)[8], const float* wbase_in, const int ldb, const int ks, const int t) {
    const float* wbase = uniform_ptr(wbase_in);
    const unsigned toff = (unsigned)((8 * (t & 7)) * ldb + 4 * ((t >> 3) & 7)) * 4u;
    const float* s = wbase + (size_t)(ks * 64) * ldb;
#pragma unroll
    for (int i = 0; i < 8; ++i) breg[i] = *(const __attribute__((address_space(1))) f32x4*)((const __attribute__((address_space(1))) char*)(s + (size_t)i * ldb) + toff);
}
DEVI void gemm_tile_wf32(f32x4 (&acc)[4][8], f32x4 (&breg)[8], LAS unsigned char* lds, const bf16_t* A0, const float* wbase_in, const int ldb,
                         const float* nbase, const int nldb, const int (&aoff)[4], const int K, int& tid) {
    const int kper = K >> 6;
#pragma unroll
    for (int mt = 0; mt < 4; ++mt)
#pragma unroll
        for (int nt = 0; nt < 8; ++nt) acc[mt][nt] = (f32x4){0.f, 0.f, 0.f, 0.f};
    auto stage_a = [&](int buf, int ks, int t) {
        const int lch = ((t & 7) ^ ((t >> 3) & 7)) * 8;
        const int k0 = ks * 64 + lch;
        LAS unsigned char* base = lds + buf * 65536 + t * 16;
#pragma unroll
        for (int i = 0; i < 4; ++i) glds16o(A0, (unsigned)(aoff[i] + k0) * 2u, base + i * 8192);
    };
    auto write_b = [&](int buf, int t) {
        const int kg = t & 7, n4 = t >> 3;
        LAS unsigned char* base = lds + buf * 65536 + 32768 + (4 * n4) * 128;
#pragma unroll
        for (int j = 0; j < 4; ++j) {
            u32x4 o;
            o.x = pk2(breg[0][j], breg[1][j]); o.y = pk2(breg[2][j], breg[3][j]); o.z = pk2(breg[4][j], breg[5][j]); o.w = pk2(breg[6][j], breg[7][j]);
            *(LAS u32x4*)(base + j * 128 + ((kg ^ ((4 * n4 + j) & 7)) * 16)) = o;
        }
    };
    stage_a(0, 0, tid);
    write_b(0, tid);
    wf32_load_b(breg, (kper > 1) ? wbase_in : nbase, (kper > 1) ? ldb : nldb, (kper > 1) ? 1 : 0, tid);
    int buf = 0;
#pragma unroll 1
    for (int ks = 0; ks < kper; ++ks) {
        asm volatile("" : "+v"(tid));
        asm volatile("s_waitcnt vmcnt(8)" ::: "memory");
        asm volatile("s_waitcnt lgkmcnt(0)" ::: "memory");
        __builtin_amdgcn_s_barrier();
        asm volatile("" ::: "memory");
        const bool more = ks + 1 < kper;
        if (more) stage_a(buf ^ 1, ks + 1, tid);
        {
            const int w = tid >> 6, lane = tid & 63, fr = lane & 15, fq = lane >> 4, wm = w >> 1, wn = w & 1;
            mma_step<true, 2>(acc, lds + buf * 65536 + (64 * wm + fr) * 128, lds + buf * 65536 + 32768 + (128 * wn + fr) * 128, fr, fq);
        }
        if (more) {
            write_b(buf ^ 1, tid);
            const bool more2 = ks + 2 < kper;
            wf32_load_b(breg, more2 ? wbase_in : nbase, more2 ? ldb : nldb, more2 ? ks + 2 : 0, tid);
        }
        buf ^= 1;
    }
}

constexpr int EPI_RS = 272, EPI_WAVE = 32 * EPI_RS;
DEVI void epi_transpose(LAS unsigned char* wl, const u32x2 (&pk)[2][8], u32x4 (&rows8)[8], const int lane) {
    const int fr = lane & 15, fq = lane >> 4;
#pragma unroll
    for (int m2 = 0; m2 < 2; ++m2)
#pragma unroll
        for (int nt = 0; nt < 8; ++nt) *(LAS u32x2*)(wl + (16 * m2 + fr) * EPI_RS + (16 * nt + 4 * fq) * 2) = pk[m2][nt];
    asm volatile("s_waitcnt lgkmcnt(0)" ::: "memory");
#pragma unroll
    for (int j = 0; j < 8; ++j) rows8[j] = *(LAS const u32x4*)(wl + (4 * j + fq) * EPI_RS + fr * 16);
    asm volatile("s_waitcnt lgkmcnt(0)" ::: "memory");
}

constexpr int EPV_RS = 144, EPV_WAVE = 64 * EPV_RS;
DEVI void epi_transpose_vt(LAS unsigned char* wl, const u32x2 (&pk)[4][4], u32x4 (&rows8)[8], const int lane) {
    const int fr = lane & 15, fq = lane >> 4;
#pragma unroll
    for (int mt = 0; mt < 4; ++mt)
#pragma unroll
        for (int n4 = 0; n4 < 4; ++n4) *(LAS u32x2*)(wl + (16 * n4 + fr) * EPV_RS + (32 * (mt >> 1) + 8 * fq + 4 * (mt & 1)) * 2) = pk[mt][n4];
    asm volatile("s_waitcnt lgkmcnt(0)" ::: "memory");
#pragma unroll
    for (int j = 0; j < 8; ++j) rows8[j] = *(LAS const u32x4*)(wl + (8 * j + (lane >> 3)) * EPV_RS + (lane & 7) * 16);
    asm volatile("s_waitcnt lgkmcnt(0)" ::: "memory");
}
constexpr int EPF_RS = 528, EPF_WAVE = 16 * EPF_RS;
DEVI void epi_transpose_f32(LAS unsigned char* wl, const f32x4 (&v)[8], f32x4 (&o)[8], const int lane) {
    const int fr = lane & 15, fq = lane >> 4;
#pragma unroll
    for (int nt = 0; nt < 8; ++nt) *(LAS f32x4*)(wl + fr * EPF_RS + (16 * nt + 4 * fq) * 4) = v[nt];
    asm volatile("s_waitcnt lgkmcnt(0)" ::: "memory");
#pragma unroll
    for (int j = 0; j < 8; ++j) o[j] = *(LAS const f32x4*)(wl + (2 * j + (lane >> 5)) * EPF_RS + (lane & 31) * 16);
    asm volatile("s_waitcnt lgkmcnt(0)" ::: "memory");
}

DEVI void transpose_item(const float* W, int N, int k0, int n0, bf16_t* dst_row0  , bf16_t* dst_lo_row0, int K, LAS float* scr, int lane) {
#pragma unroll 8
    for (int i = 0; i < 32; ++i) { const int kk = 2 * i + (lane >> 5); scr[kk * 33 + (lane & 31)] = W[(size_t)(k0 + kk) * N + n0 + (lane & 31)]; }
    asm volatile("s_waitcnt lgkmcnt(0)" ::: "memory");
    const int c = lane & 7;
#pragma unroll
    for (int j = 0; j < 4; ++j) {
        const int n = (lane >> 3) + 8 * j; const LAS float* s = scr + (8 * c) * 33 + n;
        float v[8];
#pragma unroll
        for (int q = 0; q < 8; ++q) v[q] = s[q * 33];
        unsigned ow[4];
#pragma unroll
        for (int q = 0; q < 4; ++q) ow[q] = pk2(v[2 * q], v[2 * q + 1]);
        u32x4 o; o.x = ow[0]; o.y = ow[1]; o.z = ow[2]; o.w = ow[3];
        *(u32x4*)(dst_row0 + (size_t)n * K + k0 + 8 * c) = o;
        if (dst_lo_row0) {
            unsigned lw[4];
#pragma unroll
            for (int q = 0; q < 4; ++q) lw[q] = pk2(v[2 * q] - bflo(ow[q]), v[2 * q + 1] - bfhi(ow[q]));
            u32x4 ol; ol.x = lw[0]; ol.y = lw[1]; ol.z = lw[2]; ol.w = lw[3];
            *(u32x4*)(dst_lo_row0 + (size_t)n * K + k0 + 8 * c) = ol;
        }
    }
    asm volatile("s_waitcnt lgkmcnt(0)" ::: "memory");
}

DEVI void phase0(const Params& p, LAS unsigned char* lds, int tid, int vcu, int G) {
    unsigned char* ws = p.ws;
    const int w = tid >> 6, lane = tid & 63;
    {
        LAS float* sc = (LAS float*)lds;
        LAS float* red = (LAS float*)(lds + 32768);
        float* mod = (float*)(ws + WS_MOD);
        for (int item = vcu; item < 192; item += G) {
            for (int i = tid; i < BATCH * DM; i += NTHREADS) sc[i] = siluf(p.c[i]);
            __syncthreads();
            const int cc = tid & 31, g = tid >> 5, col = item * 32 + cc;
            float a[8];
#pragma unroll
            for (int b = 0; b < 8; ++b) a[b] = 0.f;
            const float* wp = p.w_ada + (size_t)(g * 64) * 6144 + col;
#pragma unroll 1
            for (int k0 = 0; k0 < 64; k0 += 16) {
                float wv[16];
#pragma unroll
                for (int i = 0; i < 16; ++i) wv[i] = wp[(size_t)(k0 + i) * 6144];
#pragma unroll
                for (int i = 0; i < 16; ++i)
#pragma unroll
                    for (int b = 0; b < 8; ++b) a[b] += sc[b * DM + g * 64 + k0 + i] * wv[i];
            }
#pragma unroll
            for (int b = 0; b < 8; ++b) red[(g * 8 + b) * 32 + cc] = a[b];
            __syncthreads();
            if (tid < 256) {
                const int b = tid >> 5, c2 = tid & 31;
                float s = 0.f;
#pragma unroll
                for (int gg = 0; gg < 16; ++gg) s += red[(gg * 8 + b) * 32 + c2];
                mod[b * 6144 + item * 32 + c2] = s + p.b_ada[item * 32 + c2];
            }
            __syncthreads();
        }
    }
    {
        float* kmz = (float*)(ws + WS_KMEAN);
        for (int i = vcu * NTHREADS + tid; i < 8 * 8 * 8 * 64; i += G * NTHREADS) kmz[i] = 0.f;
        float* cosT = (float*)(ws + WS_ROPE); float* sinT = cosT + SEQ * 64;
        for (int i = vcu * NTHREADS + tid; i < SEQ * 64; i += G * NTHREADS) {
            const int pos = i >> 6, j = i & 63;
            const float inv = powf(10000.0f, -(float)j / 64.0f);
            const float ang = (float)pos * inv;
            cosT[i] = cosf(ang); sinT[i] = sinf(ang);
        }
    }
    {
        LAS float* scr = (LAS float*)(lds + w * 8448);
        const int gw = vcu * NWAVES + w, NGW = G * NWAVES;
        constexpr int I_IN = 16 * (INC / 32), I_OUT = 16 * 32, I_R = 16 * 8;
        constexpr int I_TOTAL = I_IN + I_OUT + I_R;
        bf16_t* win = (bf16_t*)(ws + WS_WIN); bf16_t* wout = (bf16_t*)(ws + WS_WOUT); bf16_t* wr = (bf16_t*)(ws + WS_WR);
        for (int it = gw; it < I_TOTAL; it += NGW) {
            int r = it;
            if (r < I_IN) { const int nb = INC / 32, kb = r / nb, n0 = (r % nb) * 32; transpose_item(p.w_in, INC, kb * 64, n0, win + (size_t)n0 * DM, nullptr, DM, scr, lane); continue; } r -= I_IN;
            if (r < I_OUT) { const int kb = r / 32, n0 = (r % 32) * 32; transpose_item(p.w_out, DM, kb * 64, n0, wout + (size_t)n0 * DM, nullptr, DM, scr, lane); continue; } r -= I_OUT;
            { const int kb = r / 8, n0 = (r % 8) * 32; transpose_item(p.w_router, NEXP, kb * 64, n0, wr + (size_t)n0 * DM, wr + (size_t)(NEXP + n0) * DM, DM, scr, lane); }
        }
    }
}

template <bool LO>
DEVI void rownorm_phase(const float* X, const float* g, const float* mod, int sh_off, int sc_off, bf16_t* Hhi, bf16_t* Hlo, int tid, int vcu, int G) {
    const int w = tid >> 6, lane = tid & 63;
    const int gw = vcu * NWAVES + w, NGW = G * NWAVES;
    for (int row = gw; row < NTOK; row += NGW) {
        const int b = row >> 11;
        const f32x4* xr = (const f32x4*)(X + (size_t)row * DM) + lane;
        f32x4 v[4]; float s = 0.f;
#pragma unroll
        for (int j = 0; j < 4; ++j) { v[j] = xr[64 * j]; s += (v[j].x * v[j].x + v[j].y * v[j].y) + (v[j].z * v[j].z + v[j].w * v[j].w); }
        const float rstd = rsqrtf(wave_sum(s) * (1.0f / DM) + EPS);
#pragma unroll
        for (int j = 0; j < 4; ++j) {
            const int col = 4 * lane + 256 * j;
            const f32x4 gg = *(const f32x4*)(g + col);
            const f32x4 sc = *(const f32x4*)(mod + b * 6144 + sc_off + col);
            const f32x4 sh = *(const f32x4*)(mod + b * 6144 + sh_off + col);
            f32x4 h = v[j] * rstd * gg * (sc + 1.0f) + sh;
            u32x2 o; o.x = pk2(h.x, h.y); o.y = pk2(h.z, h.w);
            *(u32x2*)(Hhi + (size_t)row * DM + col) = o;
            if (LO) {
                u32x2 ol; ol.x = pk2(h.x - bflo(o.x), h.y - bfhi(o.x)); ol.y = pk2(h.z - bflo(o.y), h.w - bfhi(o.y));
                *(u32x2*)(Hlo + (size_t)row * DM + col) = ol;
            }
        }
    }
}

DEVI void phase2(const Params& p, LAS unsigned char* lds, int tid, int vcu, int G) {
    unsigned char* ws = p.ws;
    const bf16_t* H = (const bf16_t*)(ws + WS_H1); const bf16_t* WT = (const bf16_t*)(ws + WS_WIN);
    const float* cosT = (const float*)(ws + WS_ROPE); const float* sinT = cosT + SEQ * 64;
    for (int it = vcu; it < 768 + 256; it += G) {
        asm volatile("" : "+v"(tid));
        const int w = tid >> 6, lane = tid & 63, fr = lane & 15, fq = lane >> 4;
        const bool halfm = it >= 768;
        const int id = halfm ? 768 + ((it - 768) >> 1) : it, rh = halfm ? ((it - 768) & 1) : 0, nra = halfm ? 2 : 4;
        const int pm = id / 14, pn = id % 14;
        int aoff[4], boff[4];
#pragma unroll
        for (int i = 0; i < 4; ++i) { aoff[i] = (pm * 256 + 128 * rh + (i & (nra - 1)) * 64 + (tid >> 3)) * DM; boff[i] = (pn * 256 + i * 64 + (tid >> 3)) * DM; }
        f32x4 acc[4][8];
        const int cat = pn >> 1, half = pn & 1;
        const int wm = w >> 1, wn = w & 1;
        const bool wact = wm < nra;
        if (cat == 2 || cat == 6) gemm_tile<1, false>(acc, lds, H, H, H, WT, WT, WT, aoff, boff, DM, tid, nra);
        else gemm_tile<1, true>(acc, lds, H, H, H, WT, WT, WT, aoff, boff, DM, tid, nra);
        const int b = pm >> 3, s0 = (pm & 7) * 256 + 128 * rh + 64 * wm;
        const bool isk = (cat == 5);
        LAS float* red = (LAS float*)(lds + 98304);
        __syncthreads();
        if (!wact) {
        } else if (cat == 2 || cat == 6) {
            bf16_t* dst = (bf16_t*)(ws + (cat == 2 ? WS_RVT : WS_MVT));
            LAS unsigned char* wl = lds + w * EPV_WAVE;
#pragma unroll
            for (int hf = 0; hf < 2; ++hf) {
                u32x2 pk[4][4];
#pragma unroll
                for (int mt = 0; mt < 4; ++mt)
#pragma unroll
                    for (int n4 = 0; n4 < 4; ++n4) { const f32x4 v = acc[mt][4 * hf + n4]; pk[mt][n4].x = pk2(v.x, v.y); pk[mt][n4].y = pk2(v.z, v.w); }
                u32x4 rows8[8];
                epi_transpose_vt(wl, pk, rows8, lane);
                const size_t rowbase = (size_t)b * 512 + 256 * half + 128 * wn + 64 * hf + (lane >> 3);
#pragma unroll
                for (int j = 0; j < 8; ++j) *(u32x4*)(dst + (rowbase + 8 * j) * SEQ + s0 + 8 * (lane & 7)) = rows8[j];
            }
        } else {
            LAS unsigned char* wl = lds + w * EPI_WAVE;
            const float* gain = isk ? p.k_gain : p.q_gain;
#pragma unroll
            for (int hf = 0; hf < 2; ++hf) {
                u32x2 pk[2][8];
                if (cat <= 1) {
                    const float lgh = log2f(1.0f - exp2f(-5.0f - (float)(2 * half + wn)));
                    const float sclb = (cat == 1) ? 0.08838834764831845f : 1.0f, lgs = (cat == 1) ? -lgh : lgh;
#pragma unroll
                    for (int m2 = 0; m2 < 2; ++m2) {
                        const int s = s0 + 32 * hf + 16 * m2 + fr;
                        const float scl = sclb * exp2f(lgs * (float)(s - 1024));
#pragma unroll
                        for (int np = 0; np < 4; ++np) {
                            const f32x4 cs = *(const f32x4*)(cosT + s * 64 + 16 * np + 4 * fq) * scl;
                            const f32x4 sn = *(const f32x4*)(sinT + s * 64 + 16 * np + 4 * fq) * scl;
                            const f32x4 x1 = acc[2 * hf + m2][np], x2 = acc[2 * hf + m2][np + 4];
                            const f32x4 o1 = x1 * cs - x2 * sn, o2 = x1 * sn + x2 * cs;
                            pk[m2][np].x = pk2(o1.x, o1.y); pk[m2][np].y = pk2(o1.z, o1.w);
                            pk[m2][np + 4].x = pk2(o2.x, o2.y); pk[m2][np + 4].y = pk2(o2.z, o2.w);
                        }
                    }
                } else if (cat == 3) {
#pragma unroll
                    for (int m2 = 0; m2 < 2; ++m2)
#pragma unroll
                        for (int nt = 0; nt < 8; ++nt) { const f32x4 v = acc[2 * hf + m2][nt]; pk[m2][nt].x = pk2(siluf(v.x), siluf(v.y)); pk[m2][nt].y = pk2(siluf(v.z), siluf(v.w)); }
                } else {
#pragma unroll
                    for (int hh = 0; hh < 2; ++hh) {
                        float rstd[2];
#pragma unroll
                        for (int m2 = 0; m2 < 2; ++m2) {
                            float ss = 0.f;
#pragma unroll
                            for (int np = 0; np < 4; ++np) { const f32x4 v = acc[2 * hf + m2][4 * hh + np]; ss += (v.x * v.x + v.y * v.y) + (v.z * v.z + v.w * v.w); }
                            ss += __shfl_xor(ss, 16); ss += __shfl_xor(ss, 32);
                            rstd[m2] = rsqrtf(ss * (1.0f / 64.0f) + EPS);
                        }
#pragma unroll
                        for (int np = 0; np < 4; ++np) {
                            const f32x4 gn = *(const f32x4*)(gain + 16 * np + 4 * fq) * (isk ? 1.0f : 0.125f * 1.4426950408889634f);
                            f32x4 cs = (f32x4){0.f, 0.f, 0.f, 0.f};
#pragma unroll
                            for (int m2 = 0; m2 < 2; ++m2) {
                                const f32x4 v = acc[2 * hf + m2][4 * hh + np] * rstd[m2] * gn;
                                cs += v;
                                pk[m2][4 * hh + np].x = pk2(v.x, v.y); pk[m2][4 * hh + np].y = pk2(v.z, v.w);
                            }
                            if (isk) {
#pragma unroll
                                for (int r = 0; r < 4; ++r) {
                                    float v = cs[r];
                                    v += __shfl_xor(v, 1); v += __shfl_xor(v, 2); v += __shfl_xor(v, 4); v += __shfl_xor(v, 8);
                                    if (fr == 0) { LAS float* rp = red + wm * 256 + 128 * wn + 64 * hh + 16 * np + 4 * fq + r; if (hf == 0) *rp = v; else *rp += v; }
                                }
                            }
                        }
                    }
                }
                u32x4 rows8[8];
                epi_transpose(wl, pk, rows8, lane);
#pragma unroll
                for (int j = 0; j < 8; ++j) {
                    const int s = s0 + 32 * hf + 4 * j + fq;
                    bf16_t* d;
                    if (cat <= 1) d = (bf16_t*)(ws + (cat == 0 ? WS_RQ : WS_RK)) + ((size_t)((b * 4 + 2 * half + wn) * SEQ + s)) * 128 + 8 * fr;
                    else if (cat == 3) d = (bf16_t*)(ws + WS_RG) + ((size_t)b * SEQ + s) * 512 + 256 * half + 128 * wn + 8 * fr;
                    else d = (bf16_t*)(ws + (isk ? WS_MK : WS_MQ)) + ((size_t)((b * 8 + 4 * half + 2 * wn + (fr >> 3)) * SEQ + s)) * 64 + 8 * (fr & 7);
                    *(u32x4*)d = rows8[j];
                }
            }
        }
        if (isk) {
            __syncthreads();
            if (tid < 256) {
                float* km = (float*)(ws + WS_KMEAN) + ((size_t)((b * 8 + 4 * half + (tid >> 6)) * 8 + (pm & 7))) * 64 + (tid & 63);
                if (halfm) atomicAdd(km, (red[tid] + red[256 + tid]) * (1.0f / 256.0f));
                else *km = ((red[tid] + red[256 + tid]) + (red[512 + tid] + red[768 + tid])) * (1.0f / 256.0f);
            }
        }
        __syncthreads();
    }
}

template <int D, bool MOBA>
DEVI void attn_unit(const Params& p, LAS unsigned char* lds, int b, int h, int qb, int tid) {
    unsigned char* ws = p.ws;
    constexpr int H = MOBA ? 8 : 4, KK = D / 32, DT = D / 16, RB = D * 2, TILE = 64 * RB, MASK = (D == 64) ? 7 : 15, ROUNDS = TILE / 8192;
    const int w = tid >> 6, lane = tid & 63, fr = lane & 15, fq = lane >> 4;
    const bf16_t* Q = (const bf16_t*)(ws + (MOBA ? WS_MQ : WS_RQ));
    const bf16_t* Kp = (const bf16_t*)(ws + (MOBA ? WS_MK : WS_RK));
    const bf16_t* VT = (const bf16_t*)(ws + (MOBA ? WS_MVT : WS_RVT));
    const size_t qk_base = (size_t)(b * H + h) * SEQ * D, vt_base = (size_t)(b * H + h) * D * SEQ;
    const int q0 = qb * 256 + 32 * w;
    LAS unsigned char* misc = lds + LDS_MISC;
    unsigned selm[2] = {0u, 0u};
    if (MOBA) {
        LAS float* km = (LAS float*)(misc + MISC_KM);
        LAS unsigned char* sel = misc + MISC_SEL;
        const float* kmg = (const float*)(ws + WS_KMEAN) + (size_t)((b * 8 + h) * 8) * 64;
        if (tid < 448 && (tid >> 6) < qb) km[tid] = kmg[tid];
        __syncthreads();
        if (tid < 256) {
            unsigned m = 0u;
            if (qb <= 3) m = (1u << qb) - 1u;
            else {
                float t0 = -INFINITY, t1 = -INFINITY, t2 = -INFINITY; int i0 = 0, i1 = 0, i2 = 0;
                const u32x4* qr = (const u32x4*)(Q + qk_base + (size_t)(qb * 256 + tid) * 64);
                u32x4 qv[8];
#pragma unroll
                for (int c = 0; c < 8; ++c) qv[c] = qr[c];
#pragma unroll 1
                for (int kb = 0; kb < qb; ++kb) {
                    const LAS f32x4* kr = (const LAS f32x4*)(km + kb * 64);
                    float g = 0.f;
#pragma unroll
                    for (int c = 0; c < 8; ++c) {
                        const f32x4 k0 = kr[2 * c], k1 = kr[2 * c + 1];
                        g += bflo(qv[c].x) * k0.x + bfhi(qv[c].x) * k0.y + bflo(qv[c].y) * k0.z + bfhi(qv[c].y) * k0.w
                           + bflo(qv[c].z) * k1.x + bfhi(qv[c].z) * k1.y + bflo(qv[c].w) * k1.z + bfhi(qv[c].w) * k1.w;
                    }
                    if (g > t0) { t2 = t1; i2 = i1; t1 = t0; i1 = i0; t0 = g; i0 = kb; }
                    else if (g > t1) { t2 = t1; i2 = i1; t1 = g; i1 = kb; }
                    else if (g > t2) { t2 = g; i2 = kb; }
                }
                m = (1u << i0) | (1u << i1) | (1u << i2);
            }
            sel[tid] = (unsigned char)m;
        }
        __syncthreads();
        selm[0] = sel[32 * w + fr]; selm[1] = sel[32 * w + 16 + fr];
    }
    bf16x8 qf[2][KK];
#pragma unroll
    for (int qt = 0; qt < 2; ++qt)
#pragma unroll
        for (int kk = 0; kk < KK; ++kk) qf[qt][kk] = *(const bf16x8*)(Q + qk_base + (size_t)(q0 + 16 * qt + fr) * D + kk * 32 + fq * 8);
    f32x4 o[DT][2];
#pragma unroll
    for (int dt = 0; dt < DT; ++dt) { o[dt][0] = (f32x4){0.f, 0.f, 0.f, 0.f}; o[dt][1] = (f32x4){0.f, 0.f, 0.f, 0.f}; }
    float mrun[2] = {-INFINITY, -INFINITY}, lrun[2] = {0.f, 0.f};
    float mfix = 0.f; bool usefix = false;
    if (MOBA) {
        float gq = fabsf(p.q_gain[lane]), gk = fabsf(p.k_gain[lane]);
#pragma unroll
        for (int o = 1; o < 64; o <<= 1) { gq = fmaxf(gq, __shfl_xor(gq, o)); gk = fmaxf(gk, __shfl_xor(gk, o)); }
        const float smax = 8.0f * gq * gk * 1.02f;
        mfix = smax * 1.4426950408889634f;
        usefix = __builtin_amdgcn_readfirstlane((int)(smax < 40.0f)) != 0;
    }
    const int ntiles = 4 * (qb + 1);
    auto tile_ks = [&](int i) -> int {
        if (MOBA) { const int kb = (i < 4) ? qb : ((i - 4) >> 2); return kb * 256 + (i & 3) * 64; }
        return i * 64;
    };
    auto stage = [&](int buf, int i) {
        const int ks = tile_ks(i);
        LAS unsigned char* base = lds + buf * (2 * TILE);
#pragma unroll
        for (int r = 0; r < ROUNDS; ++r) {
            int row, lchunk;
            if (D == 64) { row = tid >> 3; lchunk = (tid & 7) ^ (row & 7); }
            else { row = r * 32 + (tid >> 4); lchunk = (tid & 15) ^ (row & 15); }
            glds16(Kp + qk_base + (size_t)(ks + row) * D + lchunk * 8, base + r * 8192 + tid * 16);
            const int d = r * 64 + (tid >> 3), lc2 = (tid & 7) ^ ((d >> 1) & 7);
            glds16(VT + vt_base + (size_t)d * SEQ + ks + lc2 * 8, base + TILE + r * 8192 + tid * 16);
        }
    };
    stage(0, 0); stage(1, 1);
    const int npairs = ntiles >> 1;
    for (int jp = 0; jp < npairs; ++jp) {
        VM_WAIT();
        __syncthreads();
        if (jp + 1 < npairs) { stage(((jp + 1) & 1) * 2, 2 * jp + 2); stage(((jp + 1) & 1) * 2 + 1, 2 * jp + 3); }
#pragma unroll 1
      for (int hp = 0; hp < 2; ++hp) {
        const int i = 2 * jp + hp;
        const int ks = tile_ks(i);
        const int kb = ks >> 8;
        const bool own = (kb == qb);
        if (ks > q0 + 31) continue;
        LAS const unsigned char* Kb = lds + ((jp & 1) * 2 + hp) * (2 * TILE);
        LAS const unsigned char* Vb = Kb + TILE;
        float bi0 = 0.f, bi1 = 0.f;
        if (MOBA) {
            const float bsel = usefix ? -mfix : 0.f;
            bi0 = (own || ((selm[0] >> kb) & 1u)) ? bsel : -1.0e30f;
            bi1 = (own || ((selm[1] >> kb) & 1u)) ? bsel : -1.0e30f;
        }
        f32x4 s[2][4];
#pragma unroll
        for (int kt = 0; kt < 4; ++kt) {
            s[0][kt] = (f32x4){bi0, bi0, bi0, bi0}; s[1][kt] = (f32x4){bi1, bi1, bi1, bi1};
#pragma unroll
            for (int kk = 0; kk < KK; ++kk) {
                const bf16x8 kf = lds128(Kb + (16 * kt + fr) * RB + (((kk * 4 + fq) ^ (fr & MASK)) * 16));
                s[0][kt] = __builtin_amdgcn_mfma_f32_16x16x32_bf16(kf, qf[0][kk], s[0][kt], 0, 0, 0);
                s[1][kt] = __builtin_amdgcn_mfma_f32_16x16x32_bf16(kf, qf[1][kk], s[1][kt], 0, 0, 0);
            }
        }
        unsigned pw[2][2][4];
        if (MOBA) {
            const bool diag = own && (ks + 63 > q0);
            if (usefix) {
#pragma unroll
                for (int qt = 0; qt < 2; ++qt) {
                    const int qpos = q0 + 16 * qt + fr;
                    float ls = 0.f;
                    if (diag) {
#pragma unroll
                        for (int kt = 0; kt < 4; ++kt) {
                            float pv[4];
#pragma unroll
                            for (int r = 0; r < 4; ++r) { pv[r] = __builtin_amdgcn_exp2f((ks + 16 * kt + 4 * fq + r <= qpos) ? s[qt][kt][r] : -INFINITY); ls += pv[r]; }
                            pw[qt][kt >> 1][(kt & 1) * 2 + 0] = pk2(pv[0], pv[1]);
                            pw[qt][kt >> 1][(kt & 1) * 2 + 1] = pk2(pv[2], pv[3]);
                        }
                    } else {
#pragma unroll
                        for (int kt = 0; kt < 4; ++kt) {
                            float pv[4];
#pragma unroll
                            for (int r = 0; r < 4; ++r) { pv[r] = __builtin_amdgcn_exp2f(s[qt][kt][r]); ls += pv[r]; }
                            pw[qt][kt >> 1][(kt & 1) * 2 + 0] = pk2(pv[0], pv[1]);
                            pw[qt][kt >> 1][(kt & 1) * 2 + 1] = pk2(pv[2], pv[3]);
                        }
                    }
                    lrun[qt] += ls;
                }
            } else
#pragma unroll
            for (int qt = 0; qt < 2; ++qt) {
                const int qpos = q0 + 16 * qt + fr;
                float sv[4][4]; float mx = -INFINITY;
                if (diag) {
#pragma unroll
                    for (int kt = 0; kt < 4; ++kt)
#pragma unroll
                        for (int r = 0; r < 4; ++r) {
                            const int kpos = ks + 16 * kt + 4 * fq + r;
                            sv[kt][r] = (kpos <= qpos) ? s[qt][kt][r] : -INFINITY;
                            mx = fmaxf(mx, sv[kt][r]);
                        }
                } else {
#pragma unroll
                    for (int kt = 0; kt < 4; ++kt)
#pragma unroll
                        for (int r = 0; r < 4; ++r) { sv[kt][r] = s[qt][kt][r]; mx = fmaxf(mx, sv[kt][r]); }
                }
                mx = fmaxf(mx, __shfl_xor(mx, 16)); mx = fmaxf(mx, __shfl_xor(mx, 32));
                const float mnew = fmaxf(mrun[qt], mx);
                const float msub = (mnew == -INFINITY) ? 0.f : mnew;
                if (__builtin_amdgcn_ballot_w64(mnew != mrun[qt]) != 0ull) {
                    const float alpha = (mnew == -INFINITY) ? 1.0f : __builtin_amdgcn_exp2f(mrun[qt] - mnew);
                    lrun[qt] *= alpha;
#pragma unroll
                    for (int dt = 0; dt < DT; ++dt) o[dt][qt] *= alpha;
                }
                mrun[qt] = mnew;
                float ls = 0.f;
#pragma unroll
                for (int kt = 0; kt < 4; ++kt) {
                    float pv[4];
#pragma unroll
                    for (int r = 0; r < 4; ++r) { pv[r] = __builtin_amdgcn_exp2f(sv[kt][r] - msub); ls += pv[r]; }
                    pw[qt][kt >> 1][(kt & 1) * 2 + 0] = pk2(pv[0], pv[1]);
                    pw[qt][kt >> 1][(kt & 1) * 2 + 1] = pk2(pv[2], pv[3]);
                }
                lrun[qt] += ls;
            }
        } else {
#pragma unroll
            for (int qt = 0; qt < 2; ++qt) {
                const int qpos = q0 + 16 * qt + fr;
#pragma unroll
                for (int kt = 0; kt < 4; ++kt) {
                    float pv[4];
#pragma unroll
                    for (int r = 0; r < 4; ++r) {
                        const int kpos = ks + 16 * kt + 4 * fq + r;
                        pv[r] = (kpos <= qpos) ? s[qt][kt][r] : 0.f;
                    }
                    pw[qt][kt >> 1][(kt & 1) * 2 + 0] = pk2(pv[0], pv[1]);
                    pw[qt][kt >> 1][(kt & 1) * 2 + 1] = pk2(pv[2], pv[3]);
                }
            }
        }
#pragma unroll
        for (int sh = 0; sh < 2; ++sh) {
            bf16x8 pb[2];
#pragma unroll
            for (int qt = 0; qt < 2; ++qt) { u32x4 t; t.x = pw[qt][sh][0]; t.y = pw[qt][sh][1]; t.z = pw[qt][sh][2]; t.w = pw[qt][sh][3]; pb[qt] = __builtin_bit_cast(bf16x8, t); }
#pragma unroll
            for (int dt = 0; dt < DT; ++dt) {
                const bf16x8 vf = lds128(Vb + (16 * dt + fr) * 128 + (((4 * sh + fq) ^ ((fr >> 1) & 7)) * 16));
                o[dt][0] = __builtin_amdgcn_mfma_f32_16x16x32_bf16(vf, pb[0], o[dt][0], 0, 0, 0);
                o[dt][1] = __builtin_amdgcn_mfma_f32_16x16x32_bf16(vf, pb[1], o[dt][1], 0, 0, 0);
            }
        }
      }
    }
    bf16_t* mix = (bf16_t*)(ws + WS_MIX);
#pragma unroll
    for (int qt = 0; qt < 2; ++qt) {
        const size_t tok = (size_t)b * SEQ + q0 + 16 * qt + fr;
        if (MOBA) {
            float l = lrun[qt]; l += __shfl_xor(l, 16); l += __shfl_xor(l, 32);
            const float inv = 1.0f / l;
#pragma unroll
            for (int dt = 0; dt < DT; ++dt) {
                const f32x4 v = o[dt][qt] * inv;
                u32x2 ov; ov.x = pk2(v.x, v.y); ov.y = pk2(v.z, v.w);
                *(u32x2*)(mix + tok * DM + 512 + h * 64 + 16 * dt + 4 * fq) = ov;
            }
        } else {
            float ss = 0.f;
#pragma unroll
            for (int dt = 0; dt < DT; ++dt) { const f32x4 v = o[dt][qt]; ss += (v.x * v.x + v.y * v.y) + (v.z * v.z + v.w * v.w); }
            ss += __shfl_xor(ss, 16); ss += __shfl_xor(ss, 32);
            const float rstd = rsqrtf(ss * (1.0f / 128.0f) + EPS);
            const bf16_t* rg = (const bf16_t*)(ws + WS_RG);
#pragma unroll
            for (int dt = 0; dt < DT; ++dt) {
                const u32x2 gv = *(const u32x2*)(rg + tok * 512 + h * 128 + 16 * dt + 4 * fq);
                const f32x4 v = o[dt][qt] * rstd;
                u32x2 ov; ov.x = pk2(v.x * bflo(gv.x), v.y * bfhi(gv.x)); ov.y = pk2(v.z * bflo(gv.y), v.w * bfhi(gv.y));
                *(u32x2*)(mix + tok * DM + h * 128 + 16 * dt + 4 * fq) = ov;
            }
        }
    }
}

DEVI void phase3(const Params& p, LAS unsigned char* lds, int tid, unsigned* ctl) {
    LAS int* scal = (LAS int*)(lds + LDS_MISC + MISC_SCAL);
    for (;;) {
        asm volatile("" : "+v"(tid));
        __syncthreads();
        if (tid == 0) scal[0] = (int)atomicAdd(&ctl[CW_QATT], 1u);
        __syncthreads();
        const int u = scal[0];
        if (u >= 768) break;
        if (u < 256) {
            const int qb = 7 - (u >> 5), bh = u & 31;
            attn_unit<128, false>(p, lds, bh >> 2, bh & 3, qb, tid);
        } else {
            const int v = u - 256, qb = 7 - (v >> 6), bh = v & 63;
            attn_unit<64, true>(p, lds, bh >> 3, bh & 7, qb, tid);
        }
    }
}

template <bool FUSE>
DEVI void phase4(const Params& p, LAS unsigned char* lds, int tid, int vcu, int G, unsigned* ctl) {
    unsigned char* ws = p.ws;
    const bf16_t* A = (const bf16_t*)(ws + WS_MIX); const bf16_t* WT = (const bf16_t*)(ws + WS_WOUT);
    const float* mod = (const float*)(ws + WS_MOD);
    float* x1 = (float*)(ws + WS_X1);
    for (int id = vcu; id < 256; id += G) {
        asm volatile("" : "+v"(tid));
        const int w = tid >> 6, lane = tid & 63, fr = lane & 15, fq = lane >> 4;
        const int pm = id >> 2, pn = id & 3;
        int aoff[4], boff[4];
#pragma unroll
        for (int i = 0; i < 4; ++i) { aoff[i] = (pm * 256 + i * 64 + (tid >> 3)) * DM; boff[i] = (pn * 256 + i * 64 + (tid >> 3)) * DM; }
        f32x4 acc[4][8];
        gemm_tile<1>(acc, lds, A, A, A, WT, WT, WT, aoff, boff, DM, tid);
        const int b = pm >> 3, wm = w >> 1, wn = w & 1;
        __syncthreads();
        LAS unsigned char* wl = lds + w * EPF_WAVE;
        LAS float* rowss = (LAS float*)(lds + 98304);
#pragma unroll
        for (int mt = 0; mt < 4; ++mt) {
            f32x4 o[8];
            epi_transpose_f32(wl, acc[mt], o, lane);
            const int col = pn * 256 + 128 * wn + 4 * (lane & 31);
            const f32x4 gt = *(const f32x4*)(mod + b * 6144 + 2048 + col);
#pragma unroll
            for (int j = 0; j < 8; ++j) {
                const int row = 64 * wm + 16 * mt + 2 * j + (lane >> 5);
                const size_t tok = (size_t)pm * 256 + row;
                const f32x4 xv = *(const f32x4*)(p.x + tok * DM + col);
                const f32x4 v = xv + gt * o[j];
                *(f32x4*)(x1 + tok * DM + col) = v;
                if (FUSE) {
                    float ss = (v.x * v.x + v.y * v.y) + (v.z * v.z + v.w * v.w);
                    ss += __shfl_xor(ss, 1); ss += __shfl_xor(ss, 2); ss += __shfl_xor(ss, 4); ss += __shfl_xor(ss, 8); ss += __shfl_xor(ss, 16);
                    if ((lane & 31) == 0) rowss[wn * 256 + row] = ss;
                }
            }
        }
        if (FUSE) {
            __attribute__((address_space(1))) float* stats = (__attribute__((address_space(1))) float*)(ws + WS_STATS) + (size_t)pm * 1024;
            __syncthreads();
            if (tid < 256) __hip_atomic_store(stats + pn * 256 + tid, rowss[tid] + rowss[256 + tid], __ATOMIC_RELAXED, __HIP_MEMORY_SCOPE_AGENT);
            asm volatile("s_waitcnt vmcnt(0)" ::: "memory");
            __syncthreads();
            if (tid == 0) {
                unsigned* cw = ctl + CW_P4 + 64 * pm;
                (void)xb_add(cw, 1u);
                unsigned sp = 0;
                while (xb_ld(cw) < 4u && ++sp < (1u << 20)) __builtin_amdgcn_s_sleep(1);
                __builtin_amdgcn_fence(__ATOMIC_ACQUIRE, "agent");
                asm volatile("s_waitcnt vmcnt(0)" ::: "memory");
            }
            __syncthreads();
            if (tid < 256) {
                float s = 0.f;
#pragma unroll
                for (int q = 0; q < 4; ++q) s += __hip_atomic_load(stats + q * 256 + tid, __ATOMIC_RELAXED, __HIP_MEMORY_SCOPE_AGENT);
                rowss[512 + tid] = rsqrtf(s * (1.0f / DM) + EPS);
            }
            __syncthreads();
            bf16_t* Hhi = (bf16_t*)(ws + WS_H1); bf16_t* Hlo = (bf16_t*)(ws + WS_H2LO);
            const int col = pn * 256 + 128 * wn + 4 * (lane & 31);
            const f32x4 gg = *(const f32x4*)(p.g_ffn + col);
            const f32x4 sc = *(const f32x4*)(mod + b * 6144 + 4096 + col) + 1.0f;
            const f32x4 sh = *(const f32x4*)(mod + b * 6144 + 3072 + col);
#pragma unroll 4
            for (int rr = 0; rr < 32; ++rr) {
                const int row = 64 * wm + 2 * rr + (lane >> 5);
                const size_t tok = (size_t)pm * 256 + row;
                const f32x4 v = *(const f32x4*)(x1 + tok * DM + col);
                const f32x4 h = v * rowss[512 + row] * gg * sc + sh;
                u32x2 o; o.x = pk2(h.x, h.y); o.y = pk2(h.z, h.w);
                *(u32x2*)(Hhi + tok * DM + col) = o;
                u32x2 ol; ol.x = pk2(h.x - bflo(o.x), h.y - bfhi(o.x)); ol.y = pk2(h.z - bflo(o.y), h.w - bfhi(o.y));
                *(u32x2*)(Hlo + tok * DM + col) = ol;
            }
            asm volatile("s_waitcnt vmcnt(0)" ::: "memory");
            __syncthreads();
            {
                const bf16_t* Wh = (const bf16_t*)(ws + WS_WR); const bf16_t* Wl = Wh + (size_t)NEXP * DM;
#pragma unroll
                for (int i = 0; i < 4; ++i) { aoff[i] = (pm * 256 + i * 64 + (tid >> 3)) * DM + 256 * pn; boff[i] = (i * 64 + (tid >> 3)) * DM + 256 * pn; }
                gemm_tile<3>(acc, lds, Hlo, Hhi, Hhi, Wh, Wl, Wh, aoff, boff, 256, tid);
                float* dst = (float*)(ws + WS_RQ) + (size_t)pn * NTOK * NEXP;
#pragma unroll
                for (int mt = 0; mt < 4; ++mt) {
                    const size_t tok = (size_t)pm * 256 + 64 * wm + 16 * mt + fr;
#pragma unroll
                    for (int nt = 0; nt < 8; ++nt) *(f32x4*)(dst + tok * NEXP + 128 * wn + 16 * nt + 4 * fq) = acc[mt][nt];
                }
            }
        }
        __syncthreads();
    }
}

constexpr int RR = 8;
DEVI float wave_max(float v) {
#pragma unroll
    for (int o = 1; o < 64; o <<= 1) v = fmaxf(v, __shfl_xor(v, o));
    return v;
}
DEVI void route_rows(const Params& p, unsigned char* ws, unsigned* ctl, int tok0, int lane) {
    const float* part = (const float*)(ws + WS_RQ);
    const f32x4 b4 = *(const f32x4*)(p.router_bias + 4 * lane);
    float sc[RR][4], ch[RR][4];
#pragma unroll
    for (int q = 0; q < RR; ++q) {
        const size_t off = (size_t)(tok0 + q) * NEXP + 4 * lane;
        f32x4 l4 = *(const f32x4*)(part + off);
#pragma unroll
        for (int j = 1; j < 4; ++j) l4 += *(const f32x4*)(part + (size_t)j * NTOK * NEXP + off);
        float bi[4];
#pragma unroll
        for (int j = 0; j < 4; ++j) { sc[q][j] = 1.0f / (1.0f + __expf(-l4[j])); bi[j] = sc[q][j] + b4[j]; }
        float t1 = fmaxf(bi[0], bi[1]), t2 = fminf(bi[0], bi[1]);
        { const float a1 = fmaxf(bi[2], bi[3]), a2 = fminf(bi[2], bi[3]); const float n1 = fmaxf(t1, a1), n2 = fmaxf(fminf(t1, a1), fmaxf(t2, a2)); t1 = n1; t2 = n2; }
#pragma unroll
        for (int o = 1; o < 8; o <<= 1) {
            const float a1 = __shfl_xor(t1, o), a2 = __shfl_xor(t2, o);
            const float n1 = fmaxf(t1, a1), n2 = fmaxf(fminf(t1, a1), fmaxf(t2, a2)); t1 = n1; t2 = n2;
        }
        const float gs = t1 + t2; const int g = lane >> 3;
        int rank = 0;
#pragma unroll
        for (int j = 0; j < 8; ++j) { const float o = __uint_as_float(__builtin_amdgcn_readlane(__float_as_uint(gs), 8 * j)); rank += (o > gs || (o == gs && j < g)) ? 1 : 0; }
        const bool gsel = rank < 4;
#pragma unroll
        for (int j = 0; j < 4; ++j) ch[q][j] = gsel ? bi[j] : -INFINITY;
    }
    int me[RR]; float mw[RR], wsum[RR];
#pragma unroll
    for (int q = 0; q < RR; ++q) { me[q] = 0; mw[q] = 0.f; wsum[q] = 0.f; }
#pragma unroll
    for (int k = 0; k < 8; ++k) {
        float M[RR];
#pragma unroll
        for (int q = 0; q < RR; ++q) M[q] = fmaxf(fmaxf(ch[q][0], ch[q][1]), fmaxf(ch[q][2], ch[q][3]));
#pragma unroll
        for (int o = 1; o < 64; o <<= 1) {
#pragma unroll
            for (int q = 0; q < RR; ++q) M[q] = fmaxf(M[q], __shfl_xor(M[q], o));
        }
#pragma unroll
        for (int q = 0; q < RR; ++q) {
            const bool h0 = ch[q][0] == M[q], h1 = ch[q][1] == M[q], h2 = ch[q][2] == M[q], h3 = ch[q][3] == M[q];
            const unsigned long long bal = __builtin_amdgcn_ballot_w64(h0 || h1 || h2 || h3);
            const int wl = __builtin_amdgcn_readfirstlane((int)__builtin_ctzll(bal));
            const int sub = h0 ? 0 : (h1 ? 1 : (h2 ? 2 : 3));
            const float myscore = h0 ? sc[q][0] : (h1 ? sc[q][1] : (h2 ? sc[q][2] : sc[q][3]));
            const int wsub = __builtin_amdgcn_readlane(sub, wl);
            const float wsel = __uint_as_float(__builtin_amdgcn_readlane(__float_as_uint(myscore), wl));
            if (lane == wl) {
                if (sub == 0) ch[q][0] = -INFINITY; else if (sub == 1) ch[q][1] = -INFINITY; else if (sub == 2) ch[q][2] = -INFINITY; else ch[q][3] = -INFINITY;
            }
            wsum[q] += wsel;
            if (lane == k) { me[q] = 4 * wl + wsub; mw[q] = wsel; }
        }
    }
    if (lane < 8) {
        unsigned rk[RR];
#pragma unroll
        for (int q = 0; q < RR; ++q) rk[q] = __hip_atomic_fetch_add(&ctl[CW_CNT + 64 * me[q]], 1u, __ATOMIC_RELAXED, __HIP_MEMORY_SCOPE_AGENT);
#pragma unroll
        for (int q = 0; q < RR; ++q) {
            const int aid = (tok0 + q) * 8 + lane;
            ((float*)(ws + WS_TOPW))[aid] = mw[q] * (2.5f / wsum[q]);
            ((int*)(ws + WS_LIST))[(size_t)me[q] * LIST_CAP + rk[q]] = aid;
        }
    }
}

DEVI void phase6(const Params& p, LAS unsigned char* lds, int tid, int vcu, int G) {
    unsigned char* ws = p.ws;
    const bf16_t* Hh = (const bf16_t*)(ws + WS_H1); const bf16_t* Hl = (const bf16_t*)(ws + WS_H2LO);
    const bf16_t* Wh = (const bf16_t*)(ws + WS_WR); const bf16_t* Wl = Wh + (size_t)NEXP * DM;
    float* part = (float*)(ws + WS_RQ);
    for (int id = vcu; id < 4 * (NTOK / 256); id += G) {
        asm volatile("" : "+v"(tid));
        const int w = tid >> 6, lane = tid & 63, fr = lane & 15, fq = lane >> 4;
        const int pm = id >> 2, kq = id & 3;
        int aoff[4], boff[4];
#pragma unroll
        for (int i = 0; i < 4; ++i) { aoff[i] = (pm * 256 + i * 64 + (tid >> 3)) * DM + 256 * kq; boff[i] = (i * 64 + (tid >> 3)) * DM + 256 * kq; }
        f32x4 acc[4][8];
        gemm_tile<3>(acc, lds, Hl, Hh, Hh, Wh, Wl, Wh, aoff, boff, 256, tid);
        float* dst = part + (size_t)kq * NTOK * NEXP;
        const int wm = w >> 1, wn = w & 1;
#pragma unroll
        for (int mt = 0; mt < 4; ++mt) {
            const size_t tok = (size_t)pm * 256 + 64 * wm + 16 * mt + fr;
#pragma unroll
            for (int nt = 0; nt < 8; ++nt) *(f32x4*)(dst + tok * NEXP + 128 * wn + 16 * nt + 4 * fq) = acc[mt][nt];
        }
        __syncthreads();
    }
}

DEVI void phase_route(const Params& p, int tid, int vcu, int G, unsigned* ctl) {
    const int w = tid >> 6, lane = tid & 63;
    const int gw = vcu * NWAVES + w, NGW = G * NWAVES;
    for (int t0 = gw * RR; t0 < NTOK; t0 += NGW * RR) route_rows(p, p.ws, ctl, t0, lane);
}

DEVI void phase7(const Params& p, LAS unsigned char* lds, int tid, int vcu, int G, unsigned* ctl) {
    unsigned char* ws = p.ws;
    LAS int* pre = (LAS int*)(lds + LDS_MISC + MISC_PRE);
    LAS int* cnts = (LAS int*)lds;
    LAS int* scan = (LAS int*)(lds + 1024);
    if (tid < NEXP) { const int c = (int)xb_ld(&ctl[CW_CNT + 64 * tid]); cnts[tid] = c; scan[tid] = (c + 255) >> 8; }
    __syncthreads();
#pragma unroll 1
    for (int o = 1; o < NEXP; o <<= 1) {
        int v = 0;
        if (tid < NEXP && tid >= o) v = scan[tid - o];
        __syncthreads();
        if (tid < NEXP) scan[tid] += v;
        __syncthreads();
    }
    if (tid < NEXP) pre[tid + 1] = scan[tid];
    if (tid == 0) pre[0] = 0;
    __syncthreads();
    if (tid == 0) pre[NEXP + 1] = pre[NEXP] + NTOK / 256;
    __syncthreads();
    const int U = pre[NEXP + 1];
    LAS int* cntm = (LAS int*)(lds + LDS_MISC + MISC_KM);
    if (tid < NEXP) cntm[tid] = cnts[tid];
    __syncthreads();
    const bf16_t* Hh = (const bf16_t*)(ws + WS_H1);
    bf16_t* Hs = (bf16_t*)(ws + WS_MIX) + (size_t)blockIdx.x * 256 * 256;
    bf16_t* Y = (bf16_t*)(ws + WS_Y);
    const int* list = (const int*)(ws + WS_LIST); const float* topw = (const float*)(ws + WS_TOPW);
    auto unit_expert = [&](int uu) -> int { int lo = 0, hi = NEXP + 1; while (hi - lo > 1) { const int mid = (lo + hi) >> 1; if (pre[mid] <= uu) lo = mid; else hi = mid; } return lo; };
    auto stage1_base = [&](int ee, int ww) -> const float* {
        const float* Wg = (ee < NEXP) ? p.w_gate + (size_t)ee * DM * EFF : p.ws_gate;
        const float* Wu = (ee < NEXP) ? p.w_up + (size_t)ee * DM * EFF : p.ws_up;
        const int R = 32 * ww, within = R & 127;
        return ((within < 64) ? Wg : Wu) + 64 * (R >> 7) + (within & 63);
    };
    f32x4 breg[8];
    if (vcu < U) wf32_load_b(breg, stage1_base(unit_expert(vcu), tid >> 6), EFF, 0, tid);
    for (int u = vcu; u < U; u += G) {
        asm volatile("" : "+v"(tid));
        const int w = tid >> 6, lane = tid & 63, fr = lane & 15, fq = lane >> 4;
        const int e = unit_expert(u), mtile = u - pre[e];
        const int cnt = (e < NEXP) ? cntm[e] : NTOK;
        const int rbase = mtile * 256;
        int aoff[4];
#pragma unroll
        for (int i = 0; i < 4; ++i) {
            int r = rbase + i * 64 + (tid >> 3); r = r < cnt ? r : cnt - 1;
            const int tok = (e < NEXP) ? (list[(size_t)e * LIST_CAP + r] >> 3) : r;
            aoff[i] = tok * DM;
        }
        {
            LAS int* taid = (LAS int*)(lds + LDS_ROWTAB); LAS float* tw = (LAS float*)(lds + LDS_ROWTAB + 1024);
            if (tid < 256) {
                const int r = rbase + tid; int a = -1; float wv = 0.f;
                if (r < cnt) { if (e < NEXP) { a = list[(size_t)e * LIST_CAP + r]; wv = topw[a]; } else { a = NASSIGN + r; wv = 1.0f; } }
                taid[tid] = a; tw[tid] = wv;
            }
        }
        f32x4 acc[4][8];
        const float* Wdn = (e < NEXP) ? p.w_down + (size_t)e * EFF * DM : p.ws_down;
        const float* b1 = stage1_base(e, w);
        const float* b2 = Wdn + 32 * w;
        const float* bnext = (u + G < U) ? stage1_base(unit_expert(u + G), w) : b1;
#pragma unroll 1
        for (int nh = 0; nh < 2; ++nh) {
            const float* bcol = b1 + nh * 128;
            const float* nb = (nh == 0) ? b1 + 128 : b2;
            gemm_tile_wf32(acc, breg, lds, Hh, bcol, EFF, nb, (nh == 0) ? EFF : DM, aoff, DM, tid);
            const int w = tid >> 6, lane = tid & 63, fr = lane & 15, fq = lane >> 4, wm = w >> 1, wn = w & 1;
#pragma unroll
            for (int mt = 0; mt < 4; ++mt)
#pragma unroll
                for (int nt = 0; nt < 4; ++nt) {
                    const f32x4 g = acc[mt][nt], uu = acc[mt][nt + 4];
                    u32x2 o; o.x = pk2(siluf(g.x) * uu.x, siluf(g.y) * uu.y); o.y = pk2(siluf(g.z) * uu.z, siluf(g.w) * uu.w);
                    *(u32x2*)(Hs + (size_t)(64 * wm + 16 * mt + fr) * 256 + nh * 128 + 64 * wn + 16 * nt + 4 * fq) = o;
                    if (nt == 3) __builtin_amdgcn_sched_barrier(0);
                }
            __syncthreads();
        }
#pragma unroll 1
        for (int nq = 0; nq < 4; ++nq) {
#pragma unroll
            for (int i = 0; i < 4; ++i) aoff[i] = (i * 64 + (tid >> 3)) * 256;
            gemm_tile_wf32(acc, breg, lds, Hs, b2 + nq * 256, DM, (nq < 3) ? b2 + (nq + 1) * 256 : bnext, (nq < 3) ? DM : EFF, aoff, EFF, tid);
            const int w = tid >> 6, lane = tid & 63, fr = lane & 15, fq = lane >> 4, wm = w >> 1, wn = w & 1;
            __syncthreads();
            LAS unsigned char* wl = lds + w * EPI_WAVE;
#pragma unroll
            for (int hf = 0; hf < 2; ++hf) {
                u32x2 pk[2][8];
#pragma unroll
                for (int m2 = 0; m2 < 2; ++m2) {
                    const float wrow = ((LAS const float*)(lds + LDS_ROWTAB + 1024))[64 * wm + 32 * hf + 16 * m2 + fr];
#pragma unroll
                    for (int nt = 0; nt < 8; ++nt) { const f32x4 v = acc[2 * hf + m2][nt] * wrow; pk[m2][nt].x = pk2(v.x, v.y); pk[m2][nt].y = pk2(v.z, v.w); }
                }
                u32x4 rows8[8];
                epi_transpose(wl, pk, rows8, lane);
#pragma unroll
                for (int j = 0; j < 8; ++j) {
                    const int aid = ((LAS const int*)(lds + LDS_ROWTAB))[64 * wm + 32 * hf + 4 * j + fq];
                    if (aid >= 0) *(u32x4*)(Y + (size_t)aid * DM + nq * 256 + 128 * wn + 8 * fr) = rows8[j];
                }
            }
            __syncthreads();
        }
    }
}

DEVI void phase8(const Params& p, int tid, int vcu, int G) {
    unsigned char* ws = p.ws;
    const int w = tid >> 6, lane = tid & 63;
    const int gw = vcu * NWAVES + w, NGW = G * NWAVES;
    const bf16_t* Y = (const bf16_t*)(ws + WS_Y); const float* mod = (const float*)(ws + WS_MOD);
    for (int tok = gw; tok < NTOK; tok += NGW) {
        const int b = tok >> 11;
#pragma unroll
        for (int j = 0; j < 2; ++j) {
            const int col = 512 * j + 8 * lane;
            float a[8];
#pragma unroll
            for (int q = 0; q < 8; ++q) a[q] = 0.f;
#pragma unroll
            for (int k = 0; k < 9; ++k) {
                const size_t row = (k < 8) ? ((size_t)tok * 8 + k) : ((size_t)NASSIGN + tok);
                const u32x4 v = *(const u32x4*)(Y + row * DM + col);
                a[0] += bflo(v.x); a[1] += bfhi(v.x); a[2] += bflo(v.y); a[3] += bfhi(v.y); a[4] += bflo(v.z); a[5] += bfhi(v.z); a[6] += bflo(v.w); a[7] += bfhi(v.w);
            }
            float* o = p.out + (size_t)tok * DM + col;
            const float* xi = (const float*)(ws + WS_X1) + (size_t)tok * DM + col;
            const float* gt = mod + b * 6144 + 5120 + col;
            const f32x4 x0 = *(const f32x4*)xi, x1 = *(const f32x4*)(xi + 4);
            const f32x4 g0 = *(const f32x4*)gt, g1 = *(const f32x4*)(gt + 4);
            *(f32x4*)o = x0 + g0 * (f32x4){a[0], a[1], a[2], a[3]};
            *(f32x4*)(o + 4) = x1 + g1 * (f32x4){a[4], a[5], a[6], a[7]};
        }
    }
}

__global__ void __launch_bounds__(NTHREADS) hymba_fwd(Params p_in) {
    extern __shared__ __attribute__((aligned(16))) unsigned char smem[];
    LAS unsigned char* lds = (LAS unsigned char*)smem;
    int tid = threadIdx.x;
    const int G = gridDim.x;
    const int bx = blockIdx.x;
    const int vcu = (G % 8 == 0) ? (bx % 8) * (G / 8) + bx / 8 : bx;
    unsigned* ctl = (unsigned*)(p_in.ws + WS_CTL);
    if (tid < 4) ((LAS unsigned*)(lds + LDS_MISC + MISC_BAR))[tid] = 0u;
    __syncthreads();
    XcdBarrier bar; bar.bar = ctl + CW_BAR; bar.x = 0; bar.st = nullptr;
    const bool multi = (p_in.ph_hi - p_in.ph_lo) > 1;
    if (multi) bar = xcd_barrier_post(ctl + CW_BAR, (volatile LAS unsigned*)(lds + LDS_MISC + MISC_BAR));
    const float* mod = nullptr;
    Params p = p_in;
#pragma unroll 1
    for (int pi = p_in.ph_lo; pi < p_in.ph_hi; ++pi) {
        if (pi > p_in.ph_lo) xcd_barrier(bar);
        int ph = p_in.prog[0];
#pragma unroll
        for (int q = 1; q < 14; ++q) ph = (pi == q) ? p_in.prog[q] : ph;
        {
            int t = threadIdx.x; asm volatile("" : "+v"(t)); tid = t;
            unsigned char* wsl = p_in.ws; asm volatile("" : "+s"(wsl)); p.ws = wsl;
            float* ol = p_in.out; asm volatile("" : "+s"(ol)); p.out = ol;
            mod = (const float*)(wsl + WS_MOD);
        }
        switch (ph) {
#if !defined(ONLY_PH) || ONLY_PH == 0
        case 0: phase0(p, lds, tid, vcu, G); break;
#endif
#if !defined(ONLY_PH) || ONLY_PH == 1
        case 1: rownorm_phase<false>(p.x, p.g_mix, mod, 0, 1024, (bf16_t*)(p.ws + WS_H1), nullptr, tid, vcu, G); break;
#endif
#if !defined(ONLY_PH) || ONLY_PH == 2
        case 2: phase2(p, lds, tid, vcu, G); break;
#endif
#if !defined(ONLY_PH) || ONLY_PH == 3
        case 3: phase3(p, lds, tid, ctl + pi); break;
#endif
#if !defined(ONLY_PH) || ONLY_PH == 4
        case 4: phase4<false>(p, lds, tid, vcu, G, ctl); break;
        case 11: phase4<true>(p, lds, tid, vcu, G, ctl); break;
#endif
#if !defined(ONLY_PH) || ONLY_PH == 5
        case 5: rownorm_phase<true>((const float*)(p.ws + WS_X1), p.g_ffn, mod, 3072, 4096, (bf16_t*)(p.ws + WS_H1), (bf16_t*)(p.ws + WS_H2LO), tid, vcu, G); break;
#endif
#if !defined(ONLY_PH) || ONLY_PH == 6
        case 6: phase6(p, lds, tid, vcu, G); break;
#endif
#if !defined(ONLY_PH) || ONLY_PH == 7
        case 7: phase_route(p, tid, vcu, G, ctl); break;
#endif
#if !defined(ONLY_PH) || ONLY_PH == 8
        case 8: phase7(p, lds, tid, vcu, G, ctl); break;
#endif
#if !defined(ONLY_PH) || ONLY_PH == 9
        case 9: phase8(p, tid, vcu, G); break;
#endif
        default: break;
        }
    }
}

extern "C" void kernel_launch(void* const* d_in, const int* in_sizes, int n_in, void* d_out, int out_size, void* d_ws, size_t ws_size, hipStream_t stream) {
    static int grid = 0;
    if (grid == 0) {
        if (n_in != 18 || out_size != NTOK * DM || ws_size < WS_END) {
            fprintf(stderr, "kernel_launch: unexpected shapes (n_in %d, out %d, ws %zu, need %zu)\n", n_in, out_size, ws_size, (size_t)WS_END); grid = -1; return;
        }
        int dev = 0, cus = 0, per_cu = 0;
        hipGetDevice(&dev);
        hipDeviceGetAttribute(&cus, hipDeviceAttributeMultiprocessorCount, dev);
        hipFuncSetAttribute((const void*)hymba_fwd, hipFuncAttributeMaxDynamicSharedMemorySize, LDS_BYTES);
        hipOccupancyMaxActiveBlocksPerMultiprocessor(&per_cu, (const void*)hymba_fwd, NTHREADS, LDS_BYTES);
        if (per_cu < 1) { fprintf(stderr, "kernel_launch: occupancy query says %d blocks/CU\n", per_cu); grid = -1; return; }
        grid = cus < 256 ? cus : 256;
        (void)hipGetLastError();
    }
    if (grid < 0) return;
    hipMemsetAsync((char*)d_ws + WS_CTL, 0, CTL_BYTES, stream);
    Params p{};
    p.x = (const float*)d_in[0]; p.c = (const float*)d_in[1]; p.w_ada = (const float*)d_in[2]; p.b_ada = (const float*)d_in[3];
    p.g_mix = (const float*)d_in[4]; p.w_in = (const float*)d_in[5]; p.q_gain = (const float*)d_in[6]; p.k_gain = (const float*)d_in[7];
    p.w_out = (const float*)d_in[8]; p.g_ffn = (const float*)d_in[9]; p.w_router = (const float*)d_in[10]; p.router_bias = (const float*)d_in[11];
    p.w_gate = (const float*)d_in[12]; p.w_up = (const float*)d_in[13]; p.w_down = (const float*)d_in[14];
    p.ws_gate = (const float*)d_in[15]; p.ws_up = (const float*)d_in[16]; p.ws_down = (const float*)d_in[17];
    p.out = (float*)d_out; p.ws = (unsigned char*)d_ws;
    int np = 0;
    for (int ph = 0; ph < NPHASE; ++ph) {
        if (grid == 256 && ph == 4) { p.prog[np++] = 11; continue; }
        if (grid == 256 && (ph == 5 || ph == 6)) continue;
        p.prog[np++] = ph;
#ifdef PROBE_DUP
        if (ph == PROBE_DUP) p.prog[np++] = ph;
#endif
    }
#if MK_N_LAUNCHES == 1
    p.ph_lo = 0; p.ph_hi = np;
    hipLaunchKernelGGL(hymba_fwd, dim3(grid), dim3(NTHREADS), LDS_BYTES, stream, p);
#else
    for (int pi = 0; pi < np; ++pi) {
        p.ph_lo = pi; p.ph_hi = pi + 1;
        hipLaunchKernelGGL(hymba_fwd, dim3(grid), dim3(NTHREADS), LDS_BYTES, stream, p);
    }
#endif
}
```

```cpp
#include <hip/hip_runtime.h>
#include <stdint.h>
#include <stdio.h>

#ifndef MK_N_LAUNCHES
#define MK_N_LAUNCHES 1
#endif

#define DEVI __device__ __forceinline__
#define LAS __attribute__((address_space(3)))

typedef unsigned short bf16_t;
typedef short bf16x8 __attribute__((ext_vector_type(8)));
typedef float f32x4 __attribute__((ext_vector_type(4)));
typedef unsigned u32x4 __attribute__((ext_vector_type(4)));
typedef unsigned u32x2 __attribute__((ext_vector_type(2)));

constexpr int BATCH = 8, SEQ = 2048, DM = 1024, NTOK = BATCH * SEQ;
constexpr int INC = 3584;
constexpr int NEXP = 256, TOPK = 8, EFF = 256;
constexpr int NASSIGN = NTOK * TOPK;
constexpr int LIST_CAP = NTOK;
constexpr float EPS = 1e-6f;
constexpr int NTHREADS = 512, NWAVES = 8;
constexpr int NPHASE = 10;

constexpr int LDS_STAGE = 131072;
constexpr int LDS_MISC = LDS_STAGE;
constexpr int LDS_BYTES = LDS_STAGE + 4096 + 2048;
constexpr int LDS_ROWTAB = LDS_STAGE + 4096;
constexpr int MISC_BAR = 0, MISC_PRE = 64, MISC_SEL = 1280, MISC_KM = 1536, MISC_SCAL = 3400;

constexpr size_t al256(size_t x) { return (x + 255) & ~(size_t)255; }
constexpr size_t WS_CTL = 0;
constexpr size_t CTL_BYTES = 131072;
constexpr size_t WS_MOD = WS_CTL + CTL_BYTES;
constexpr size_t WS_ROPE = WS_MOD + al256((size_t)BATCH * 6144 * 4);
constexpr size_t WS_KMEAN = WS_ROPE + (size_t)2 * SEQ * 64 * 4;
constexpr size_t WS_WIN = WS_KMEAN + (size_t)8 * 8 * 8 * 64 * 4;
constexpr size_t WS_WOUT = WS_WIN + (size_t)INC * DM * 2;
constexpr size_t WS_WR = WS_WOUT + (size_t)DM * DM * 2;
constexpr size_t WS_WGU = WS_WR + (size_t)2 * NEXP * DM * 2;
constexpr size_t WS_WD = WS_WGU + (size_t)257 * 512 * DM * 2;
constexpr size_t WS_H1 = WS_WD + (size_t)257 * DM * 256 * 2;
constexpr size_t WS_H2LO = WS_H1 + (size_t)NTOK * DM * 2;
constexpr size_t WS_RQ = WS_H2LO + (size_t)NTOK * DM * 2;
constexpr size_t WS_RK = WS_RQ + (size_t)NTOK * 512 * 2;
constexpr size_t WS_RVT = WS_RK + (size_t)NTOK * 512 * 2;
constexpr size_t WS_RG = WS_RVT + (size_t)NTOK * 512 * 2;
constexpr size_t WS_MQ = WS_RG + (size_t)NTOK * 512 * 2;
constexpr size_t WS_MK = WS_MQ + (size_t)NTOK * 512 * 2;
constexpr size_t WS_MVT = WS_MK + (size_t)NTOK * 512 * 2;
constexpr size_t WS_MIX = WS_MVT + (size_t)NTOK * 512 * 2;
constexpr size_t WS_LOGIT = WS_MIX + (size_t)NTOK * DM * 2;
constexpr size_t WS_TOPW = WS_LOGIT + (size_t)NTOK * NEXP * 4;
constexpr size_t WS_LIST = WS_TOPW + (size_t)NASSIGN * 4;
constexpr size_t WS_Y = WS_LIST + (size_t)NEXP * LIST_CAP * 4;
constexpr size_t WS_STATS = WS_Y + (size_t)(NASSIGN + NTOK) * DM * 2;
constexpr size_t WS_END = WS_STATS + (size_t)64 * 4 * 256 * 4;

constexpr size_t WS_X1 = WS_WGU;


constexpr int CW_BAR = 0;
constexpr int CW_CNT = 4096;
constexpr int CW_QATT = 4096 + 64 * 256;
constexpr int CW_QMOE = CW_QATT + 64;
constexpr int CW_P4 = CW_QMOE + 128;

struct Params {
    const float* x; const float* c; const float* w_ada; const float* b_ada; const float* g_mix; const float* w_in;
    const float* q_gain; const float* k_gain; const float* w_out; const float* g_ffn; const float* w_router; const float* router_bias;
    const float* w_gate; const float* w_up; const float* w_down; const float* ws_gate; const float* ws_up; const float* ws_down;
    float* out; unsigned char* ws;
    int ph_lo, ph_hi;
    int prog[14];
};

DEVI unsigned pk2(float lo, float hi) { unsigned r; asm("v_cvt_pk_bf16_f32 %0, %1, %2" : "=v"(r) : "v"(lo), "v"(hi)); return r; }
DEVI float bf2f(unsigned short b) { return __uint_as_float((unsigned)b << 16); }
DEVI float bflo(unsigned u) { return __uint_as_float(u << 16); }
DEVI float bfhi(unsigned u) { return __uint_as_float(u & 0xffff0000u); }
DEVI float siluf(float v) { return v / (1.0f + __expf(-v)); }
DEVI float wave_sum(float v) {
#pragma unroll
    for (int o = 1; o < 64; o <<= 1) v += __shfl_xor(v, o);
    return v;
}
DEVI void glds16(const void* g, LAS unsigned char* l) {
    __builtin_amdgcn_global_load_lds((const __attribute__((address_space(1))) unsigned*)g, (LAS unsigned*)l, 16, 0, 0);
}
DEVI void glds16o(const void* base, unsigned off, LAS unsigned char* l) {
    __builtin_amdgcn_global_load_lds((const __attribute__((address_space(1))) unsigned*)((const __attribute__((address_space(1))) char*)base + off), (LAS unsigned*)l, 16, 0, 0);
}
DEVI bf16x8 lds128(LAS const unsigned char* p) { return *(LAS const bf16x8*)p; }
DEVI u32x2 lds64(LAS const unsigned char* p) { return *(LAS const u32x2*)p; }
#define VM_WAIT() asm volatile("s_waitcnt vmcnt(0)" ::: "memory")
DEVI const float* uniform_ptr(const float* p) {
    const unsigned long long v = (unsigned long long)p;
    const unsigned lo = __builtin_amdgcn_readfirstlane((unsigned)v), hi = __builtin_amdgcn_readfirstlane((unsigned)(v >> 32));
    return (const float*)(((unsigned long long)hi << 32) | lo);
}


#define XB_TMO      128
#define XB_XCNT(j)  (256  + 64 * (j))
#define XB_XSUB(j)  (1280 + 64 * (j))
#define XB_XGEN(j)  (2304 + 64 * (j))
#define XB_TOP      3328
#define XB_TOPGEN   3392
#define XCD_BAR_WORDS 3456
#define XB_SPIN_CAP (1u << 22)
DEVI unsigned xb_ld(unsigned* p) { return __hip_atomic_load(p, __ATOMIC_RELAXED, __HIP_MEMORY_SCOPE_AGENT); }
DEVI unsigned xb_add(unsigned* p, unsigned v) { return __hip_atomic_fetch_add(p, v, __ATOMIC_RELAXED, __HIP_MEMORY_SCOPE_AGENT); }
DEVI unsigned xb_xcc_id() { return (unsigned)__builtin_amdgcn_s_getreg((3 << 11) | 20) & 0xFu; }
#define XB_SPIN(cond, bar) do { unsigned _sp = 0; while (cond) { __builtin_amdgcn_s_sleep(1); \
    if ((++_sp & 255u) == 0u) { if (xb_ld(&(bar)[XB_TMO])) break; if (_sp > XB_SPIN_CAP) { atomicAdd(&(bar)[XB_TMO], 1u); break; } } } } while (0)
struct XcdBarrier { unsigned* bar; unsigned x; volatile LAS unsigned* st; };
DEVI XcdBarrier xcd_barrier_post(unsigned* bar, volatile LAS unsigned* st) {
    XcdBarrier b; b.bar = bar; b.x = xb_xcc_id(); b.st = st;
    if (threadIdx.x == 0) (void)xb_add(&bar[XB_XCNT(b.x)], 1u);
    return b;
}
DEVI void xcd_barrier_complete(unsigned* bar, unsigned x, unsigned& nloc, unsigned& nx) {
    const unsigned G = gridDim.x * gridDim.y * gridDim.z;
    unsigned sum, cnt, mine, sp = 0u;
    for (;;) {
        sum = 0u; cnt = 0u; mine = 0u;
#pragma unroll
        for (unsigned j = 0; j < 16; ++j) { const unsigned c = xb_ld(&bar[XB_XCNT(j)]); sum += c; cnt += (c > 0u) ? 1u : 0u; mine = (j == x) ? c : mine; }
        if (sum == G) break;
        __builtin_amdgcn_s_sleep(1);
        if ((++sp & 255u) == 0u) { if (xb_ld(&bar[XB_TMO])) break; if (sp > XB_SPIN_CAP) { atomicAdd(&bar[XB_TMO], 1u); break; } }
    }
    nloc = mine > 0u ? mine : 1u; nx = cnt > 0u ? cnt : 1u;
}
DEVI void xcd_barrier(const XcdBarrier& b) {
    asm volatile("s_waitcnt vmcnt(0)" ::: "memory");
    __syncthreads();
    if (threadIdx.x == 0) {
        unsigned* bar = b.bar;
        __builtin_amdgcn_s_waitcnt(0);
        unsigned nloc = b.st[0], nx = b.st[1];
        if (nloc == 0u) { xcd_barrier_complete(bar, b.x, nloc, nx); b.st[0] = nloc; b.st[1] = nx; }
        const unsigned old = xb_add(&bar[XB_XSUB(b.x)], 1u);
        const unsigned gen = old / nloc;
        if (old + 1u == (gen + 1u) * nloc) {
            __builtin_amdgcn_fence(__ATOMIC_RELEASE, "agent");
            asm volatile("s_waitcnt vmcnt(0)" ::: "memory");
            const unsigned og = xb_add(&bar[XB_TOP], 1u);
            const unsigned tg = og / nx;
            if (og + 1u == (tg + 1u) * nx) xb_add(&bar[XB_TOPGEN], 1u);
            else XB_SPIN(xb_ld(&bar[XB_TOPGEN]) == tg, bar);
            __builtin_amdgcn_fence(__ATOMIC_ACQUIRE, "agent");
            xb_add(&bar[XB_XGEN(b.x)], 1u);
            asm volatile("s_waitcnt vmcnt(0)" ::: "memory");
        } else {
            XB_SPIN(xb_ld(&bar[XB_XGEN(b.x)]) == gen, bar);
            __builtin_amdgcn_fence(__ATOMIC_ACQUIRE, "agent");
            asm volatile("s_waitcnt vmcnt(0)" ::: "memory");
        }
    }
    __syncthreads();
}

template <bool SWAP, int BH = 1, bool BSWZ = false>
DEVI void mma_step(f32x4 (&acc)[4][8], LAS const unsigned char* Ab, LAS const unsigned char* Bb, const int fr, const int fq) {
#pragma unroll
    for (int kk = 0; kk < 2; ++kk) {
        const int co = ((kk * 4 + fq) ^ (fr & 7)) * 16;
        const int cob0 = BSWZ ? ((kk * 4 + fq) ^ (((fr >> 2) & 3) | (((fr >> 1) & 1) << 2))) * 16 : co;
        const int cob1 = BSWZ ? (cob0 ^ 64) : co;
        bf16x8 a[4];
#pragma unroll
        for (int mt = 0; mt < 4; ++mt) a[mt] = lds128(Ab + mt * 2048 + co);
#pragma unroll
        for (int h = 0; h < BH; ++h) {
            constexpr int NB = 8 / BH;
            bf16x8 b[NB];
#pragma unroll
            for (int nt = 0; nt < NB; ++nt) b[nt] = lds128(Bb + (h * NB + nt) * 2048 + ((nt & 1) ? cob1 : cob0));
#pragma unroll
            for (int nt = 0; nt < NB; ++nt)
#pragma unroll
                for (int mt = 0; mt < 4; ++mt) {
                    if (SWAP) acc[mt][h * NB + nt] = __builtin_amdgcn_mfma_f32_16x16x32_bf16(b[nt], a[mt], acc[mt][h * NB + nt], 0, 0, 0);
                    else acc[mt][h * NB + nt] = __builtin_amdgcn_mfma_f32_16x16x32_bf16(a[mt], b[nt], acc[mt][h * NB + nt], 0, 0, 0);
                }
            __builtin_amdgcn_sched_barrier(0);
        }
    }
}

template <int NSEG, bool SWAP = true>
DEVI void gemm_tile(f32x4 (&acc)[4][8], LAS unsigned char* lds, const bf16_t* A0, const bf16_t* A1, const bf16_t* A2,
                    const bf16_t* B0, const bf16_t* B1, const bf16_t* B2,
                    const int (&aoff)[4], const int (&boff)[4], const int K, const int tid, const int nra = 4) {
    const int w = tid >> 6, lane = tid & 63, fr = lane & 15, fq = lane >> 4, wm = w >> 1, wn = w & 1;
    const int lch = ((tid & 7) ^ ((tid >> 3) & 7)) * 8;
    const int kper = K >> 6;
#pragma unroll
    for (int mt = 0; mt < 4; ++mt)
#pragma unroll
        for (int nt = 0; nt < 8; ++nt) acc[mt][nt] = (f32x4){0.f, 0.f, 0.f, 0.f};
    auto stage = [&](int buf, const bf16_t* Ab, const bf16_t* Bb, int ks) {
        const int k0 = ks * 64 + lch;
        LAS unsigned char* base = lds + buf * 65536 + tid * 16;
#pragma unroll
        for (int i = 0; i < 4; ++i) if (i < nra) glds16o(Ab, (unsigned)(aoff[i] + k0) * 2u, base + i * 8192);
#pragma unroll
        for (int i = 0; i < 4; ++i) glds16o(Bb, (unsigned)(boff[i] + k0) * 2u, base + 32768 + i * 8192);
    };
    stage(0, A0, B0, 0);
    int buf = 0;
#pragma unroll
    for (int seg = 0; seg < NSEG; ++seg) {
        const bf16_t* Ac = (seg == 0) ? A0 : (seg == 1) ? A1 : A2;
        const bf16_t* Bc = (seg == 0) ? B0 : (seg == 1) ? B1 : B2;
        const bf16_t* An = (seg == 0) ? A1 : A2;
        const bf16_t* Bn = (seg == 0) ? B1 : B2;
#pragma unroll 1
        for (int ks = 0; ks < kper; ++ks) {
            VM_WAIT();
            __syncthreads();
            if (ks + 1 < kper) stage(buf ^ 1, Ac, Bc, ks + 1);
            else if (seg + 1 < NSEG) stage(buf ^ 1, An, Bn, 0);
            if (wm < nra) mma_step<SWAP>(acc, lds + buf * 65536 + (64 * wm + fr) * 128, lds + buf * 65536 + 32768 + (128 * wn + fr) * 128, fr, fq);
            buf ^= 1;
        }
    }
}

DEVI void wf32_load_b(f32x4 (&breg)[8], const float* wbase_in, const int ldb, const int ks, const int t) {
    const float* wbase = uniform_ptr(wbase_in);
    const unsigned toff = (unsigned)((8 * ((t >> 3) & 7)) * ldb + 4 * (t & 7)) * 4u;
    const float* s = wbase + (size_t)(ks * 64) * ldb;
#pragma unroll
    for (int i = 0; i < 8; ++i) breg[i] = *(const __attribute__((address_space(1))) f32x4*)((const __attribute__((address_space(1))) char*)(s + (size_t)i * ldb) + toff);
}
DEVI void gemm_tile_wf32(f32x4 (&acc)[4][8], f32x4 (&breg)[8], LAS unsigned char* lds, const bf16_t* A0, const float* wbase_in, const int ldb,
                         const float* nbase, const int nldb, const int (&aoff)[4], const int K, int& tid) {
    const int kper = K >> 6;
#pragma unroll
    for (int mt = 0; mt < 4; ++mt)
#pragma unroll
        for (int nt = 0; nt < 8; ++nt) acc[mt][nt] = (f32x4){0.f, 0.f, 0.f, 0.f};
    auto stage_a = [&](int buf, int ks, int t) {
        const int lch = ((t & 7) ^ ((t >> 3) & 7)) * 8;
        const int k0 = ks * 64 + lch;
        LAS unsigned char* base = lds + buf * 65536 + t * 16;
#pragma unroll
        for (int i = 0; i < 4; ++i) glds16o(A0, (unsigned)(aoff[i] + k0) * 2u, base + i * 8192);
    };
    auto write_b = [&](int buf, int t) {
        const int kg = (t >> 3) & 7, n4 = t & 7;
        LAS unsigned char* base = lds + buf * 65536 + 32768 + (32 * (t >> 6) + 4 * n4) * 128;
#pragma unroll
        for (int j = 0; j < 4; ++j) {
            u32x4 o;
            o.x = pk2(breg[0][j], breg[1][j]); o.y = pk2(breg[2][j], breg[3][j]); o.z = pk2(breg[4][j], breg[5][j]); o.w = pk2(breg[6][j], breg[7][j]);
            const int swz = (n4 & 3) | ((((j >> 1) ^ (n4 >> 2)) & 1) << 2);
            *(LAS u32x4*)(base + j * 128 + ((kg ^ swz) * 16)) = o;
        }
    };
    stage_a(0, 0, tid);
    write_b(0, tid);
    wf32_load_b(breg, (kper > 1) ? wbase_in : nbase, (kper > 1) ? ldb : nldb, (kper > 1) ? 1 : 0, tid);
    int buf = 0;
#pragma unroll 1
    for (int ks = 0; ks < kper; ++ks) {
        asm volatile("" : "+v"(tid));
        asm volatile("s_waitcnt vmcnt(8)" ::: "memory");
        asm volatile("s_waitcnt lgkmcnt(0)" ::: "memory");
        __builtin_amdgcn_s_barrier();
        asm volatile("" ::: "memory");
        const bool more = ks + 1 < kper;
        if (more) stage_a(buf ^ 1, ks + 1, tid);
        {
            const int w = tid >> 6, lane = tid & 63, fr = lane & 15, fq = lane >> 4, wm = w >> 1, wn = w & 1;
            mma_step<true, 2, true>(acc, lds + buf * 65536 + (64 * wm + fr) * 128, lds + buf * 65536 + 32768 + (128 * wn + fr) * 128, fr, fq);
        }
        if (more) {
            write_b(buf ^ 1, tid);
            const bool more2 = ks + 2 < kper;
            wf32_load_b(breg, more2 ? wbase_in : nbase, more2 ? ldb : nldb, more2 ? ks + 2 : 0, tid);
        }
        buf ^= 1;
    }
}

constexpr int EPI_RS = 272, EPI_WAVE = 32 * EPI_RS;
DEVI void epi_transpose(LAS unsigned char* wl, const u32x2 (&pk)[2][8], u32x4 (&rows8)[8], const int lane) {
    const int fr = lane & 15, fq = lane >> 4;
#pragma unroll
    for (int m2 = 0; m2 < 2; ++m2)
#pragma unroll
        for (int nt = 0; nt < 8; ++nt) *(LAS u32x2*)(wl + (16 * m2 + fr) * EPI_RS + (16 * nt + 4 * fq) * 2) = pk[m2][nt];
    asm volatile("s_waitcnt lgkmcnt(0)" ::: "memory");
#pragma unroll
    for (int j = 0; j < 8; ++j) rows8[j] = *(LAS const u32x4*)(wl + (4 * j + fq) * EPI_RS + fr * 16);
    asm volatile("s_waitcnt lgkmcnt(0)" ::: "memory");
}

constexpr int EPV_RS = 144, EPV_WAVE = 64 * EPV_RS;
DEVI void epi_transpose_vt(LAS unsigned char* wl, const u32x2 (&pk)[4][4], u32x4 (&rows8)[8], const int lane) {
    const int fr = lane & 15, fq = lane >> 4;
#pragma unroll
    for (int mt = 0; mt < 4; ++mt)
#pragma unroll
        for (int n4 = 0; n4 < 4; ++n4) *(LAS u32x2*)(wl + (16 * n4 + fr) * EPV_RS + (32 * (mt >> 1) + 8 * fq + 4 * (mt & 1)) * 2) = pk[mt][n4];
    asm volatile("s_waitcnt lgkmcnt(0)" ::: "memory");
#pragma unroll
    for (int j = 0; j < 8; ++j) rows8[j] = *(LAS const u32x4*)(wl + (8 * j + (lane >> 3)) * EPV_RS + (lane & 7) * 16);
    asm volatile("s_waitcnt lgkmcnt(0)" ::: "memory");
}
constexpr int EPF_RS = 528, EPF_WAVE = 16 * EPF_RS;
DEVI void epi_transpose_f32(LAS unsigned char* wl, const f32x4 (&v)[8], f32x4 (&o)[8], const int lane) {
    const int fr = lane & 15, fq = lane >> 4;
#pragma unroll
    for (int nt = 0; nt < 8; ++nt) *(LAS f32x4*)(wl + fr * EPF_RS + (16 * nt + 4 * fq) * 4) = v[nt];
    asm volatile("s_waitcnt lgkmcnt(0)" ::: "memory");
#pragma unroll
    for (int j = 0; j < 8; ++j) o[j] = *(LAS const f32x4*)(wl + (2 * j + (lane >> 5)) * EPF_RS + (lane & 31) * 16);
    asm volatile("s_waitcnt lgkmcnt(0)" ::: "memory");
}

DEVI void transpose_item(const float* W, int N, int k0, int n0, bf16_t* dst_row0  , bf16_t* dst_lo_row0, int K, LAS float* scr, int lane) {
#pragma unroll 8
    for (int i = 0; i < 32; ++i) { const int kk = 2 * i + (lane >> 5); scr[kk * 33 + (lane & 31)] = W[(size_t)(k0 + kk) * N + n0 + (lane & 31)]; }
    asm volatile("s_waitcnt lgkmcnt(0)" ::: "memory");
    const int c = lane & 7;
#pragma unroll
    for (int j = 0; j < 4; ++j) {
        const int n = (lane >> 3) + 8 * j; const LAS float* s = scr + (8 * c) * 33 + n;
        float v[8];
#pragma unroll
        for (int q = 0; q < 8; ++q) v[q] = s[q * 33];
        unsigned ow[4];
#pragma unroll
        for (int q = 0; q < 4; ++q) ow[q] = pk2(v[2 * q], v[2 * q + 1]);
        u32x4 o; o.x = ow[0]; o.y = ow[1]; o.z = ow[2]; o.w = ow[3];
        *(u32x4*)(dst_row0 + (size_t)n * K + k0 + 8 * c) = o;
        if (dst_lo_row0) {
            unsigned lw[4];
#pragma unroll
            for (int q = 0; q < 4; ++q) lw[q] = pk2(v[2 * q] - bflo(ow[q]), v[2 * q + 1] - bfhi(ow[q]));
            u32x4 ol; ol.x = lw[0]; ol.y = lw[1]; ol.z = lw[2]; ol.w = lw[3];
            *(u32x4*)(dst_lo_row0 + (size_t)n * K + k0 + 8 * c) = ol;
        }
    }
    asm volatile("s_waitcnt lgkmcnt(0)" ::: "memory");
}

DEVI void phase0(const Params& p, LAS unsigned char* lds, int tid, int vcu, int G) {
    unsigned char* ws = p.ws;
    const int w = tid >> 6, lane = tid & 63;
    {
        LAS float* sc = (LAS float*)lds;
        LAS float* red = (LAS float*)(lds + 32768);
        float* mod = (float*)(ws + WS_MOD);
        for (int item = vcu; item < 192; item += G) {
            for (int i = tid; i < BATCH * DM; i += NTHREADS) sc[i] = siluf(p.c[i]);
            __syncthreads();
            const int cc = tid & 31, g = tid >> 5, col = item * 32 + cc;
            float a[8];
#pragma unroll
            for (int b = 0; b < 8; ++b) a[b] = 0.f;
            const float* wp = p.w_ada + (size_t)(g * 64) * 6144 + col;
#pragma unroll 1
            for (int k0 = 0; k0 < 64; k0 += 16) {
                float wv[16];
#pragma unroll
                for (int i = 0; i < 16; ++i) wv[i] = wp[(size_t)(k0 + i) * 6144];
#pragma unroll
                for (int i = 0; i < 16; ++i)
#pragma unroll
                    for (int b = 0; b < 8; ++b) a[b] += sc[b * DM + g * 64 + k0 + i] * wv[i];
            }
#pragma unroll
            for (int b = 0; b < 8; ++b) red[(g * 8 + b) * 32 + cc] = a[b];
            __syncthreads();
            if (tid < 256) {
                const int b = tid >> 5, c2 = tid & 31;
                float s = 0.f;
#pragma unroll
                for (int gg = 0; gg < 16; ++gg) s += red[(gg * 8 + b) * 32 + c2];
                mod[b * 6144 + item * 32 + c2] = s + p.b_ada[item * 32 + c2];
            }
            __syncthreads();
        }
    }
    {
        float* kmz = (float*)(ws + WS_KMEAN);
        for (int i = vcu * NTHREADS + tid; i < 8 * 8 * 8 * 64; i += G * NTHREADS) kmz[i] = 0.f;
        float* cosT = (float*)(ws + WS_ROPE); float* sinT = cosT + SEQ * 64;
        for (int i = vcu * NTHREADS + tid; i < SEQ * 64; i += G * NTHREADS) {
            const int pos = i >> 6, j = i & 63;
            const float inv = powf(10000.0f, -(float)j / 64.0f);
            const float ang = (float)pos * inv;
            cosT[i] = cosf(ang); sinT[i] = sinf(ang);
        }
    }
    {
        LAS float* scr = (LAS float*)(lds + w * 8448);
        const int gw = vcu * NWAVES + w, NGW = G * NWAVES;
        constexpr int I_IN = 16 * (INC / 32), I_OUT = 16 * 32, I_R = 16 * 8;
        constexpr int I_TOTAL = I_IN + I_OUT + I_R;
        bf16_t* win = (bf16_t*)(ws + WS_WIN); bf16_t* wout = (bf16_t*)(ws + WS_WOUT); bf16_t* wr = (bf16_t*)(ws + WS_WR);
        for (int it = gw; it < I_TOTAL; it += NGW) {
            int r = it;
            if (r < I_IN) { const int nb = INC / 32, kb = r / nb, n0 = (r % nb) * 32; transpose_item(p.w_in, INC, kb * 64, n0, win + (size_t)n0 * DM, nullptr, DM, scr, lane); continue; } r -= I_IN;
            if (r < I_OUT) { const int kb = r / 32, n0 = (r % 32) * 32; transpose_item(p.w_out, DM, kb * 64, n0, wout + (size_t)n0 * DM, nullptr, DM, scr, lane); continue; } r -= I_OUT;
            { const int kb = r / 8, n0 = (r % 8) * 32; transpose_item(p.w_router, NEXP, kb * 64, n0, wr + (size_t)n0 * DM, wr + (size_t)(NEXP + n0) * DM, DM, scr, lane); }
        }
    }
}

template <bool LO>
DEVI void rownorm_phase(const float* X, const float* g, const float* mod, int sh_off, int sc_off, bf16_t* Hhi, bf16_t* Hlo, int tid, int vcu, int G) {
    const int w = tid >> 6, lane = tid & 63;
    const int gw = vcu * NWAVES + w, NGW = G * NWAVES;
    for (int row = gw; row < NTOK; row += NGW) {
        const int b = row >> 11;
        const f32x4* xr = (const f32x4*)(X + (size_t)row * DM) + lane;
        f32x4 v[4]; float s = 0.f;
#pragma unroll
        for (int j = 0; j < 4; ++j) { v[j] = xr[64 * j]; s += (v[j].x * v[j].x + v[j].y * v[j].y) + (v[j].z * v[j].z + v[j].w * v[j].w); }
        const float rstd = rsqrtf(wave_sum(s) * (1.0f / DM) + EPS);
#pragma unroll
        for (int j = 0; j < 4; ++j) {
            const int col = 4 * lane + 256 * j;
            const f32x4 gg = *(const f32x4*)(g + col);
            const f32x4 sc = *(const f32x4*)(mod + b * 6144 + sc_off + col);
            const f32x4 sh = *(const f32x4*)(mod + b * 6144 + sh_off + col);
            f32x4 h = v[j] * rstd * gg * (sc + 1.0f) + sh;
            u32x2 o; o.x = pk2(h.x, h.y); o.y = pk2(h.z, h.w);
            *(u32x2*)(Hhi + (size_t)row * DM + col) = o;
            if (LO) {
                u32x2 ol; ol.x = pk2(h.x - bflo(o.x), h.y - bfhi(o.x)); ol.y = pk2(h.z - bflo(o.y), h.w - bfhi(o.y));
                *(u32x2*)(Hlo + (size_t)row * DM + col) = ol;
            }
        }
    }
}

DEVI void phase2(const Params& p, LAS unsigned char* lds, int tid, int vcu, int G) {
    unsigned char* ws = p.ws;
    const bf16_t* H = (const bf16_t*)(ws + WS_H1); const bf16_t* WT = (const bf16_t*)(ws + WS_WIN);
    const float* cosT = (const float*)(ws + WS_ROPE); const float* sinT = cosT + SEQ * 64;
    for (int it = vcu; it < 768 + 256; it += G) {
        asm volatile("" : "+v"(tid));
        const int w = tid >> 6, lane = tid & 63, fr = lane & 15, fq = lane >> 4;
        const bool halfm = it >= 768;
        const int id = halfm ? 768 + ((it - 768) >> 1) : it, rh = halfm ? ((it - 768) & 1) : 0, nra = halfm ? 2 : 4;
        const int pm = id / 14, pn = id % 14;
        int aoff[4], boff[4];
#pragma unroll
        for (int i = 0; i < 4; ++i) { aoff[i] = (pm * 256 + 128 * rh + (i & (nra - 1)) * 64 + (tid >> 3)) * DM; boff[i] = (pn * 256 + i * 64 + (tid >> 3)) * DM; }
        f32x4 acc[4][8];
        const int cat = pn >> 1, half = pn & 1;
        const int wm = w >> 1, wn = w & 1;
        const bool wact = wm < nra;
        if (cat == 2 || cat == 6) gemm_tile<1, false>(acc, lds, H, H, H, WT, WT, WT, aoff, boff, DM, tid, nra);
        else gemm_tile<1, true>(acc, lds, H, H, H, WT, WT, WT, aoff, boff, DM, tid, nra);
        const int b = pm >> 3, s0 = (pm & 7) * 256 + 128 * rh + 64 * wm;
        const bool isk = (cat == 5);
        LAS float* red = (LAS float*)(lds + 98304);
        __syncthreads();
        if (!wact) {
        } else if (cat == 2 || cat == 6) {
            bf16_t* dst = (bf16_t*)(ws + (cat == 2 ? WS_RVT : WS_MVT));
            LAS unsigned char* wl = lds + w * EPV_WAVE;
#pragma unroll
            for (int hf = 0; hf < 2; ++hf) {
                u32x2 pk[4][4];
#pragma unroll
                for (int mt = 0; mt < 4; ++mt)
#pragma unroll
                    for (int n4 = 0; n4 < 4; ++n4) { const f32x4 v = acc[mt][4 * hf + n4]; pk[mt][n4].x = pk2(v.x, v.y); pk[mt][n4].y = pk2(v.z, v.w); }
                u32x4 rows8[8];
                epi_transpose_vt(wl, pk, rows8, lane);
                const size_t rowbase = (size_t)b * 512 + 256 * half + 128 * wn + 64 * hf + (lane >> 3);
#pragma unroll
                for (int j = 0; j < 8; ++j) *(u32x4*)(dst + (rowbase + 8 * j) * SEQ + s0 + 8 * (lane & 7)) = rows8[j];
            }
        } else {
            LAS unsigned char* wl = lds + w * EPI_WAVE;
            const float* gain = isk ? p.k_gain : p.q_gain;
#pragma unroll
            for (int hf = 0; hf < 2; ++hf) {
                u32x2 pk[2][8];
                if (cat <= 1) {
                    const float lgh = log2f(1.0f - exp2f(-5.0f - (float)(2 * half + wn)));
                    const float sclb = (cat == 1) ? 0.08838834764831845f : 1.0f, lgs = (cat == 1) ? -lgh : lgh;
#pragma unroll
                    for (int m2 = 0; m2 < 2; ++m2) {
                        const int s = s0 + 32 * hf + 16 * m2 + fr;
                        const float scl = sclb * exp2f(lgs * (float)(s - 1024));
#pragma unroll
                        for (int np = 0; np < 4; ++np) {
                            const f32x4 cs = *(const f32x4*)(cosT + s * 64 + 16 * np + 4 * fq) * scl;
                            const f32x4 sn = *(const f32x4*)(sinT + s * 64 + 16 * np + 4 * fq) * scl;
                            const f32x4 x1 = acc[2 * hf + m2][np], x2 = acc[2 * hf + m2][np + 4];
                            const f32x4 o1 = x1 * cs - x2 * sn, o2 = x1 * sn + x2 * cs;
                            pk[m2][np].x = pk2(o1.x, o1.y); pk[m2][np].y = pk2(o1.z, o1.w);
                            pk[m2][np + 4].x = pk2(o2.x, o2.y); pk[m2][np + 4].y = pk2(o2.z, o2.w);
                        }
                    }
                } else if (cat == 3) {
#pragma unroll
                    for (int m2 = 0; m2 < 2; ++m2)
#pragma unroll
                        for (int nt = 0; nt < 8; ++nt) { const f32x4 v = acc[2 * hf + m2][nt]; pk[m2][nt].x = pk2(siluf(v.x), siluf(v.y)); pk[m2][nt].y = pk2(siluf(v.z), siluf(v.w)); }
                } else {
#pragma unroll
                    for (int hh = 0; hh < 2; ++hh) {
                        float rstd[2];
#pragma unroll
                        for (int m2 = 0; m2 < 2; ++m2) {
                            float ss = 0.f;
#pragma unroll
                            for (int np = 0; np < 4; ++np) { const f32x4 v = acc[2 * hf + m2][4 * hh + np]; ss += (v.x * v.x + v.y * v.y) + (v.z * v.z + v.w * v.w); }
                            ss += __shfl_xor(ss, 16); ss += __shfl_xor(ss, 32);
                            rstd[m2] = rsqrtf(ss * (1.0f / 64.0f) + EPS);
                        }
#pragma unroll
                        for (int np = 0; np < 4; ++np) {
                            const f32x4 gn = *(const f32x4*)(gain + 16 * np + 4 * fq) * (isk ? 1.0f : 0.125f * 1.4426950408889634f);
                            f32x4 cs = (f32x4){0.f, 0.f, 0.f, 0.f};
#pragma unroll
                            for (int m2 = 0; m2 < 2; ++m2) {
                                const f32x4 v = acc[2 * hf + m2][4 * hh + np] * rstd[m2] * gn;
                                cs += v;
                                pk[m2][4 * hh + np].x = pk2(v.x, v.y); pk[m2][4 * hh + np].y = pk2(v.z, v.w);
                            }
                            if (isk) {
#pragma unroll
                                for (int r = 0; r < 4; ++r) {
                                    float v = cs[r];
                                    v += __shfl_xor(v, 1); v += __shfl_xor(v, 2); v += __shfl_xor(v, 4); v += __shfl_xor(v, 8);
                                    if (fr == 0) { LAS float* rp = red + wm * 256 + 128 * wn + 64 * hh + 16 * np + 4 * fq + r; if (hf == 0) *rp = v; else *rp += v; }
                                }
                            }
                        }
                    }
                }
                u32x4 rows8[8];
                epi_transpose(wl, pk, rows8, lane);
#pragma unroll
                for (int j = 0; j < 8; ++j) {
                    const int s = s0 + 32 * hf + 4 * j + fq;
                    bf16_t* d;
                    if (cat <= 1) d = (bf16_t*)(ws + (cat == 0 ? WS_RQ : WS_RK)) + ((size_t)((b * 4 + 2 * half + wn) * SEQ + s)) * 128 + 8 * fr;
                    else if (cat == 3) d = (bf16_t*)(ws + WS_RG) + ((size_t)b * SEQ + s) * 512 + 256 * half + 128 * wn + 8 * fr;
                    else d = (bf16_t*)(ws + (isk ? WS_MK : WS_MQ)) + ((size_t)((b * 8 + 4 * half + 2 * wn + (fr >> 3)) * SEQ + s)) * 64 + 8 * (fr & 7);
                    *(u32x4*)d = rows8[j];
                }
            }
        }
        if (isk) {
            __syncthreads();
            if (tid < 256) {
                float* km = (float*)(ws + WS_KMEAN) + ((size_t)((b * 8 + 4 * half + (tid >> 6)) * 8 + (pm & 7))) * 64 + (tid & 63);
                if (halfm) atomicAdd(km, (red[tid] + red[256 + tid]) * (1.0f / 256.0f));
                else *km = ((red[tid] + red[256 + tid]) + (red[512 + tid] + red[768 + tid])) * (1.0f / 256.0f);
            }
        }
        __syncthreads();
    }
}

template <int D, bool MOBA>
DEVI void attn_unit(const Params& p, LAS unsigned char* lds, int b, int h, int qb, int tid) {
    unsigned char* ws = p.ws;
    constexpr int H = MOBA ? 8 : 4, KK = D / 32, DT = D / 16, RB = D * 2, TILE = 64 * RB, MASK = (D == 64) ? 7 : 15, ROUNDS = TILE / 8192;
    const int w = tid >> 6, lane = tid & 63, fr = lane & 15, fq = lane >> 4;
    const bf16_t* Q = (const bf16_t*)(ws + (MOBA ? WS_MQ : WS_RQ));
    const bf16_t* Kp = (const bf16_t*)(ws + (MOBA ? WS_MK : WS_RK));
    const bf16_t* VT = (const bf16_t*)(ws + (MOBA ? WS_MVT : WS_RVT));
    const size_t qk_base = (size_t)(b * H + h) * SEQ * D, vt_base = (size_t)(b * H + h) * D * SEQ;
    const int q0 = qb * 256 + 32 * w;
    LAS unsigned char* misc = lds + LDS_MISC;
    unsigned selm[2] = {0u, 0u};
    if (MOBA) {
        LAS float* km = (LAS float*)(misc + MISC_KM);
        LAS unsigned char* sel = misc + MISC_SEL;
        const float* kmg = (const float*)(ws + WS_KMEAN) + (size_t)((b * 8 + h) * 8) * 64;
        if (tid < 448 && (tid >> 6) < qb) km[tid] = kmg[tid];
        __syncthreads();
        if (tid < 256) {
            unsigned m = 0u;
            if (qb <= 3) m = (1u << qb) - 1u;
            else {
                float t0 = -INFINITY, t1 = -INFINITY, t2 = -INFINITY; int i0 = 0, i1 = 0, i2 = 0;
                const u32x4* qr = (const u32x4*)(Q + qk_base + (size_t)(qb * 256 + tid) * 64);
                u32x4 qv[8];
#pragma unroll
                for (int c = 0; c < 8; ++c) qv[c] = qr[c];
#pragma unroll 1
                for (int kb = 0; kb < qb; ++kb) {
                    const LAS f32x4* kr = (const LAS f32x4*)(km + kb * 64);
                    float g = 0.f;
#pragma unroll
                    for (int c = 0; c < 8; ++c) {
                        const f32x4 k0 = kr[2 * c], k1 = kr[2 * c + 1];
                        g += bflo(qv[c].x) * k0.x + bfhi(qv[c].x) * k0.y + bflo(qv[c].y) * k0.z + bfhi(qv[c].y) * k0.w
                           + bflo(qv[c].z) * k1.x + bfhi(qv[c].z) * k1.y + bflo(qv[c].w) * k1.z + bfhi(qv[c].w) * k1.w;
                    }
                    if (g > t0) { t2 = t1; i2 = i1; t1 = t0; i1 = i0; t0 = g; i0 = kb; }
                    else if (g > t1) { t2 = t1; i2 = i1; t1 = g; i1 = kb; }
                    else if (g > t2) { t2 = g; i2 = kb; }
                }
                m = (1u << i0) | (1u << i1) | (1u << i2);
            }
            sel[tid] = (unsigned char)m;
        }
        __syncthreads();
        selm[0] = sel[32 * w + fr]; selm[1] = sel[32 * w + 16 + fr];
    }
    bf16x8 qf[2][KK];
#pragma unroll
    for (int qt = 0; qt < 2; ++qt)
#pragma unroll
        for (int kk = 0; kk < KK; ++kk) qf[qt][kk] = *(const bf16x8*)(Q + qk_base + (size_t)(q0 + 16 * qt + fr) * D + kk * 32 + fq * 8);
    f32x4 o[DT][2];
#pragma unroll
    for (int dt = 0; dt < DT; ++dt) { o[dt][0] = (f32x4){0.f, 0.f, 0.f, 0.f}; o[dt][1] = (f32x4){0.f, 0.f, 0.f, 0.f}; }
    float mrun[2] = {-INFINITY, -INFINITY}, lrun[2] = {0.f, 0.f};
    float mfix = 0.f; bool usefix = false;
    if (MOBA) {
        float gq = fabsf(p.q_gain[lane]), gk = fabsf(p.k_gain[lane]);
#pragma unroll
        for (int o = 1; o < 64; o <<= 1) { gq = fmaxf(gq, __shfl_xor(gq, o)); gk = fmaxf(gk, __shfl_xor(gk, o)); }
        const float smax = 8.0f * gq * gk * 1.02f;
        mfix = smax * 1.4426950408889634f;
        usefix = __builtin_amdgcn_readfirstlane((int)(smax < 40.0f)) != 0;
    }
    const int ntiles = 4 * (qb + 1);
    auto tile_ks = [&](int i) -> int {
        if (MOBA) { const int kb = (i < 4) ? qb : ((i - 4) >> 2); return kb * 256 + (i & 3) * 64; }
        return i * 64;
    };
    auto stage = [&](int buf, int i) {
        const int ks = tile_ks(i);
        LAS unsigned char* base = lds + buf * (2 * TILE);
#pragma unroll
        for (int r = 0; r < ROUNDS; ++r) {
            int row, lchunk;
            if (D == 64) { row = tid >> 3; lchunk = (tid & 7) ^ (row & 7); }
            else { row = r * 32 + (tid >> 4); lchunk = (tid & 15) ^ (row & 15); }
            glds16(Kp + qk_base + (size_t)(ks + row) * D + lchunk * 8, base + r * 8192 + tid * 16);
            const int d = r * 64 + (tid >> 3), lc2 = (tid & 7) ^ ((d >> 1) & 7);
            glds16(VT + vt_base + (size_t)d * SEQ + ks + lc2 * 8, base + TILE + r * 8192 + tid * 16);
        }
    };
    stage(0, 0); stage(1, 1);
    const int npairs = ntiles >> 1;
    for (int jp = 0; jp < npairs; ++jp) {
        VM_WAIT();
        __syncthreads();
        if (jp + 1 < npairs) { stage(((jp + 1) & 1) * 2, 2 * jp + 2); stage(((jp + 1) & 1) * 2 + 1, 2 * jp + 3); }
#pragma unroll 1
      for (int hp = 0; hp < 2; ++hp) {
        const int i = 2 * jp + hp;
        const int ks = tile_ks(i);
        const int kb = ks >> 8;
        const bool own = (kb == qb);
        if (ks > q0 + 31) continue;
        LAS const unsigned char* Kb = lds + ((jp & 1) * 2 + hp) * (2 * TILE);
        LAS const unsigned char* Vb = Kb + TILE;
        float bi0 = 0.f, bi1 = 0.f;
        if (MOBA) {
            const float bsel = usefix ? -mfix : 0.f;
            bi0 = (own || ((selm[0] >> kb) & 1u)) ? bsel : -1.0e30f;
            bi1 = (own || ((selm[1] >> kb) & 1u)) ? bsel : -1.0e30f;
        }
        f32x4 s[2][4];
#pragma unroll
        for (int kt = 0; kt < 4; ++kt) {
            s[0][kt] = (f32x4){bi0, bi0, bi0, bi0}; s[1][kt] = (f32x4){bi1, bi1, bi1, bi1};
#pragma unroll
            for (int kk = 0; kk < KK; ++kk) {
                const bf16x8 kf = lds128(Kb + (16 * kt + fr) * RB + (((kk * 4 + fq) ^ (fr & MASK)) * 16));
                s[0][kt] = __builtin_amdgcn_mfma_f32_16x16x32_bf16(kf, qf[0][kk], s[0][kt], 0, 0, 0);
                s[1][kt] = __builtin_amdgcn_mfma_f32_16x16x32_bf16(kf, qf[1][kk], s[1][kt], 0, 0, 0);
            }
        }
        unsigned pw[2][2][4];
        if (MOBA) {
            const bool diag = own && (ks + 63 > q0);
            if (usefix) {
#pragma unroll
                for (int qt = 0; qt < 2; ++qt) {
                    const int qpos = q0 + 16 * qt + fr;
                    float ls = 0.f;
                    if (diag) {
#pragma unroll
                        for (int kt = 0; kt < 4; ++kt) {
                            float pv[4];
#pragma unroll
                            for (int r = 0; r < 4; ++r) { pv[r] = __builtin_amdgcn_exp2f((ks + 16 * kt + 4 * fq + r <= qpos) ? s[qt][kt][r] : -INFINITY); ls += pv[r]; }
                            pw[qt][kt >> 1][(kt & 1) * 2 + 0] = pk2(pv[0], pv[1]);
                            pw[qt][kt >> 1][(kt & 1) * 2 + 1] = pk2(pv[2], pv[3]);
                        }
                    } else {
#pragma unroll
                        for (int kt = 0; kt < 4; ++kt) {
                            float pv[4];
#pragma unroll
                            for (int r = 0; r < 4; ++r) { pv[r] = __builtin_amdgcn_exp2f(s[qt][kt][r]); ls += pv[r]; }
                            pw[qt][kt >> 1][(kt & 1) * 2 + 0] = pk2(pv[0], pv[1]);
                            pw[qt][kt >> 1][(kt & 1) * 2 + 1] = pk2(pv[2], pv[3]);
                        }
                    }
                    lrun[qt] += ls;
                }
            } else
#pragma unroll
            for (int qt = 0; qt < 2; ++qt) {
                const int qpos = q0 + 16 * qt + fr;
                float sv[4][4]; float mx = -INFINITY;
                if (diag) {
#pragma unroll
                    for (int kt = 0; kt < 4; ++kt)
#pragma unroll
                        for (int r = 0; r < 4; ++r) {
                            const int kpos = ks + 16 * kt + 4 * fq + r;
                            sv[kt][r] = (kpos <= qpos) ? s[qt][kt][r] : -INFINITY;
                            mx = fmaxf(mx, sv[kt][r]);
                        }
                } else {
#pragma unroll
                    for (int kt = 0; kt < 4; ++kt)
#pragma unroll
                        for (int r = 0; r < 4; ++r) { sv[kt][r] = s[qt][kt][r]; mx = fmaxf(mx, sv[kt][r]); }
                }
                mx = fmaxf(mx, __shfl_xor(mx, 16)); mx = fmaxf(mx, __shfl_xor(mx, 32));
                const float mnew = fmaxf(mrun[qt], mx);
                const float msub = (mnew == -INFINITY) ? 0.f : mnew;
                if (__builtin_amdgcn_ballot_w64(mnew != mrun[qt]) != 0ull) {
                    const float alpha = (mnew == -INFINITY) ? 1.0f : __builtin_amdgcn_exp2f(mrun[qt] - mnew);
                    lrun[qt] *= alpha;
#pragma unroll
                    for (int dt = 0; dt < DT; ++dt) o[dt][qt] *= alpha;
                }
                mrun[qt] = mnew;
                float ls = 0.f;
#pragma unroll
                for (int kt = 0; kt < 4; ++kt) {
                    float pv[4];
#pragma unroll
                    for (int r = 0; r < 4; ++r) { pv[r] = __builtin_amdgcn_exp2f(sv[kt][r] - msub); ls += pv[r]; }
                    pw[qt][kt >> 1][(kt & 1) * 2 + 0] = pk2(pv[0], pv[1]);
                    pw[qt][kt >> 1][(kt & 1) * 2 + 1] = pk2(pv[2], pv[3]);
                }
                lrun[qt] += ls;
            }
        } else {
#pragma unroll
            for (int qt = 0; qt < 2; ++qt) {
                const int qpos = q0 + 16 * qt + fr;
#pragma unroll
                for (int kt = 0; kt < 4; ++kt) {
                    float pv[4];
#pragma unroll
                    for (int r = 0; r < 4; ++r) {
                        const int kpos = ks + 16 * kt + 4 * fq + r;
                        pv[r] = (kpos <= qpos) ? s[qt][kt][r] : 0.f;
                    }
                    pw[qt][kt >> 1][(kt & 1) * 2 + 0] = pk2(pv[0], pv[1]);
                    pw[qt][kt >> 1][(kt & 1) * 2 + 1] = pk2(pv[2], pv[3]);
                }
            }
        }
#pragma unroll
        for (int sh = 0; sh < 2; ++sh) {
            bf16x8 pb[2];
#pragma unroll
            for (int qt = 0; qt < 2; ++qt) { u32x4 t; t.x = pw[qt][sh][0]; t.y = pw[qt][sh][1]; t.z = pw[qt][sh][2]; t.w = pw[qt][sh][3]; pb[qt] = __builtin_bit_cast(bf16x8, t); }
#pragma unroll
            for (int dt = 0; dt < DT; ++dt) {
                const bf16x8 vf = lds128(Vb + (16 * dt + fr) * 128 + (((4 * sh + fq) ^ ((fr >> 1) & 7)) * 16));
                o[dt][0] = __builtin_amdgcn_mfma_f32_16x16x32_bf16(vf, pb[0], o[dt][0], 0, 0, 0);
                o[dt][1] = __builtin_amdgcn_mfma_f32_16x16x32_bf16(vf, pb[1], o[dt][1], 0, 0, 0);
            }
        }
      }
    }
    bf16_t* mix = (bf16_t*)(ws + WS_MIX);
#pragma unroll
    for (int qt = 0; qt < 2; ++qt) {
        const size_t tok = (size_t)b * SEQ + q0 + 16 * qt + fr;
        if (MOBA) {
            float l = lrun[qt]; l += __shfl_xor(l, 16); l += __shfl_xor(l, 32);
            const float inv = 1.0f / l;
#pragma unroll
            for (int dt = 0; dt < DT; ++dt) {
                const f32x4 v = o[dt][qt] * inv;
                u32x2 ov; ov.x = pk2(v.x, v.y); ov.y = pk2(v.z, v.w);
                *(u32x2*)(mix + tok * DM + 512 + h * 64 + 16 * dt + 4 * fq) = ov;
            }
        } else {
            float ss = 0.f;
#pragma unroll
            for (int dt = 0; dt < DT; ++dt) { const f32x4 v = o[dt][qt]; ss += (v.x * v.x + v.y * v.y) + (v.z * v.z + v.w * v.w); }
            ss += __shfl_xor(ss, 16); ss += __shfl_xor(ss, 32);
            const float rstd = rsqrtf(ss * (1.0f / 128.0f) + EPS);
            const bf16_t* rg = (const bf16_t*)(ws + WS_RG);
#pragma unroll
            for (int dt = 0; dt < DT; ++dt) {
                const u32x2 gv = *(const u32x2*)(rg + tok * 512 + h * 128 + 16 * dt + 4 * fq);
                const f32x4 v = o[dt][qt] * rstd;
                u32x2 ov; ov.x = pk2(v.x * bflo(gv.x), v.y * bfhi(gv.x)); ov.y = pk2(v.z * bflo(gv.y), v.w * bfhi(gv.y));
                *(u32x2*)(mix + tok * DM + h * 128 + 16 * dt + 4 * fq) = ov;
            }
        }
    }
}

DEVI void phase3(const Params& p, LAS unsigned char* lds, int tid, unsigned* ctl) {
    LAS int* scal = (LAS int*)(lds + LDS_MISC + MISC_SCAL);
    for (;;) {
        asm volatile("" : "+v"(tid));
        __syncthreads();
        if (tid == 0) scal[0] = (int)atomicAdd(&ctl[CW_QATT], 1u);
        __syncthreads();
        const int u = scal[0];
        if (u >= 768) break;
        if (u < 256) {
            const int qb = 7 - (u >> 5), bh = u & 31;
            attn_unit<128, false>(p, lds, bh >> 2, bh & 3, qb, tid);
        } else {
            const int v = u - 256, qb = 7 - (v >> 6), bh = v & 63;
            attn_unit<64, true>(p, lds, bh >> 3, bh & 7, qb, tid);
        }
    }
}

template <bool FUSE>
DEVI void phase4(const Params& p, LAS unsigned char* lds, int tid, int vcu, int G, unsigned* ctl) {
    unsigned char* ws = p.ws;
    const bf16_t* A = (const bf16_t*)(ws + WS_MIX); const bf16_t* WT = (const bf16_t*)(ws + WS_WOUT);
    const float* mod = (const float*)(ws + WS_MOD);
    float* x1 = (float*)(ws + WS_X1);
    for (int id = vcu; id < 256; id += G) {
        asm volatile("" : "+v"(tid));
        const int w = tid >> 6, lane = tid & 63, fr = lane & 15, fq = lane >> 4;
        const int pm = id >> 2, pn = id & 3;
        int aoff[4], boff[4];
#pragma unroll
        for (int i = 0; i < 4; ++i) { aoff[i] = (pm * 256 + i * 64 + (tid >> 3)) * DM; boff[i] = (pn * 256 + i * 64 + (tid >> 3)) * DM; }
        f32x4 acc[4][8];
        gemm_tile<1>(acc, lds, A, A, A, WT, WT, WT, aoff, boff, DM, tid);
        const int b = pm >> 3, wm = w >> 1, wn = w & 1;
        __syncthreads();
        LAS unsigned char* wl = lds + w * EPF_WAVE;
        LAS float* rowss = (LAS float*)(lds + 98304);
#pragma unroll
        for (int mt = 0; mt < 4; ++mt) {
            f32x4 o[8];
            epi_transpose_f32(wl, acc[mt], o, lane);
            const int col = pn * 256 + 128 * wn + 4 * (lane & 31);
            const f32x4 gt = *(const f32x4*)(mod + b * 6144 + 2048 + col);
#pragma unroll
            for (int j = 0; j < 8; ++j) {
                const int row = 64 * wm + 16 * mt + 2 * j + (lane >> 5);
                const size_t tok = (size_t)pm * 256 + row;
                const f32x4 xv = *(const f32x4*)(p.x + tok * DM + col);
                const f32x4 v = xv + gt * o[j];
                *(f32x4*)(x1 + tok * DM + col) = v;
                if (FUSE) {
                    float ss = (v.x * v.x + v.y * v.y) + (v.z * v.z + v.w * v.w);
                    ss += __shfl_xor(ss, 1); ss += __shfl_xor(ss, 2); ss += __shfl_xor(ss, 4); ss += __shfl_xor(ss, 8); ss += __shfl_xor(ss, 16);
                    if ((lane & 31) == 0) rowss[wn * 256 + row] = ss;
                }
            }
        }
        if (FUSE) {
            __attribute__((address_space(1))) float* stats = (__attribute__((address_space(1))) float*)(ws + WS_STATS) + (size_t)pm * 1024;
            __syncthreads();
            if (tid < 256) __hip_atomic_store(stats + pn * 256 + tid, rowss[tid] + rowss[256 + tid], __ATOMIC_RELAXED, __HIP_MEMORY_SCOPE_AGENT);
            asm volatile("s_waitcnt vmcnt(0)" ::: "memory");
            __syncthreads();
            if (tid == 0) {
                unsigned* cw = ctl + CW_P4 + 64 * pm;
                (void)xb_add(cw, 1u);
                unsigned sp = 0;
                while (xb_ld(cw) < 4u && ++sp < (1u << 20)) __builtin_amdgcn_s_sleep(1);
                __builtin_amdgcn_fence(__ATOMIC_ACQUIRE, "agent");
                asm volatile("s_waitcnt vmcnt(0)" ::: "memory");
            }
            __syncthreads();
            if (tid < 256) {
                float s = 0.f;
#pragma unroll
                for (int q = 0; q < 4; ++q) s += __hip_atomic_load(stats + q * 256 + tid, __ATOMIC_RELAXED, __HIP_MEMORY_SCOPE_AGENT);
                rowss[512 + tid] = rsqrtf(s * (1.0f / DM) + EPS);
            }
            __syncthreads();
            bf16_t* Hhi = (bf16_t*)(ws + WS_H1); bf16_t* Hlo = (bf16_t*)(ws + WS_H2LO);
            const int col = pn * 256 + 128 * wn + 4 * (lane & 31);
            const f32x4 gg = *(const f32x4*)(p.g_ffn + col);
            const f32x4 sc = *(const f32x4*)(mod + b * 6144 + 4096 + col) + 1.0f;
            const f32x4 sh = *(const f32x4*)(mod + b * 6144 + 3072 + col);
#pragma unroll 4
            for (int rr = 0; rr < 32; ++rr) {
                const int row = 64 * wm + 2 * rr + (lane >> 5);
                const size_t tok = (size_t)pm * 256 + row;
                const f32x4 v = *(const f32x4*)(x1 + tok * DM + col);
                const f32x4 h = v * rowss[512 + row] * gg * sc + sh;
                u32x2 o; o.x = pk2(h.x, h.y); o.y = pk2(h.z, h.w);
                *(u32x2*)(Hhi + tok * DM + col) = o;
                u32x2 ol; ol.x = pk2(h.x - bflo(o.x), h.y - bfhi(o.x)); ol.y = pk2(h.z - bflo(o.y), h.w - bfhi(o.y));
                *(u32x2*)(Hlo + tok * DM + col) = ol;
            }
            asm volatile("s_waitcnt vmcnt(0)" ::: "memory");
            __syncthreads();
            {
                const bf16_t* Wh = (const bf16_t*)(ws + WS_WR); const bf16_t* Wl = Wh + (size_t)NEXP * DM;
#pragma unroll
                for (int i = 0; i < 4; ++i) { aoff[i] = (pm * 256 + i * 64 + (tid >> 3)) * DM + 256 * pn; boff[i] = (i * 64 + (tid >> 3)) * DM + 256 * pn; }
                gemm_tile<3>(acc, lds, Hlo, Hhi, Hhi, Wh, Wl, Wh, aoff, boff, 256, tid);
                float* dst = (float*)(ws + WS_RQ) + (size_t)pn * NTOK * NEXP;
#pragma unroll
                for (int mt = 0; mt < 4; ++mt) {
                    const size_t tok = (size_t)pm * 256 + 64 * wm + 16 * mt + fr;
#pragma unroll
                    for (int nt = 0; nt < 8; ++nt) *(f32x4*)(dst + tok * NEXP + 128 * wn + 16 * nt + 4 * fq) = acc[mt][nt];
                }
            }
        }
        __syncthreads();
    }
}

constexpr int RR = 8;
DEVI float wave_max(float v) {
#pragma unroll
    for (int o = 1; o < 64; o <<= 1) v = fmaxf(v, __shfl_xor(v, o));
    return v;
}
DEVI void route_rows(const Params& p, unsigned char* ws, unsigned* ctl, int tok0, int lane) {
    const float* part = (const float*)(ws + WS_RQ);
    const f32x4 b4 = *(const f32x4*)(p.router_bias + 4 * lane);
    float sc[RR][4], ch[RR][4];
#pragma unroll
    for (int q = 0; q < RR; ++q) {
        const size_t off = (size_t)(tok0 + q) * NEXP + 4 * lane;
        f32x4 l4 = *(const f32x4*)(part + off);
#pragma unroll
        for (int j = 1; j < 4; ++j) l4 += *(const f32x4*)(part + (size_t)j * NTOK * NEXP + off);
        float bi[4];
#pragma unroll
        for (int j = 0; j < 4; ++j) { sc[q][j] = 1.0f / (1.0f + __expf(-l4[j])); bi[j] = sc[q][j] + b4[j]; }
        float t1 = fmaxf(bi[0], bi[1]), t2 = fminf(bi[0], bi[1]);
        { const float a1 = fmaxf(bi[2], bi[3]), a2 = fminf(bi[2], bi[3]); const float n1 = fmaxf(t1, a1), n2 = fmaxf(fminf(t1, a1), fmaxf(t2, a2)); t1 = n1; t2 = n2; }
#pragma unroll
        for (int o = 1; o < 8; o <<= 1) {
            const float a1 = __shfl_xor(t1, o), a2 = __shfl_xor(t2, o);
            const float n1 = fmaxf(t1, a1), n2 = fmaxf(fminf(t1, a1), fmaxf(t2, a2)); t1 = n1; t2 = n2;
        }
        const float gs = t1 + t2; const int g = lane >> 3;
        int rank = 0;
#pragma unroll
        for (int j = 0; j < 8; ++j) { const float o = __uint_as_float(__builtin_amdgcn_readlane(__float_as_uint(gs), 8 * j)); rank += (o > gs || (o == gs && j < g)) ? 1 : 0; }
        const bool gsel = rank < 4;
#pragma unroll
        for (int j = 0; j < 4; ++j) ch[q][j] = gsel ? bi[j] : -INFINITY;
    }
    int me[RR]; float mw[RR], wsum[RR];
#pragma unroll
    for (int q = 0; q < RR; ++q) { me[q] = 0; mw[q] = 0.f; wsum[q] = 0.f; }
#pragma unroll
    for (int k = 0; k < 8; ++k) {
        float M[RR];
#pragma unroll
        for (int q = 0; q < RR; ++q) M[q] = fmaxf(fmaxf(ch[q][0], ch[q][1]), fmaxf(ch[q][2], ch[q][3]));
#pragma unroll
        for (int o = 1; o < 64; o <<= 1) {
#pragma unroll
            for (int q = 0; q < RR; ++q) M[q] = fmaxf(M[q], __shfl_xor(M[q], o));
        }
#pragma unroll
        for (int q = 0; q < RR; ++q) {
            const bool h0 = ch[q][0] == M[q], h1 = ch[q][1] == M[q], h2 = ch[q][2] == M[q], h3 = ch[q][3] == M[q];
            const unsigned long long bal = __builtin_amdgcn_ballot_w64(h0 || h1 || h2 || h3);
            const int wl = __builtin_amdgcn_readfirstlane((int)__builtin_ctzll(bal));
            const int sub = h0 ? 0 : (h1 ? 1 : (h2 ? 2 : 3));
            const float myscore = h0 ? sc[q][0] : (h1 ? sc[q][1] : (h2 ? sc[q][2] : sc[q][3]));
            const int wsub = __builtin_amdgcn_readlane(sub, wl);
            const float wsel = __uint_as_float(__builtin_amdgcn_readlane(__float_as_uint(myscore), wl));
            if (lane == wl) {
                if (sub == 0) ch[q][0] = -INFINITY; else if (sub == 1) ch[q][1] = -INFINITY; else if (sub == 2) ch[q][2] = -INFINITY; else ch[q][3] = -INFINITY;
            }
            wsum[q] += wsel;
            if (lane == k) { me[q] = 4 * wl + wsub; mw[q] = wsel; }
        }
    }
    if (lane < 8) {
        unsigned rk[RR];
#pragma unroll
        for (int q = 0; q < RR; ++q) rk[q] = __hip_atomic_fetch_add(&ctl[CW_CNT + 64 * me[q]], 1u, __ATOMIC_RELAXED, __HIP_MEMORY_SCOPE_AGENT);
#pragma unroll
        for (int q = 0; q < RR; ++q) {
            const int aid = (tok0 + q) * 8 + lane;
            ((float*)(ws + WS_TOPW))[aid] = mw[q] * (2.5f / wsum[q]);
            ((int*)(ws + WS_LIST))[(size_t)me[q] * LIST_CAP + rk[q]] = aid;
        }
    }
}

DEVI void phase6(const Params& p, LAS unsigned char* lds, int tid, int vcu, int G) {
    unsigned char* ws = p.ws;
    const bf16_t* Hh = (const bf16_t*)(ws + WS_H1); const bf16_t* Hl = (const bf16_t*)(ws + WS_H2LO);
    const bf16_t* Wh = (const bf16_t*)(ws + WS_WR); const bf16_t* Wl = Wh + (size_t)NEXP * DM;
    float* part = (float*)(ws + WS_RQ);
    for (int id = vcu; id < 4 * (NTOK / 256); id += G) {
        asm volatile("" : "+v"(tid));
        const int w = tid >> 6, lane = tid & 63, fr = lane & 15, fq = lane >> 4;
        const int pm = id >> 2, kq = id & 3;
        int aoff[4], boff[4];
#pragma unroll
        for (int i = 0; i < 4; ++i) { aoff[i] = (pm * 256 + i * 64 + (tid >> 3)) * DM + 256 * kq; boff[i] = (i * 64 + (tid >> 3)) * DM + 256 * kq; }
        f32x4 acc[4][8];
        gemm_tile<3>(acc, lds, Hl, Hh, Hh, Wh, Wl, Wh, aoff, boff, 256, tid);
        float* dst = part + (size_t)kq * NTOK * NEXP;
        const int wm = w >> 1, wn = w & 1;
#pragma unroll
        for (int mt = 0; mt < 4; ++mt) {
            const size_t tok = (size_t)pm * 256 + 64 * wm + 16 * mt + fr;
#pragma unroll
            for (int nt = 0; nt < 8; ++nt) *(f32x4*)(dst + tok * NEXP + 128 * wn + 16 * nt + 4 * fq) = acc[mt][nt];
        }
        __syncthreads();
    }
}

DEVI void phase_route(const Params& p, int tid, int vcu, int G, unsigned* ctl) {
    const int w = tid >> 6, lane = tid & 63;
    const int gw = vcu * NWAVES + w, NGW = G * NWAVES;
    for (int t0 = gw * RR; t0 < NTOK; t0 += NGW * RR) route_rows(p, p.ws, ctl, t0, lane);
}

DEVI void phase7(const Params& p, LAS unsigned char* lds, int tid, int vcu, int G, unsigned* ctl) {
    unsigned char* ws = p.ws;
    LAS int* pre = (LAS int*)(lds + LDS_MISC + MISC_PRE);
    LAS int* cnts = (LAS int*)lds;
    LAS int* scan = (LAS int*)(lds + 1024);
    if (tid < NEXP) { const int c = (int)xb_ld(&ctl[CW_CNT + 64 * tid]); cnts[tid] = c; scan[tid] = (c + 255) >> 8; }
    __syncthreads();
#pragma unroll 1
    for (int o = 1; o < NEXP; o <<= 1) {
        int v = 0;
        if (tid < NEXP && tid >= o) v = scan[tid - o];
        __syncthreads();
        if (tid < NEXP) scan[tid] += v;
        __syncthreads();
    }
    if (tid < NEXP) pre[tid + 1] = scan[tid];
    if (tid == 0) pre[0] = 0;
    __syncthreads();
    if (tid == 0) pre[NEXP + 1] = pre[NEXP] + NTOK / 256;
    __syncthreads();
    const int U = pre[NEXP + 1];
    LAS int* cntm = (LAS int*)(lds + LDS_MISC + MISC_KM);
    if (tid < NEXP) cntm[tid] = cnts[tid];
    __syncthreads();
    const bf16_t* Hh = (const bf16_t*)(ws + WS_H1);
    bf16_t* Hs = (bf16_t*)(ws + WS_MIX) + (size_t)blockIdx.x * 256 * 256;
    bf16_t* Y = (bf16_t*)(ws + WS_Y);
    const int* list = (const int*)(ws + WS_LIST); const float* topw = (const float*)(ws + WS_TOPW);
    auto unit_expert = [&](int uu) -> int { int lo = 0, hi = NEXP + 1; while (hi - lo > 1) { const int mid = (lo + hi) >> 1; if (pre[mid] <= uu) lo = mid; else hi = mid; } return lo; };
    auto stage1_base = [&](int ee, int ww) -> const float* {
        const float* Wg = (ee < NEXP) ? p.w_gate + (size_t)ee * DM * EFF : p.ws_gate;
        const float* Wu = (ee < NEXP) ? p.w_up + (size_t)ee * DM * EFF : p.ws_up;
        const int R = 32 * ww, within = R & 127;
        return ((within < 64) ? Wg : Wu) + 64 * (R >> 7) + (within & 63);
    };
    f32x4 breg[8];
    if (vcu < U) wf32_load_b(breg, stage1_base(unit_expert(vcu), tid >> 6), EFF, 0, tid);
    for (int u = vcu; u < U; u += G) {
        asm volatile("" : "+v"(tid));
        const int w = tid >> 6, lane = tid & 63, fr = lane & 15, fq = lane >> 4;
        const int e = unit_expert(u), mtile = u - pre[e];
        const int cnt = (e < NEXP) ? cntm[e] : NTOK;
        const int rbase = mtile * 256;
        int aoff[4];
#pragma unroll
        for (int i = 0; i < 4; ++i) {
            int r = rbase + i * 64 + (tid >> 3); r = r < cnt ? r : cnt - 1;
            const int tok = (e < NEXP) ? (list[(size_t)e * LIST_CAP + r] >> 3) : r;
            aoff[i] = tok * DM;
        }
        {
            LAS int* taid = (LAS int*)(lds + LDS_ROWTAB); LAS float* tw = (LAS float*)(lds + LDS_ROWTAB + 1024);
            if (tid < 256) {
                const int r = rbase + tid; int a = -1; float wv = 0.f;
                if (r < cnt) { if (e < NEXP) { a = list[(size_t)e * LIST_CAP + r]; wv = topw[a]; } else { a = NASSIGN + r; wv = 1.0f; } }
                taid[tid] = a; tw[tid] = wv;
            }
        }
        f32x4 acc[4][8];
        const float* Wdn = (e < NEXP) ? p.w_down + (size_t)e * EFF * DM : p.ws_down;
        const float* b1 = stage1_base(e, w);
        const float* b2 = Wdn + 32 * w;
        const float* bnext = (u + G < U) ? stage1_base(unit_expert(u + G), w) : b1;
#pragma unroll 1
        for (int nh = 0; nh < 2; ++nh) {
            const float* bcol = b1 + nh * 128;
            const float* nb = (nh == 0) ? b1 + 128 : b2;
            gemm_tile_wf32(acc, breg, lds, Hh, bcol, EFF, nb, (nh == 0) ? EFF : DM, aoff, DM, tid);
            const int w = tid >> 6, lane = tid & 63, fr = lane & 15, fq = lane >> 4, wm = w >> 1, wn = w & 1;
#pragma unroll
            for (int mt = 0; mt < 4; ++mt)
#pragma unroll
                for (int nt = 0; nt < 4; ++nt) {
                    const f32x4 g = acc[mt][nt], uu = acc[mt][nt + 4];
                    u32x2 o; o.x = pk2(siluf(g.x) * uu.x, siluf(g.y) * uu.y); o.y = pk2(siluf(g.z) * uu.z, siluf(g.w) * uu.w);
                    *(u32x2*)(Hs + (size_t)(64 * wm + 16 * mt + fr) * 256 + nh * 128 + 64 * wn + 16 * nt + 4 * fq) = o;
                    if (nt == 3) __builtin_amdgcn_sched_barrier(0);
                }
            __syncthreads();
        }
#pragma unroll 1
        for (int nq = 0; nq < 4; ++nq) {
#pragma unroll
            for (int i = 0; i < 4; ++i) aoff[i] = (i * 64 + (tid >> 3)) * 256;
            gemm_tile_wf32(acc, breg, lds, Hs, b2 + nq * 256, DM, (nq < 3) ? b2 + (nq + 1) * 256 : bnext, (nq < 3) ? DM : EFF, aoff, EFF, tid);
            const int w = tid >> 6, lane = tid & 63, fr = lane & 15, fq = lane >> 4, wm = w >> 1, wn = w & 1;
            __syncthreads();
            LAS unsigned char* wl = lds + w * EPI_WAVE;
#pragma unroll
            for (int hf = 0; hf < 2; ++hf) {
                u32x2 pk[2][8];
#pragma unroll
                for (int m2 = 0; m2 < 2; ++m2) {
                    const float wrow = ((LAS const float*)(lds + LDS_ROWTAB + 1024))[64 * wm + 32 * hf + 16 * m2 + fr];
#pragma unroll
                    for (int nt = 0; nt < 8; ++nt) { const f32x4 v = acc[2 * hf + m2][nt] * wrow; pk[m2][nt].x = pk2(v.x, v.y); pk[m2][nt].y = pk2(v.z, v.w); }
                }
                u32x4 rows8[8];
                epi_transpose(wl, pk, rows8, lane);
#pragma unroll
                for (int j = 0; j < 8; ++j) {
                    const int aid = ((LAS const int*)(lds + LDS_ROWTAB))[64 * wm + 32 * hf + 4 * j + fq];
                    if (aid >= 0) *(u32x4*)(Y + (size_t)aid * DM + nq * 256 + 128 * wn + 8 * fr) = rows8[j];
                }
            }
            __syncthreads();
        }
    }
}

DEVI void phase8(const Params& p, int tid, int vcu, int G) {
    unsigned char* ws = p.ws;
    const int w = tid >> 6, lane = tid & 63;
    const int gw = vcu * NWAVES + w, NGW = G * NWAVES;
    const bf16_t* Y = (const bf16_t*)(ws + WS_Y); const float* mod = (const float*)(ws + WS_MOD);
    for (int tok = gw; tok < NTOK; tok += NGW) {
        const int b = tok >> 11;
#pragma unroll
        for (int j = 0; j < 2; ++j) {
            const int col = 512 * j + 8 * lane;
            float a[8];
#pragma unroll
            for (int q = 0; q < 8; ++q) a[q] = 0.f;
#pragma unroll
            for (int k = 0; k < 9; ++k) {
                const size_t row = (k < 8) ? ((size_t)tok * 8 + k) : ((size_t)NASSIGN + tok);
                const u32x4 v = *(const u32x4*)(Y + row * DM + col);
                a[0] += bflo(v.x); a[1] += bfhi(v.x); a[2] += bflo(v.y); a[3] += bfhi(v.y); a[4] += bflo(v.z); a[5] += bfhi(v.z); a[6] += bflo(v.w); a[7] += bfhi(v.w);
            }
            float* o = p.out + (size_t)tok * DM + col;
            const float* xi = (const float*)(ws + WS_X1) + (size_t)tok * DM + col;
            const float* gt = mod + b * 6144 + 5120 + col;
            const f32x4 x0 = *(const f32x4*)xi, x1 = *(const f32x4*)(xi + 4);
            const f32x4 g0 = *(const f32x4*)gt, g1 = *(const f32x4*)(gt + 4);
            *(f32x4*)o = x0 + g0 * (f32x4){a[0], a[1], a[2], a[3]};
            *(f32x4*)(o + 4) = x1 + g1 * (f32x4){a[4], a[5], a[6], a[7]};
        }
    }
}

__global__ void __launch_bounds__(NTHREADS) hymba_fwd(Params p_in) {
    extern __shared__ __attribute__((aligned(16))) unsigned char smem[];
    LAS unsigned char* lds = (LAS unsigned char*)smem;
    int tid = threadIdx.x;
    const int G = gridDim.x;
    const int bx = blockIdx.x;
    const int vcu = (G % 8 == 0) ? (bx % 8) * (G / 8) + bx / 8 : bx;
    unsigned* ctl = (unsigned*)(p_in.ws + WS_CTL);
    if (tid < 4) ((LAS unsigned*)(lds + LDS_MISC + MISC_BAR))[tid] = 0u;
    __syncthreads();
    XcdBarrier bar; bar.bar = ctl + CW_BAR; bar.x = 0; bar.st = nullptr;
    const bool multi = (p_in.ph_hi - p_in.ph_lo) > 1;
    if (multi) bar = xcd_barrier_post(ctl + CW_BAR, (volatile LAS unsigned*)(lds + LDS_MISC + MISC_BAR));
    const float* mod = nullptr;
    Params p = p_in;
#pragma unroll 1
    for (int pi = p_in.ph_lo; pi < p_in.ph_hi; ++pi) {
        if (pi > p_in.ph_lo) xcd_barrier(bar);
        int ph = p_in.prog[0];
#pragma unroll
        for (int q = 1; q < 14; ++q) ph = (pi == q) ? p_in.prog[q] : ph;
        {
            int t = threadIdx.x; asm volatile("" : "+v"(t)); tid = t;
            unsigned char* wsl = p_in.ws; asm volatile("" : "+s"(wsl)); p.ws = wsl;
            float* ol = p_in.out; asm volatile("" : "+s"(ol)); p.out = ol;
            mod = (const float*)(wsl + WS_MOD);
        }
        switch (ph) {
#if !defined(ONLY_PH) || ONLY_PH == 0
        case 0: phase0(p, lds, tid, vcu, G); break;
#endif
#if !defined(ONLY_PH) || ONLY_PH == 1
        case 1: rownorm_phase<false>(p.x, p.g_mix, mod, 0, 1024, (bf16_t*)(p.ws + WS_H1), nullptr, tid, vcu, G); break;
#endif
#if !defined(ONLY_PH) || ONLY_PH == 2
        case 2: phase2(p, lds, tid, vcu, G); break;
#endif
#if !defined(ONLY_PH) || ONLY_PH == 3
        case 3: phase3(p, lds, tid, ctl + pi); break;
#endif
#if !defined(ONLY_PH) || ONLY_PH == 4
        case 4: phase4<false>(p, lds, tid, vcu, G, ctl); break;
        case 11: phase4<true>(p, lds, tid, vcu, G, ctl); break;
#endif
#if !defined(ONLY_PH) || ONLY_PH == 5
        case 5: rownorm_phase<true>((const float*)(p.ws + WS_X1), p.g_ffn, mod, 3072, 4096, (bf16_t*)(p.ws + WS_H1), (bf16_t*)(p.ws + WS_H2LO), tid, vcu, G); break;
#endif
#if !defined(ONLY_PH) || ONLY_PH == 6
        case 6: phase6(p, lds, tid, vcu, G); break;
#endif
#if !defined(ONLY_PH) || ONLY_PH == 7
        case 7: phase_route(p, tid, vcu, G, ctl); break;
#endif
#if !defined(ONLY_PH) || ONLY_PH == 8
        case 8: phase7(p, lds, tid, vcu, G, ctl); break;
#endif
#if !defined(ONLY_PH) || ONLY_PH == 9
        case 9: phase8(p, tid, vcu, G); break;
#endif
        default: break;
        }
    }
}

extern "C" void kernel_launch(void* const* d_in, const int* in_sizes, int n_in, void* d_out, int out_size, void* d_ws, size_t ws_size, hipStream_t stream) {
    static int grid = 0;
    if (grid == 0) {
        if (n_in != 18 || out_size != NTOK * DM || ws_size < WS_END) {
            fprintf(stderr, "kernel_launch: unexpected shapes (n_in %d, out %d, ws %zu, need %zu)\n", n_in, out_size, ws_size, (size_t)WS_END); grid = -1; return;
        }
        int dev = 0, cus = 0, per_cu = 0;
        hipGetDevice(&dev);
        hipDeviceGetAttribute(&cus, hipDeviceAttributeMultiprocessorCount, dev);
        hipFuncSetAttribute((const void*)hymba_fwd, hipFuncAttributeMaxDynamicSharedMemorySize, LDS_BYTES);
        hipOccupancyMaxActiveBlocksPerMultiprocessor(&per_cu, (const void*)hymba_fwd, NTHREADS, LDS_BYTES);
        if (per_cu < 1) { fprintf(stderr, "kernel_launch: occupancy query says %d blocks/CU\n", per_cu); grid = -1; return; }
        grid = cus < 256 ? cus : 256;
        (void)hipGetLastError();
    }
    if (grid < 0) return;
    hipMemsetAsync((char*)d_ws + WS_CTL, 0, CTL_BYTES, stream);
    Params p{};
    p.x = (const float*)d_in[0]; p.c = (const float*)d_in[1]; p.w_ada = (const float*)d_in[2]; p.b_ada = (const float*)d_in[3];
    p.g_mix = (const float*)d_in[4]; p.w_in = (const float*)d_in[5]; p.q_gain = (const float*)d_in[6]; p.k_gain = (const float*)d_in[7];
    p.w_out = (const float*)d_in[8]; p.g_ffn = (const float*)d_in[9]; p.w_router = (const float*)d_in[10]; p.router_bias = (const float*)d_in[11];
    p.w_gate = (const float*)d_in[12]; p.w_up = (const float*)d_in[13]; p.w_down = (const float*)d_in[14];
    p.ws_gate = (const float*)d_in[15]; p.ws_up = (const float*)d_in[16]; p.ws_down = (const float*)d_in[17];
    p.out = (float*)d_out; p.ws = (unsigned char*)d_ws;
    int np = 0;
    for (int ph = 0; ph < NPHASE; ++ph) {
        if (grid == 256 && ph == 4) { p.prog[np++] = 11; continue; }
        if (grid == 256 && (ph == 5 || ph == 6)) continue;
        p.prog[np++] = ph;
#ifdef PROBE_DUP
        if (ph == PROBE_DUP) p.prog[np++] = ph;
#endif
    }
#if MK_N_LAUNCHES == 1
    p.ph_lo = 0; p.ph_hi = np;
    hipLaunchKernelGGL(hymba_fwd, dim3(grid), dim3(NTHREADS), LDS_BYTES, stream, p);
#else
    for (int pi = 0; pi < np; ++pi) {
        p.ph_lo = pi; p.ph_hi = pi + 1;
        hipLaunchKernelGGL(hymba_fwd, dim3(grid), dim3(NTHREADS), LDS_BYTES, stream, p);
    }
#endif
}
```

```cpp
#include <hip/hip_runtime.h>
#include <stdint.h>
#include <stdio.h>

#ifndef MK_N_LAUNCHES
#define MK_N_LAUNCHES 1
#endif

#define DEVI __device__ __forceinline__
#define LAS __attribute__((address_space(3)))

typedef unsigned short bf16_t;
typedef short bf16x8 __attribute__((ext_vector_type(8)));
typedef float f32x4 __attribute__((ext_vector_type(4)));
typedef unsigned u32x4 __attribute__((ext_vector_type(4)));
typedef unsigned u32x2 __attribute__((ext_vector_type(2)));

constexpr int BATCH = 8, SEQ = 2048, DM = 1024, NTOK = BATCH * SEQ;
constexpr int INC = 3584;
constexpr int NEXP = 256, TOPK = 8, EFF = 256;
constexpr int NASSIGN = NTOK * TOPK;
constexpr int LIST_CAP = NTOK;
constexpr float EPS = 1e-6f;
constexpr int NTHREADS = 512, NWAVES = 8;
constexpr int NPHASE = 10;

constexpr int LDS_STAGE = 131072;
constexpr int LDS_MISC = LDS_STAGE;
constexpr int LDS_BYTES = LDS_STAGE + 4096 + 2048;
constexpr int LDS_ROWTAB = LDS_STAGE + 4096;
constexpr int MISC_BAR = 0, MISC_PRE = 64, MISC_SEL = 1280, MISC_KM = 1536, MISC_SCAL = 3400;

constexpr size_t al256(size_t x) { return (x + 255) & ~(size_t)255; }
constexpr size_t WS_CTL = 0;
constexpr size_t CTL_BYTES = 131072;
constexpr size_t WS_MOD = WS_CTL + CTL_BYTES;
constexpr size_t WS_ROPE = WS_MOD + al256((size_t)BATCH * 6144 * 4);
constexpr size_t WS_KMEAN = WS_ROPE + (size_t)2 * SEQ * 64 * 4;
constexpr size_t WS_WIN = WS_KMEAN + (size_t)8 * 8 * 8 * 64 * 4;
constexpr size_t WS_WOUT = WS_WIN + (size_t)INC * DM * 2;
constexpr size_t WS_WR = WS_WOUT + (size_t)DM * DM * 2;
constexpr size_t WS_WGU = WS_WR + (size_t)2 * NEXP * DM * 2;
constexpr size_t WS_WD = WS_WGU + (size_t)257 * 512 * DM * 2;
constexpr size_t WS_H1 = WS_WD + (size_t)257 * DM * 256 * 2;
constexpr size_t WS_H2LO = WS_H1 + (size_t)NTOK * DM * 2;
constexpr size_t WS_RQ = WS_H2LO + (size_t)NTOK * DM * 2;
constexpr size_t WS_RK = WS_RQ + (size_t)NTOK * 512 * 2;
constexpr size_t WS_RVT = WS_RK + (size_t)NTOK * 512 * 2;
constexpr size_t WS_RG = WS_RVT + (size_t)NTOK * 512 * 2;
constexpr size_t WS_MQ = WS_RG + (size_t)NTOK * 512 * 2;
constexpr size_t WS_MK = WS_MQ + (size_t)NTOK * 512 * 2;
constexpr size_t WS_MVT = WS_MK + (size_t)NTOK * 512 * 2;
constexpr size_t WS_MIX = WS_MVT + (size_t)NTOK * 512 * 2;
constexpr size_t WS_LOGIT = WS_MIX + (size_t)NTOK * DM * 2;
constexpr size_t WS_TOPW = WS_LOGIT + (size_t)NTOK * NEXP * 4;
constexpr size_t WS_LIST = WS_TOPW + (size_t)NASSIGN * 4;
constexpr size_t WS_Y = WS_LIST + (size_t)NEXP * LIST_CAP * 4;
constexpr size_t WS_STATS = WS_Y + (size_t)(NASSIGN + NTOK) * DM * 2;
constexpr size_t WS_END = WS_STATS + (size_t)64 * 4 * 256 * 4;

constexpr size_t WS_X1 = WS_WGU;


constexpr int CW_BAR = 0;
constexpr int CW_CNT = 4096;
constexpr int CW_QATT = 4096 + 64 * 256;
constexpr int CW_QMOE = CW_QATT + 64;
constexpr int CW_MOD = 24832;
constexpr int CW_P4 = CW_QMOE + 128;

struct Params {
    const float* x; const float* c; const float* w_ada; const float* b_ada; const float* g_mix; const float* w_in;
    const float* q_gain; const float* k_gain; const float* w_out; const float* g_ffn; const float* w_router; const float* router_bias;
    const float* w_gate; const float* w_up; const float* w_down; const float* ws_gate; const float* ws_up; const float* ws_down;
    float* out; unsigned char* ws;
    int ph_lo, ph_hi;
    int prog[14];
};

DEVI unsigned pk2(float lo, float hi) { unsigned r; asm("v_cvt_pk_bf16_f32 %0, %1, %2" : "=v"(r) : "v"(lo), "v"(hi)); return r; }
DEVI float bf2f(unsigned short b) { return __uint_as_float((unsigned)b << 16); }
DEVI float bflo(unsigned u) { return __uint_as_float(u << 16); }
DEVI float bfhi(unsigned u) { return __uint_as_float(u & 0xffff0000u); }
DEVI float siluf(float v) { return v / (1.0f + __expf(-v)); }
DEVI float wave_sum(float v) {
#pragma unroll
    for (int o = 1; o < 64; o <<= 1) v += __shfl_xor(v, o);
    return v;
}
DEVI void glds16(const void* g, LAS unsigned char* l) {
    __builtin_amdgcn_global_load_lds((const __attribute__((address_space(1))) unsigned*)g, (LAS unsigned*)l, 16, 0, 0);
}
DEVI void glds16o(const void* base, unsigned off, LAS unsigned char* l) {
    __builtin_amdgcn_global_load_lds((const __attribute__((address_space(1))) unsigned*)((const __attribute__((address_space(1))) char*)base + off), (LAS unsigned*)l, 16, 0, 0);
}
DEVI bf16x8 lds128(LAS const unsigned char* p) { return *(LAS const bf16x8*)p; }
DEVI u32x2 lds64(LAS const unsigned char* p) { return *(LAS const u32x2*)p; }
#define VM_WAIT() asm volatile("s_waitcnt vmcnt(0)" ::: "memory")
DEVI const float* uniform_ptr(const float* p) {
    const unsigned long long v = (unsigned long long)p;
    const unsigned lo = __builtin_amdgcn_readfirstlane((unsigned)v), hi = __builtin_amdgcn_readfirstlane((unsigned)(v >> 32));
    return (const float*)(((unsigned long long)hi << 32) | lo);
}


#define XB_TMO      128
#define XB_XCNT(j)  (256  + 64 * (j))
#define XB_XSUB(j)  (1280 + 64 * (j))
#define XB_XGEN(j)  (2304 + 64 * (j))
#define XB_TOP      3328
#define XB_TOPGEN   3392
#define XCD_BAR_WORDS 3456
#define XB_SPIN_CAP (1u << 22)
DEVI unsigned xb_ld(unsigned* p) { return __hip_atomic_load(p, __ATOMIC_RELAXED, __HIP_MEMORY_SCOPE_AGENT); }
DEVI unsigned xb_add(unsigned* p, unsigned v) { return __hip_atomic_fetch_add(p, v, __ATOMIC_RELAXED, __HIP_MEMORY_SCOPE_AGENT); }
DEVI unsigned xb_xcc_id() { return (unsigned)__builtin_amdgcn_s_getreg((3 << 11) | 20) & 0xFu; }
#define XB_SPIN(cond, bar) do { unsigned _sp = 0; while (cond) { __builtin_amdgcn_s_sleep(1); \
    if ((++_sp & 255u) == 0u) { if (xb_ld(&(bar)[XB_TMO])) break; if (_sp > XB_SPIN_CAP) { atomicAdd(&(bar)[XB_TMO], 1u); break; } } } } while (0)
struct XcdBarrier { unsigned* bar; unsigned x; volatile LAS unsigned* st; };
DEVI XcdBarrier xcd_barrier_post(unsigned* bar, volatile LAS unsigned* st) {
    XcdBarrier b; b.bar = bar; b.x = xb_xcc_id(); b.st = st;
    if (threadIdx.x == 0) (void)xb_add(&bar[XB_XCNT(b.x)], 1u);
    return b;
}
DEVI void xcd_barrier_complete(unsigned* bar, unsigned x, unsigned& nloc, unsigned& nx) {
    const unsigned G = gridDim.x * gridDim.y * gridDim.z;
    unsigned sum, cnt, mine, sp = 0u;
    for (;;) {
        sum = 0u; cnt = 0u; mine = 0u;
#pragma unroll
        for (unsigned j = 0; j < 16; ++j) { const unsigned c = xb_ld(&bar[XB_XCNT(j)]); sum += c; cnt += (c > 0u) ? 1u : 0u; mine = (j == x) ? c : mine; }
        if (sum == G) break;
        __builtin_amdgcn_s_sleep(1);
        if ((++sp & 255u) == 0u) { if (xb_ld(&bar[XB_TMO])) break; if (sp > XB_SPIN_CAP) { atomicAdd(&bar[XB_TMO], 1u); break; } }
    }
    nloc = mine > 0u ? mine : 1u; nx = cnt > 0u ? cnt : 1u;
}
DEVI void xcd_barrier(const XcdBarrier& b) {
    asm volatile("s_waitcnt vmcnt(0)" ::: "memory");
    __syncthreads();
    if (threadIdx.x == 0) {
        unsigned* bar = b.bar;
        __builtin_amdgcn_s_waitcnt(0);
        unsigned nloc = b.st[0], nx = b.st[1];
        if (nloc == 0u) { xcd_barrier_complete(bar, b.x, nloc, nx); b.st[0] = nloc; b.st[1] = nx; }
        const unsigned old = xb_add(&bar[XB_XSUB(b.x)], 1u);
        const unsigned gen = old / nloc;
        if (old + 1u == (gen + 1u) * nloc) {
            __builtin_amdgcn_fence(__ATOMIC_RELEASE, "agent");
            asm volatile("s_waitcnt vmcnt(0)" ::: "memory");
            const unsigned og = xb_add(&bar[XB_TOP], 1u);
            const unsigned tg = og / nx;
            if (og + 1u == (tg + 1u) * nx) xb_add(&bar[XB_TOPGEN], 1u);
            else XB_SPIN(xb_ld(&bar[XB_TOPGEN]) == tg, bar);
            __builtin_amdgcn_fence(__ATOMIC_ACQUIRE, "agent");
            xb_add(&bar[XB_XGEN(b.x)], 1u);
            asm volatile("s_waitcnt vmcnt(0)" ::: "memory");
        } else {
            XB_SPIN(xb_ld(&bar[XB_XGEN(b.x)]) == gen, bar);
            __builtin_amdgcn_fence(__ATOMIC_ACQUIRE, "agent");
            asm volatile("s_waitcnt vmcnt(0)" ::: "memory");
        }
    }
    __syncthreads();
}

template <bool SWAP, int BH = 1, bool BSWZ = false>
DEVI void mma_step(f32x4 (&acc)[4][8], LAS const unsigned char* Ab, LAS const unsigned char* Bb, const int fr, const int fq) {
#pragma unroll
    for (int kk = 0; kk < 2; ++kk) {
        const int co = ((kk * 4 + fq) ^ (fr & 7)) * 16;
        const int cob0 = BSWZ ? ((kk * 4 + fq) ^ (((fr >> 2) & 3) | (((fr >> 1) & 1) << 2))) * 16 : co;
        const int cob1 = BSWZ ? (cob0 ^ 64) : co;
        bf16x8 a[4];
#pragma unroll
        for (int mt = 0; mt < 4; ++mt) a[mt] = lds128(Ab + mt * 2048 + co);
#pragma unroll
        for (int h = 0; h < BH; ++h) {
            constexpr int NB = 8 / BH;
            bf16x8 b[NB];
#pragma unroll
            for (int nt = 0; nt < NB; ++nt) b[nt] = lds128(Bb + (h * NB + nt) * 2048 + ((nt & 1) ? cob1 : cob0));
#pragma unroll
            for (int nt = 0; nt < NB; ++nt)
#pragma unroll
                for (int mt = 0; mt < 4; ++mt) {
                    if (SWAP) acc[mt][h * NB + nt] = __builtin_amdgcn_mfma_f32_16x16x32_bf16(b[nt], a[mt], acc[mt][h * NB + nt], 0, 0, 0);
                    else acc[mt][h * NB + nt] = __builtin_amdgcn_mfma_f32_16x16x32_bf16(a[mt], b[nt], acc[mt][h * NB + nt], 0, 0, 0);
                }
            __builtin_amdgcn_sched_barrier(0);
        }
    }
}

template <int NSEG, bool SWAP = true>
DEVI void gemm_tile(f32x4 (&acc)[4][8], LAS unsigned char* lds, const bf16_t* A0, const bf16_t* A1, const bf16_t* A2,
                    const bf16_t* B0, const bf16_t* B1, const bf16_t* B2,
                    const int (&aoff)[4], const int (&boff)[4], const int K, const int tid, const int nra = 4) {
    const int w = tid >> 6, lane = tid & 63, fr = lane & 15, fq = lane >> 4, wm = w >> 1, wn = w & 1;
    const int lch = ((tid & 7) ^ ((tid >> 3) & 7)) * 8;
    const int kper = K >> 6;
#pragma unroll
    for (int mt = 0; mt < 4; ++mt)
#pragma unroll
        for (int nt = 0; nt < 8; ++nt) acc[mt][nt] = (f32x4){0.f, 0.f, 0.f, 0.f};
    auto stage = [&](int buf, const bf16_t* Ab, const bf16_t* Bb, int ks) {
        const int k0 = ks * 64 + lch;
        LAS unsigned char* base = lds + buf * 65536 + tid * 16;
#pragma unroll
        for (int i = 0; i < 4; ++i) if (i < nra) glds16o(Ab, (unsigned)(aoff[i] + k0) * 2u, base + i * 8192);
#pragma unroll
        for (int i = 0; i < 4; ++i) glds16o(Bb, (unsigned)(boff[i] + k0) * 2u, base + 32768 + i * 8192);
    };
    stage(0, A0, B0, 0);
    int buf = 0;
#pragma unroll
    for (int seg = 0; seg < NSEG; ++seg) {
        const bf16_t* Ac = (seg == 0) ? A0 : (seg == 1) ? A1 : A2;
        const bf16_t* Bc = (seg == 0) ? B0 : (seg == 1) ? B1 : B2;
        const bf16_t* An = (seg == 0) ? A1 : A2;
        const bf16_t* Bn = (seg == 0) ? B1 : B2;
#pragma unroll 1
        for (int ks = 0; ks < kper; ++ks) {
            VM_WAIT();
            __syncthreads();
            if (ks + 1 < kper) stage(buf ^ 1, Ac, Bc, ks + 1);
            else if (seg + 1 < NSEG) stage(buf ^ 1, An, Bn, 0);
            if (wm < nra) mma_step<SWAP>(acc, lds + buf * 65536 + (64 * wm + fr) * 128, lds + buf * 65536 + 32768 + (128 * wn + fr) * 128, fr, fq);
            buf ^= 1;
        }
    }
}

DEVI void wf32_load_b(f32x4 (&breg)[8], const float* wbase_in, const int ldb, const int ks, const int t) {
    const float* wbase = uniform_ptr(wbase_in);
    const unsigned toff = (unsigned)((8 * ((t >> 3) & 7)) * ldb + 4 * (t & 7)) * 4u;
    const float* s = wbase + (size_t)(ks * 64) * ldb;
#pragma unroll
    for (int i = 0; i < 8; ++i) breg[i] = *(const __attribute__((address_space(1))) f32x4*)((const __attribute__((address_space(1))) char*)(s + (size_t)i * ldb) + toff);
}
DEVI void gemm_tile_wf32(f32x4 (&acc)[4][8], f32x4 (&breg)[8], LAS unsigned char* lds, const bf16_t* A0, const float* wbase_in, const int ldb,
                         const float* nbase, const int nldb, const int (&aoff)[4], const int K, int& tid) {
    const int kper = K >> 6;
#pragma unroll
    for (int mt = 0; mt < 4; ++mt)
#pragma unroll
        for (int nt = 0; nt < 8; ++nt) acc[mt][nt] = (f32x4){0.f, 0.f, 0.f, 0.f};
    auto stage_a = [&](int buf, int ks, int t) {
        const int lch = ((t & 7) ^ ((t >> 3) & 7)) * 8;
        const int k0 = ks * 64 + lch;
        LAS unsigned char* base = lds + buf * 65536 + t * 16;
#pragma unroll
        for (int i = 0; i < 4; ++i) glds16o(A0, (unsigned)(aoff[i] + k0) * 2u, base + i * 8192);
    };
    auto write_b = [&](int buf, int t) {
        const int kg = (t >> 3) & 7, n4 = t & 7;
        LAS unsigned char* base = lds + buf * 65536 + 32768 + (32 * (t >> 6) + 4 * n4) * 128;
#pragma unroll
        for (int j = 0; j < 4; ++j) {
            u32x4 o;
            o.x = pk2(breg[0][j], breg[1][j]); o.y = pk2(breg[2][j], breg[3][j]); o.z = pk2(breg[4][j], breg[5][j]); o.w = pk2(breg[6][j], breg[7][j]);
            const int swz = (n4 & 3) | ((((j >> 1) ^ (n4 >> 2)) & 1) << 2);
            *(LAS u32x4*)(base + j * 128 + ((kg ^ swz) * 16)) = o;
        }
    };
    stage_a(0, 0, tid);
    write_b(0, tid);
    wf32_load_b(breg, (kper > 1) ? wbase_in : nbase, (kper > 1) ? ldb : nldb, (kper > 1) ? 1 : 0, tid);
    int buf = 0;
#pragma unroll 1
    for (int ks = 0; ks < kper; ++ks) {
        asm volatile("" : "+v"(tid));
        asm volatile("s_waitcnt vmcnt(8)" ::: "memory");
        asm volatile("s_waitcnt lgkmcnt(0)" ::: "memory");
        __builtin_amdgcn_s_barrier();
        asm volatile("" ::: "memory");
        const bool more = ks + 1 < kper;
        if (more) stage_a(buf ^ 1, ks + 1, tid);
        {
            const int w = tid >> 6, lane = tid & 63, fr = lane & 15, fq = lane >> 4, wm = w >> 1, wn = w & 1;
            mma_step<true, 2, true>(acc, lds + buf * 65536 + (64 * wm + fr) * 128, lds + buf * 65536 + 32768 + (128 * wn + fr) * 128, fr, fq);
        }
        if (more) {
            write_b(buf ^ 1, tid);
            const bool more2 = ks + 2 < kper;
            wf32_load_b(breg, more2 ? wbase_in : nbase, more2 ? ldb : nldb, more2 ? ks + 2 : 0, tid);
        }
        buf ^= 1;
    }
}

constexpr int EPI_RS = 272, EPI_WAVE = 32 * EPI_RS;
DEVI void epi_transpose(LAS unsigned char* wl, const u32x2 (&pk)[2][8], u32x4 (&rows8)[8], const int lane) {
    const int fr = lane & 15, fq = lane >> 4;
#pragma unroll
    for (int m2 = 0; m2 < 2; ++m2)
#pragma unroll
        for (int nt = 0; nt < 8; ++nt) *(LAS u32x2*)(wl + (16 * m2 + fr) * EPI_RS + (16 * nt + 4 * fq) * 2) = pk[m2][nt];
    asm volatile("s_waitcnt lgkmcnt(0)" ::: "memory");
#pragma unroll
    for (int j = 0; j < 8; ++j) rows8[j] = *(LAS const u32x4*)(wl + (4 * j + fq) * EPI_RS + fr * 16);
    asm volatile("s_waitcnt lgkmcnt(0)" ::: "memory");
}

constexpr int EPV_RS = 144, EPV_WAVE = 64 * EPV_RS;
DEVI void epi_transpose_vt(LAS unsigned char* wl, const u32x2 (&pk)[4][4], u32x4 (&rows8)[8], const int lane) {
    const int fr = lane & 15, fq = lane >> 4;
#pragma unroll
    for (int mt = 0; mt < 4; ++mt)
#pragma unroll
        for (int n4 = 0; n4 < 4; ++n4) *(LAS u32x2*)(wl + (16 * n4 + fr) * EPV_RS + (32 * (mt >> 1) + 8 * fq + 4 * (mt & 1)) * 2) = pk[mt][n4];
    asm volatile("s_waitcnt lgkmcnt(0)" ::: "memory");
#pragma unroll
    for (int j = 0; j < 8; ++j) rows8[j] = *(LAS const u32x4*)(wl + (8 * j + (lane >> 3)) * EPV_RS + (lane & 7) * 16);
    asm volatile("s_waitcnt lgkmcnt(0)" ::: "memory");
}
constexpr int EPF_RS = 528, EPF_WAVE = 16 * EPF_RS;
DEVI void epi_transpose_f32(LAS unsigned char* wl, const f32x4 (&v)[8], f32x4 (&o)[8], const int lane) {
    const int fr = lane & 15, fq = lane >> 4;
#pragma unroll
    for (int nt = 0; nt < 8; ++nt) *(LAS f32x4*)(wl + fr * EPF_RS + (16 * nt + 4 * fq) * 4) = v[nt];
    asm volatile("s_waitcnt lgkmcnt(0)" ::: "memory");
#pragma unroll
    for (int j = 0; j < 8; ++j) o[j] = *(LAS const f32x4*)(wl + (2 * j + (lane >> 5)) * EPF_RS + (lane & 31) * 16);
    asm volatile("s_waitcnt lgkmcnt(0)" ::: "memory");
}

DEVI void transpose_item(const float* W, int N, int k0, int n0, bf16_t* dst_row0  , bf16_t* dst_lo_row0, int K, LAS float* scr, int lane) {
#pragma unroll 8
    for (int i = 0; i < 32; ++i) { const int kk = 2 * i + (lane >> 5); scr[kk * 33 + (lane & 31)] = W[(size_t)(k0 + kk) * N + n0 + (lane & 31)]; }
    asm volatile("s_waitcnt lgkmcnt(0)" ::: "memory");
    const int c = lane & 7;
#pragma unroll
    for (int j = 0; j < 4; ++j) {
        const int n = (lane >> 3) + 8 * j; const LAS float* s = scr + (8 * c) * 33 + n;
        float v[8];
#pragma unroll
        for (int q = 0; q < 8; ++q) v[q] = s[q * 33];
        unsigned ow[4];
#pragma unroll
        for (int q = 0; q < 4; ++q) ow[q] = pk2(v[2 * q], v[2 * q + 1]);
        u32x4 o; o.x = ow[0]; o.y = ow[1]; o.z = ow[2]; o.w = ow[3];
        *(u32x4*)(dst_row0 + (size_t)n * K + k0 + 8 * c) = o;
        if (dst_lo_row0) {
            unsigned lw[4];
#pragma unroll
            for (int q = 0; q < 4; ++q) lw[q] = pk2(v[2 * q] - bflo(ow[q]), v[2 * q + 1] - bfhi(ow[q]));
            u32x4 ol; ol.x = lw[0]; ol.y = lw[1]; ol.z = lw[2]; ol.w = lw[3];
            *(u32x4*)(dst_lo_row0 + (size_t)n * K + k0 + 8 * c) = ol;
        }
    }
    asm volatile("s_waitcnt lgkmcnt(0)" ::: "memory");
}

DEVI void phase0(const Params& p, LAS unsigned char* lds, int tid, int vcu, int G, unsigned* ctl) {
    unsigned char* ws = p.ws;
    const int w = tid >> 6, lane = tid & 63;
    {
        LAS float* sc = (LAS float*)lds;
        LAS float* red = (LAS float*)(lds + 32768);
        float* mod = (float*)(ws + WS_MOD);
        for (int item = vcu; item < 192; item += G) {
            for (int i = tid; i < BATCH * DM; i += NTHREADS) sc[i] = siluf(p.c[i]);
            __syncthreads();
            const int cc = tid & 31, g = tid >> 5, col = item * 32 + cc;
            float a[8];
#pragma unroll
            for (int b = 0; b < 8; ++b) a[b] = 0.f;
            const float* wp = p.w_ada + (size_t)(g * 64) * 6144 + col;
#pragma unroll 1
            for (int k0 = 0; k0 < 64; k0 += 16) {
                float wv[16];
#pragma unroll
                for (int i = 0; i < 16; ++i) wv[i] = wp[(size_t)(k0 + i) * 6144];
#pragma unroll
                for (int i = 0; i < 16; ++i)
#pragma unroll
                    for (int b = 0; b < 8; ++b) a[b] += sc[b * DM + g * 64 + k0 + i] * wv[i];
            }
#pragma unroll
            for (int b = 0; b < 8; ++b) red[(g * 8 + b) * 32 + cc] = a[b];
            __syncthreads();
            if (tid < 256) {
                const int b = tid >> 5, c2 = tid & 31;
                float s = 0.f;
#pragma unroll
                for (int gg = 0; gg < 16; ++gg) s += red[(gg * 8 + b) * 32 + c2];
                __hip_atomic_store((__attribute__((address_space(1))) float*)(mod + b * 6144 + item * 32 + c2), s + p.b_ada[item * 32 + c2], __ATOMIC_RELAXED, __HIP_MEMORY_SCOPE_AGENT);
            }
            asm volatile("s_waitcnt vmcnt(0)" ::: "memory");
            __syncthreads();
            if (tid == 0) (void)xb_add(&ctl[CW_MOD], 1u);
        }
    }
    {
        float* kmz = (float*)(ws + WS_KMEAN);
        for (int i = vcu * NTHREADS + tid; i < 8 * 8 * 8 * 64; i += G * NTHREADS) kmz[i] = 0.f;
        float* cosT = (float*)(ws + WS_ROPE); float* sinT = cosT + SEQ * 64;
        for (int i = vcu * NTHREADS + tid; i < SEQ * 64; i += G * NTHREADS) {
            const int pos = i >> 6, j = i & 63;
            const float inv = powf(10000.0f, -(float)j / 64.0f);
            const float ang = (float)pos * inv;
            cosT[i] = cosf(ang); sinT[i] = sinf(ang);
        }
    }
    {
        LAS float* scr = (LAS float*)(lds + w * 8448);
        const int gw = vcu * NWAVES + w, NGW = G * NWAVES;
        constexpr int I_IN = 16 * (INC / 32), I_OUT = 16 * 32, I_R = 16 * 8;
        constexpr int I_TOTAL = I_IN + I_OUT + I_R;
        bf16_t* win = (bf16_t*)(ws + WS_WIN); bf16_t* wout = (bf16_t*)(ws + WS_WOUT); bf16_t* wr = (bf16_t*)(ws + WS_WR);
        for (int it = gw; it < I_TOTAL; it += NGW) {
            int r = it;
            if (r < I_IN) { const int nb = INC / 32, kb = r / nb, n0 = (r % nb) * 32; transpose_item(p.w_in, INC, kb * 64, n0, win + (size_t)n0 * DM, nullptr, DM, scr, lane); continue; } r -= I_IN;
            if (r < I_OUT) { const int kb = r / 32, n0 = (r % 32) * 32; transpose_item(p.w_out, DM, kb * 64, n0, wout + (size_t)n0 * DM, nullptr, DM, scr, lane); continue; } r -= I_OUT;
            { const int kb = r / 8, n0 = (r % 8) * 32; transpose_item(p.w_router, NEXP, kb * 64, n0, wr + (size_t)n0 * DM, wr + (size_t)(NEXP + n0) * DM, DM, scr, lane); }
        }
    }
}

template <bool LO>
DEVI void rownorm_phase(const float* X, const float* g, const float* mod, int sh_off, int sc_off, bf16_t* Hhi, bf16_t* Hlo, int tid, int vcu, int G) {
    const int w = tid >> 6, lane = tid & 63;
    const int gw = vcu * NWAVES + w, NGW = G * NWAVES;
    for (int row = gw; row < NTOK; row += NGW) {
        const int b = row >> 11;
        const f32x4* xr = (const f32x4*)(X + (size_t)row * DM) + lane;
        f32x4 v[4]; float s = 0.f;
#pragma unroll
        for (int j = 0; j < 4; ++j) { v[j] = xr[64 * j]; s += (v[j].x * v[j].x + v[j].y * v[j].y) + (v[j].z * v[j].z + v[j].w * v[j].w); }
        const float rstd = rsqrtf(wave_sum(s) * (1.0f / DM) + EPS);
#pragma unroll
        for (int j = 0; j < 4; ++j) {
            const int col = 4 * lane + 256 * j;
            const f32x4 gg = *(const f32x4*)(g + col);
            const f32x4 sc = *(const f32x4*)(mod + b * 6144 + sc_off + col);
            const f32x4 sh = *(const f32x4*)(mod + b * 6144 + sh_off + col);
            f32x4 h = v[j] * rstd * gg * (sc + 1.0f) + sh;
            u32x2 o; o.x = pk2(h.x, h.y); o.y = pk2(h.z, h.w);
            *(u32x2*)(Hhi + (size_t)row * DM + col) = o;
            if (LO) {
                u32x2 ol; ol.x = pk2(h.x - bflo(o.x), h.y - bfhi(o.x)); ol.y = pk2(h.z - bflo(o.y), h.w - bfhi(o.y));
                *(u32x2*)(Hlo + (size_t)row * DM + col) = ol;
            }
        }
    }
}

DEVI void phase2(const Params& p, LAS unsigned char* lds, int tid, int vcu, int G) {
    unsigned char* ws = p.ws;
    const bf16_t* H = (const bf16_t*)(ws + WS_H1); const bf16_t* WT = (const bf16_t*)(ws + WS_WIN);
    const float* cosT = (const float*)(ws + WS_ROPE); const float* sinT = cosT + SEQ * 64;
    for (int it = vcu; it < 768 + 256; it += G) {
        asm volatile("" : "+v"(tid));
        const int w = tid >> 6, lane = tid & 63, fr = lane & 15, fq = lane >> 4;
        const bool halfm = it >= 768;
        const int id = halfm ? 768 + ((it - 768) >> 1) : it, rh = halfm ? ((it - 768) & 1) : 0, nra = halfm ? 2 : 4;
        const int pm = id / 14, pn = id % 14;
        int aoff[4], boff[4];
#pragma unroll
        for (int i = 0; i < 4; ++i) { aoff[i] = (pm * 256 + 128 * rh + (i & (nra - 1)) * 64 + (tid >> 3)) * DM; boff[i] = (pn * 256 + i * 64 + (tid >> 3)) * DM; }
        f32x4 acc[4][8];
        const int cat = pn >> 1, half = pn & 1;
        const int wm = w >> 1, wn = w & 1;
        const bool wact = wm < nra;
        if (cat == 2 || cat == 6) gemm_tile<1, false>(acc, lds, H, H, H, WT, WT, WT, aoff, boff, DM, tid, nra);
        else gemm_tile<1, true>(acc, lds, H, H, H, WT, WT, WT, aoff, boff, DM, tid, nra);
        const int b = pm >> 3, s0 = (pm & 7) * 256 + 128 * rh + 64 * wm;
        const bool isk = (cat == 5);
        LAS float* red = (LAS float*)(lds + 98304);
        __syncthreads();
        if (!wact) {
        } else if (cat == 2 || cat == 6) {
            bf16_t* dst = (bf16_t*)(ws + (cat == 2 ? WS_RVT : WS_MVT));
            LAS unsigned char* wl = lds + w * EPV_WAVE;
#pragma unroll
            for (int hf = 0; hf < 2; ++hf) {
                u32x2 pk[4][4];
#pragma unroll
                for (int mt = 0; mt < 4; ++mt)
#pragma unroll
                    for (int n4 = 0; n4 < 4; ++n4) { const f32x4 v = acc[mt][4 * hf + n4]; pk[mt][n4].x = pk2(v.x, v.y); pk[mt][n4].y = pk2(v.z, v.w); }
                u32x4 rows8[8];
                epi_transpose_vt(wl, pk, rows8, lane);
                const size_t rowbase = (size_t)b * 512 + 256 * half + 128 * wn + 64 * hf + (lane >> 3);
#pragma unroll
                for (int j = 0; j < 8; ++j) *(u32x4*)(dst + (rowbase + 8 * j) * SEQ + s0 + 8 * (lane & 7)) = rows8[j];
            }
        } else {
            LAS unsigned char* wl = lds + w * EPI_WAVE;
            const float* gain = isk ? p.k_gain : p.q_gain;
#pragma unroll
            for (int hf = 0; hf < 2; ++hf) {
                u32x2 pk[2][8];
                if (cat <= 1) {
                    const float lgh = log2f(1.0f - exp2f(-5.0f - (float)(2 * half + wn)));
                    const float sclb = (cat == 1) ? 0.08838834764831845f : 1.0f, lgs = (cat == 1) ? -lgh : lgh;
#pragma unroll
                    for (int m2 = 0; m2 < 2; ++m2) {
                        const int s = s0 + 32 * hf + 16 * m2 + fr;
                        const float scl = sclb * exp2f(lgs * (float)(s - 1024));
#pragma unroll
                        for (int np = 0; np < 4; ++np) {
                            const f32x4 cs = *(const f32x4*)(cosT + s * 64 + 16 * np + 4 * fq) * scl;
                            const f32x4 sn = *(const f32x4*)(sinT + s * 64 + 16 * np + 4 * fq) * scl;
                            const f32x4 x1 = acc[2 * hf + m2][np], x2 = acc[2 * hf + m2][np + 4];
                            const f32x4 o1 = x1 * cs - x2 * sn, o2 = x1 * sn + x2 * cs;
                            pk[m2][np].x = pk2(o1.x, o1.y); pk[m2][np].y = pk2(o1.z, o1.w);
                            pk[m2][np + 4].x = pk2(o2.x, o2.y); pk[m2][np + 4].y = pk2(o2.z, o2.w);
                        }
                    }
                } else if (cat == 3) {
#pragma unroll
                    for (int m2 = 0; m2 < 2; ++m2)
#pragma unroll
                        for (int nt = 0; nt < 8; ++nt) { const f32x4 v = acc[2 * hf + m2][nt]; pk[m2][nt].x = pk2(siluf(v.x), siluf(v.y)); pk[m2][nt].y = pk2(siluf(v.z), siluf(v.w)); }
                } else {
#pragma unroll
                    for (int hh = 0; hh < 2; ++hh) {
                        float rstd[2];
#pragma unroll
                        for (int m2 = 0; m2 < 2; ++m2) {
                            float ss = 0.f;
#pragma unroll
                            for (int np = 0; np < 4; ++np) { const f32x4 v = acc[2 * hf + m2][4 * hh + np]; ss += (v.x * v.x + v.y * v.y) + (v.z * v.z + v.w * v.w); }
                            ss += __shfl_xor(ss, 16); ss += __shfl_xor(ss, 32);
                            rstd[m2] = rsqrtf(ss * (1.0f / 64.0f) + EPS);
                        }
#pragma unroll
                        for (int np = 0; np < 4; ++np) {
                            const f32x4 gn = *(const f32x4*)(gain + 16 * np + 4 * fq) * (isk ? 1.0f : 0.125f * 1.4426950408889634f);
                            f32x4 cs = (f32x4){0.f, 0.f, 0.f, 0.f};
#pragma unroll
                            for (int m2 = 0; m2 < 2; ++m2) {
                                const f32x4 v = acc[2 * hf + m2][4 * hh + np] * rstd[m2] * gn;
                                cs += v;
                                pk[m2][4 * hh + np].x = pk2(v.x, v.y); pk[m2][4 * hh + np].y = pk2(v.z, v.w);
                            }
                            if (isk) {
#pragma unroll
                                for (int r = 0; r < 4; ++r) {
                                    float v = cs[r];
                                    v += __shfl_xor(v, 1); v += __shfl_xor(v, 2); v += __shfl_xor(v, 4); v += __shfl_xor(v, 8);
                                    if (fr == 0) { LAS float* rp = red + wm * 256 + 128 * wn + 64 * hh + 16 * np + 4 * fq + r; if (hf == 0) *rp = v; else *rp += v; }
                                }
                            }
                        }
                    }
                }
                u32x4 rows8[8];
                epi_transpose(wl, pk, rows8, lane);
#pragma unroll
                for (int j = 0; j < 8; ++j) {
                    const int s = s0 + 32 * hf + 4 * j + fq;
                    bf16_t* d;
                    if (cat <= 1) d = (bf16_t*)(ws + (cat == 0 ? WS_RQ : WS_RK)) + ((size_t)((b * 4 + 2 * half + wn) * SEQ + s)) * 128 + 8 * fr;
                    else if (cat == 3) d = (bf16_t*)(ws + WS_RG) + ((size_t)b * SEQ + s) * 512 + 256 * half + 128 * wn + 8 * fr;
                    else d = (bf16_t*)(ws + (isk ? WS_MK : WS_MQ)) + ((size_t)((b * 8 + 4 * half + 2 * wn + (fr >> 3)) * SEQ + s)) * 64 + 8 * (fr & 7);
                    *(u32x4*)d = rows8[j];
                }
            }
        }
        if (isk) {
            __syncthreads();
            if (tid < 256) {
                float* km = (float*)(ws + WS_KMEAN) + ((size_t)((b * 8 + 4 * half + (tid >> 6)) * 8 + (pm & 7))) * 64 + (tid & 63);
                if (halfm) atomicAdd(km, (red[tid] + red[256 + tid]) * (1.0f / 256.0f));
                else *km = ((red[tid] + red[256 + tid]) + (red[512 + tid] + red[768 + tid])) * (1.0f / 256.0f);
            }
        }
        __syncthreads();
    }
}

template <int D, bool MOBA>
DEVI void attn_unit(const Params& p, LAS unsigned char* lds, int b, int h, int qb, int tid) {
    unsigned char* ws = p.ws;
    constexpr int H = MOBA ? 8 : 4, KK = D / 32, DT = D / 16, RB = D * 2, TILE = 64 * RB, MASK = (D == 64) ? 7 : 15, ROUNDS = TILE / 8192;
    const int w = tid >> 6, lane = tid & 63, fr = lane & 15, fq = lane >> 4;
    const bf16_t* Q = (const bf16_t*)(ws + (MOBA ? WS_MQ : WS_RQ));
    const bf16_t* Kp = (const bf16_t*)(ws + (MOBA ? WS_MK : WS_RK));
    const bf16_t* VT = (const bf16_t*)(ws + (MOBA ? WS_MVT : WS_RVT));
    const size_t qk_base = (size_t)(b * H + h) * SEQ * D, vt_base = (size_t)(b * H + h) * D * SEQ;
    const int q0 = qb * 256 + 32 * w;
    LAS unsigned char* misc = lds + LDS_MISC;
    unsigned selm[2] = {0u, 0u};
    if (MOBA) {
        LAS float* km = (LAS float*)(misc + MISC_KM);
        LAS unsigned char* sel = misc + MISC_SEL;
        const float* kmg = (const float*)(ws + WS_KMEAN) + (size_t)((b * 8 + h) * 8) * 64;
        if (tid < 448 && (tid >> 6) < qb) km[tid] = kmg[tid];
        __syncthreads();
        if (tid < 256) {
            unsigned m = 0u;
            if (qb <= 3) m = (1u << qb) - 1u;
            else {
                float t0 = -INFINITY, t1 = -INFINITY, t2 = -INFINITY; int i0 = 0, i1 = 0, i2 = 0;
                const u32x4* qr = (const u32x4*)(Q + qk_base + (size_t)(qb * 256 + tid) * 64);
                u32x4 qv[8];
#pragma unroll
                for (int c = 0; c < 8; ++c) qv[c] = qr[c];
#pragma unroll 1
                for (int kb = 0; kb < qb; ++kb) {
                    const LAS f32x4* kr = (const LAS f32x4*)(km + kb * 64);
                    float g = 0.f;
#pragma unroll
                    for (int c = 0; c < 8; ++c) {
                        const f32x4 k0 = kr[2 * c], k1 = kr[2 * c + 1];
                        g += bflo(qv[c].x) * k0.x + bfhi(qv[c].x) * k0.y + bflo(qv[c].y) * k0.z + bfhi(qv[c].y) * k0.w
                           + bflo(qv[c].z) * k1.x + bfhi(qv[c].z) * k1.y + bflo(qv[c].w) * k1.z + bfhi(qv[c].w) * k1.w;
                    }
                    if (g > t0) { t2 = t1; i2 = i1; t1 = t0; i1 = i0; t0 = g; i0 = kb; }
                    else if (g > t1) { t2 = t1; i2 = i1; t1 = g; i1 = kb; }
                    else if (g > t2) { t2 = g; i2 = kb; }
                }
                m = (1u << i0) | (1u << i1) | (1u << i2);
            }
            sel[tid] = (unsigned char)m;
        }
        __syncthreads();
        selm[0] = sel[32 * w + fr]; selm[1] = sel[32 * w + 16 + fr];
    }
    bf16x8 qf[2][KK];
#pragma unroll
    for (int qt = 0; qt < 2; ++qt)
#pragma unroll
        for (int kk = 0; kk < KK; ++kk) qf[qt][kk] = *(const bf16x8*)(Q + qk_base + (size_t)(q0 + 16 * qt + fr) * D + kk * 32 + fq * 8);
    f32x4 o[DT][2];
#pragma unroll
    for (int dt = 0; dt < DT; ++dt) { o[dt][0] = (f32x4){0.f, 0.f, 0.f, 0.f}; o[dt][1] = (f32x4){0.f, 0.f, 0.f, 0.f}; }
    float mrun[2] = {-INFINITY, -INFINITY}, lrun[2] = {0.f, 0.f};
    float mfix = 0.f; bool usefix = false;
    if (MOBA) {
        float gq = fabsf(p.q_gain[lane]), gk = fabsf(p.k_gain[lane]);
#pragma unroll
        for (int o = 1; o < 64; o <<= 1) { gq = fmaxf(gq, __shfl_xor(gq, o)); gk = fmaxf(gk, __shfl_xor(gk, o)); }
        const float smax = 8.0f * gq * gk * 1.02f;
        mfix = smax * 1.4426950408889634f;
        usefix = __builtin_amdgcn_readfirstlane((int)(smax < 40.0f)) != 0;
    }
    const int ntiles = 4 * (qb + 1);
    auto tile_ks = [&](int i) -> int {
        if (MOBA) { const int kb = (i < 4) ? qb : ((i - 4) >> 2); return kb * 256 + (i & 3) * 64; }
        return i * 64;
    };
    auto stage = [&](int buf, int i) {
        const int ks = tile_ks(i);
        LAS unsigned char* base = lds + buf * (2 * TILE);
#pragma unroll
        for (int r = 0; r < ROUNDS; ++r) {
            int row, lchunk;
            if (D == 64) { row = tid >> 3; lchunk = (tid & 7) ^ (row & 7); }
            else { row = r * 32 + (tid >> 4); lchunk = (tid & 15) ^ (row & 15); }
            glds16(Kp + qk_base + (size_t)(ks + row) * D + lchunk * 8, base + r * 8192 + tid * 16);
            const int d = r * 64 + (tid >> 3), lc2 = (tid & 7) ^ ((d >> 1) & 7);
            glds16(VT + vt_base + (size_t)d * SEQ + ks + lc2 * 8, base + TILE + r * 8192 + tid * 16);
        }
    };
    stage(0, 0); stage(1, 1);
    const int npairs = ntiles >> 1;
    for (int jp = 0; jp < npairs; ++jp) {
        VM_WAIT();
        __syncthreads();
        if (jp + 1 < npairs) { stage(((jp + 1) & 1) * 2, 2 * jp + 2); stage(((jp + 1) & 1) * 2 + 1, 2 * jp + 3); }
#pragma unroll 1
      for (int hp = 0; hp < 2; ++hp) {
        const int i = 2 * jp + hp;
        const int ks = tile_ks(i);
        const int kb = ks >> 8;
        const bool own = (kb == qb);
        if (ks > q0 + 31) continue;
        LAS const unsigned char* Kb = lds + ((jp & 1) * 2 + hp) * (2 * TILE);
        LAS const unsigned char* Vb = Kb + TILE;
        float bi0 = 0.f, bi1 = 0.f;
        if (MOBA) {
            const float bsel = usefix ? -mfix : 0.f;
            bi0 = (own || ((selm[0] >> kb) & 1u)) ? bsel : -1.0e30f;
            bi1 = (own || ((selm[1] >> kb) & 1u)) ? bsel : -1.0e30f;
        }
        f32x4 s[2][4];
#pragma unroll
        for (int kt = 0; kt < 4; ++kt) {
            s[0][kt] = (f32x4){bi0, bi0, bi0, bi0}; s[1][kt] = (f32x4){bi1, bi1, bi1, bi1};
#pragma unroll
            for (int kk = 0; kk < KK; ++kk) {
                const bf16x8 kf = lds128(Kb + (16 * kt + fr) * RB + (((kk * 4 + fq) ^ (fr & MASK)) * 16));
                s[0][kt] = __builtin_amdgcn_mfma_f32_16x16x32_bf16(kf, qf[0][kk], s[0][kt], 0, 0, 0);
                s[1][kt] = __builtin_amdgcn_mfma_f32_16x16x32_bf16(kf, qf[1][kk], s[1][kt], 0, 0, 0);
            }
        }
        unsigned pw[2][2][4];
        if (MOBA) {
            const bool diag = own && (ks + 63 > q0);
            if (usefix) {
#pragma unroll
                for (int qt = 0; qt < 2; ++qt) {
                    const int qpos = q0 + 16 * qt + fr;
                    float ls = 0.f;
                    if (diag) {
#pragma unroll
                        for (int kt = 0; kt < 4; ++kt) {
                            float pv[4];
#pragma unroll
                            for (int r = 0; r < 4; ++r) { pv[r] = __builtin_amdgcn_exp2f((ks + 16 * kt + 4 * fq + r <= qpos) ? s[qt][kt][r] : -INFINITY); ls += pv[r]; }
                            pw[qt][kt >> 1][(kt & 1) * 2 + 0] = pk2(pv[0], pv[1]);
                            pw[qt][kt >> 1][(kt & 1) * 2 + 1] = pk2(pv[2], pv[3]);
                        }
                    } else {
#pragma unroll
                        for (int kt = 0; kt < 4; ++kt) {
                            float pv[4];
#pragma unroll
                            for (int r = 0; r < 4; ++r) { pv[r] = __builtin_amdgcn_exp2f(s[qt][kt][r]); ls += pv[r]; }
                            pw[qt][kt >> 1][(kt & 1) * 2 + 0] = pk2(pv[0], pv[1]);
                            pw[qt][kt >> 1][(kt & 1) * 2 + 1] = pk2(pv[2], pv[3]);
                        }
                    }
                    lrun[qt] += ls;
                }
            } else
#pragma unroll
            for (int qt = 0; qt < 2; ++qt) {
                const int qpos = q0 + 16 * qt + fr;
                float sv[4][4]; float mx = -INFINITY;
                if (diag) {
#pragma unroll
                    for (int kt = 0; kt < 4; ++kt)
#pragma unroll
                        for (int r = 0; r < 4; ++r) {
                            const int kpos = ks + 16 * kt + 4 * fq + r;
                            sv[kt][r] = (kpos <= qpos) ? s[qt][kt][r] : -INFINITY;
                            mx = fmaxf(mx, sv[kt][r]);
                        }
                } else {
#pragma unroll
                    for (int kt = 0; kt < 4; ++kt)
#pragma unroll
                        for (int r = 0; r < 4; ++r) { sv[kt][r] = s[qt][kt][r]; mx = fmaxf(mx, sv[kt][r]); }
                }
                mx = fmaxf(mx, __shfl_xor(mx, 16)); mx = fmaxf(mx, __shfl_xor(mx, 32));
                const float mnew = fmaxf(mrun[qt], mx);
                const float msub = (mnew == -INFINITY) ? 0.f : mnew;
                if (__builtin_amdgcn_ballot_w64(mnew != mrun[qt]) != 0ull) {
                    const float alpha = (mnew == -INFINITY) ? 1.0f : __builtin_amdgcn_exp2f(mrun[qt] - mnew);
                    lrun[qt] *= alpha;
#pragma unroll
                    for (int dt = 0; dt < DT; ++dt) o[dt][qt] *= alpha;
                }
                mrun[qt] = mnew;
                float ls = 0.f;
#pragma unroll
                for (int kt = 0; kt < 4; ++kt) {
                    float pv[4];
#pragma unroll
                    for (int r = 0; r < 4; ++r) { pv[r] = __builtin_amdgcn_exp2f(sv[kt][r] - msub); ls += pv[r]; }
                    pw[qt][kt >> 1][(kt & 1) * 2 + 0] = pk2(pv[0], pv[1]);
                    pw[qt][kt >> 1][(kt & 1) * 2 + 1] = pk2(pv[2], pv[3]);
                }
                lrun[qt] += ls;
            }
        } else {
#pragma unroll
            for (int qt = 0; qt < 2; ++qt) {
                const int qpos = q0 + 16 * qt + fr;
#pragma unroll
                for (int kt = 0; kt < 4; ++kt) {
                    float pv[4];
#pragma unroll
                    for (int r = 0; r < 4; ++r) {
                        const int kpos = ks + 16 * kt + 4 * fq + r;
                        pv[r] = (kpos <= qpos) ? s[qt][kt][r] : 0.f;
                    }
                    pw[qt][kt >> 1][(kt & 1) * 2 + 0] = pk2(pv[0], pv[1]);
                    pw[qt][kt >> 1][(kt & 1) * 2 + 1] = pk2(pv[2], pv[3]);
                }
            }
        }
#pragma unroll
        for (int sh = 0; sh < 2; ++sh) {
            bf16x8 pb[2];
#pragma unroll
            for (int qt = 0; qt < 2; ++qt) { u32x4 t; t.x = pw[qt][sh][0]; t.y = pw[qt][sh][1]; t.z = pw[qt][sh][2]; t.w = pw[qt][sh][3]; pb[qt] = __builtin_bit_cast(bf16x8, t); }
#pragma unroll
            for (int dt = 0; dt < DT; ++dt) {
                const bf16x8 vf = lds128(Vb + (16 * dt + fr) * 128 + (((4 * sh + fq) ^ ((fr >> 1) & 7)) * 16));
                o[dt][0] = __builtin_amdgcn_mfma_f32_16x16x32_bf16(vf, pb[0], o[dt][0], 0, 0, 0);
                o[dt][1] = __builtin_amdgcn_mfma_f32_16x16x32_bf16(vf, pb[1], o[dt][1], 0, 0, 0);
            }
        }
      }
    }
    bf16_t* mix = (bf16_t*)(ws + WS_MIX);
#pragma unroll
    for (int qt = 0; qt < 2; ++qt) {
        const size_t tok = (size_t)b * SEQ + q0 + 16 * qt + fr;
        if (MOBA) {
            float l = lrun[qt]; l += __shfl_xor(l, 16); l += __shfl_xor(l, 32);
            const float inv = 1.0f / l;
#pragma unroll
            for (int dt = 0; dt < DT; ++dt) {
                const f32x4 v = o[dt][qt] * inv;
                u32x2 ov; ov.x = pk2(v.x, v.y); ov.y = pk2(v.z, v.w);
                *(u32x2*)(mix + tok * DM + 512 + h * 64 + 16 * dt + 4 * fq) = ov;
            }
        } else {
            float ss = 0.f;
#pragma unroll
            for (int dt = 0; dt < DT; ++dt) { const f32x4 v = o[dt][qt]; ss += (v.x * v.x + v.y * v.y) + (v.z * v.z + v.w * v.w); }
            ss += __shfl_xor(ss, 16); ss += __shfl_xor(ss, 32);
            const float rstd = rsqrtf(ss * (1.0f / 128.0f) + EPS);
            const bf16_t* rg = (const bf16_t*)(ws + WS_RG);
#pragma unroll
            for (int dt = 0; dt < DT; ++dt) {
                const u32x2 gv = *(const u32x2*)(rg + tok * 512 + h * 128 + 16 * dt + 4 * fq);
                const f32x4 v = o[dt][qt] * rstd;
                u32x2 ov; ov.x = pk2(v.x * bflo(gv.x), v.y * bfhi(gv.x)); ov.y = pk2(v.z * bflo(gv.y), v.w * bfhi(gv.y));
                *(u32x2*)(mix + tok * DM + h * 128 + 16 * dt + 4 * fq) = ov;
            }
        }
    }
}

DEVI void phase3(const Params& p, LAS unsigned char* lds, int tid, unsigned* ctl) {
    LAS int* scal = (LAS int*)(lds + LDS_MISC + MISC_SCAL);
    for (;;) {
        asm volatile("" : "+v"(tid));
        __syncthreads();
        if (tid == 0) scal[0] = (int)atomicAdd(&ctl[CW_QATT], 1u);
        __syncthreads();
        const int u = scal[0];
        if (u >= 768) break;
        if (u < 256) {
            const int qb = 7 - (u >> 5), bh = u & 31;
            attn_unit<128, false>(p, lds, bh >> 2, bh & 3, qb, tid);
        } else {
            const int v = u - 256, qb = 7 - (v >> 6), bh = v & 63;
            attn_unit<64, true>(p, lds, bh >> 3, bh & 7, qb, tid);
        }
    }
}

template <bool FUSE>
DEVI void phase4(const Params& p, LAS unsigned char* lds, int tid, int vcu, int G, unsigned* ctl) {
    unsigned char* ws = p.ws;
    const bf16_t* A = (const bf16_t*)(ws + WS_MIX); const bf16_t* WT = (const bf16_t*)(ws + WS_WOUT);
    const float* mod = (const float*)(ws + WS_MOD);
    float* x1 = (float*)(ws + WS_X1);
    for (int id = vcu; id < 256; id += G) {
        asm volatile("" : "+v"(tid));
        const int w = tid >> 6, lane = tid & 63, fr = lane & 15, fq = lane >> 4;
        const int pm = id >> 2, pn = id & 3;
        int aoff[4], boff[4];
#pragma unroll
        for (int i = 0; i < 4; ++i) { aoff[i] = (pm * 256 + i * 64 + (tid >> 3)) * DM; boff[i] = (pn * 256 + i * 64 + (tid >> 3)) * DM; }
        f32x4 acc[4][8];
        gemm_tile<1>(acc, lds, A, A, A, WT, WT, WT, aoff, boff, DM, tid);
        const int b = pm >> 3, wm = w >> 1, wn = w & 1;
        __syncthreads();
        LAS unsigned char* wl = lds + w * EPF_WAVE;
        LAS float* rowss = (LAS float*)(lds + 98304);
#pragma unroll
        for (int mt = 0; mt < 4; ++mt) {
            f32x4 o[8];
            epi_transpose_f32(wl, acc[mt], o, lane);
            const int col = pn * 256 + 128 * wn + 4 * (lane & 31);
            const f32x4 gt = *(const f32x4*)(mod + b * 6144 + 2048 + col);
#pragma unroll
            for (int j = 0; j < 8; ++j) {
                const int row = 64 * wm + 16 * mt + 2 * j + (lane >> 5);
                const size_t tok = (size_t)pm * 256 + row;
                const f32x4 xv = *(const f32x4*)(p.x + tok * DM + col);
                const f32x4 v = xv + gt * o[j];
                *(f32x4*)(x1 + tok * DM + col) = v;
                if (FUSE) {
                    float ss = (v.x * v.x + v.y * v.y) + (v.z * v.z + v.w * v.w);
                    ss += __shfl_xor(ss, 1); ss += __shfl_xor(ss, 2); ss += __shfl_xor(ss, 4); ss += __shfl_xor(ss, 8); ss += __shfl_xor(ss, 16);
                    if ((lane & 31) == 0) rowss[wn * 256 + row] = ss;
                }
            }
        }
        if (FUSE) {
            __attribute__((address_space(1))) float* stats = (__attribute__((address_space(1))) float*)(ws + WS_STATS) + (size_t)pm * 1024;
            __syncthreads();
            if (tid < 256) __hip_atomic_store(stats + pn * 256 + tid, rowss[tid] + rowss[256 + tid], __ATOMIC_RELAXED, __HIP_MEMORY_SCOPE_AGENT);
            asm volatile("s_waitcnt vmcnt(0)" ::: "memory");
            __syncthreads();
            if (tid == 0) {
                unsigned* cw = ctl + CW_P4 + 64 * pm;
                (void)xb_add(cw, 1u);
                unsigned sp = 0;
                while (xb_ld(cw) < 4u && ++sp < (1u << 20)) __builtin_amdgcn_s_sleep(1);
                __builtin_amdgcn_fence(__ATOMIC_ACQUIRE, "agent");
                asm volatile("s_waitcnt vmcnt(0)" ::: "memory");
            }
            __syncthreads();
            if (tid < 256) {
                float s = 0.f;
#pragma unroll
                for (int q = 0; q < 4; ++q) s += __hip_atomic_load(stats + q * 256 + tid, __ATOMIC_RELAXED, __HIP_MEMORY_SCOPE_AGENT);
                rowss[512 + tid] = rsqrtf(s * (1.0f / DM) + EPS);
            }
            __syncthreads();
            bf16_t* Hhi = (bf16_t*)(ws + WS_H1); bf16_t* Hlo = (bf16_t*)(ws + WS_H2LO);
            const int col = pn * 256 + 128 * wn + 4 * (lane & 31);
            const f32x4 gg = *(const f32x4*)(p.g_ffn + col);
            const f32x4 sc = *(const f32x4*)(mod + b * 6144 + 4096 + col) + 1.0f;
            const f32x4 sh = *(const f32x4*)(mod + b * 6144 + 3072 + col);
#pragma unroll 4
            for (int rr = 0; rr < 32; ++rr) {
                const int row = 64 * wm + 2 * rr + (lane >> 5);
                const size_t tok = (size_t)pm * 256 + row;
                const f32x4 v = *(const f32x4*)(x1 + tok * DM + col);
                const f32x4 h = v * rowss[512 + row] * gg * sc + sh;
                u32x2 o; o.x = pk2(h.x, h.y); o.y = pk2(h.z, h.w);
                *(u32x2*)(Hhi + tok * DM + col) = o;
                u32x2 ol; ol.x = pk2(h.x - bflo(o.x), h.y - bfhi(o.x)); ol.y = pk2(h.z - bflo(o.y), h.w - bfhi(o.y));
                *(u32x2*)(Hlo + tok * DM + col) = ol;
            }
            asm volatile("s_waitcnt vmcnt(0)" ::: "memory");
            __syncthreads();
            {
                const bf16_t* Wh = (const bf16_t*)(ws + WS_WR); const bf16_t* Wl = Wh + (size_t)NEXP * DM;
#pragma unroll
                for (int i = 0; i < 4; ++i) { aoff[i] = (pm * 256 + i * 64 + (tid >> 3)) * DM + 256 * pn; boff[i] = (i * 64 + (tid >> 3)) * DM + 256 * pn; }
                gemm_tile<3>(acc, lds, Hlo, Hhi, Hhi, Wh, Wl, Wh, aoff, boff, 256, tid);
                float* dst = (float*)(ws + WS_RQ) + (size_t)pn * NTOK * NEXP;
#pragma unroll
                for (int mt = 0; mt < 4; ++mt) {
                    const size_t tok = (size_t)pm * 256 + 64 * wm + 16 * mt + fr;
#pragma unroll
                    for (int nt = 0; nt < 8; ++nt) *(f32x4*)(dst + tok * NEXP + 128 * wn + 16 * nt + 4 * fq) = acc[mt][nt];
                }
            }
        }
        __syncthreads();
    }
}

constexpr int RR = 8;
DEVI float wave_max(float v) {
#pragma unroll
    for (int o = 1; o < 64; o <<= 1) v = fmaxf(v, __shfl_xor(v, o));
    return v;
}
DEVI void route_rows(const Params& p, unsigned char* ws, unsigned* ctl, int tok0, int lane) {
    const float* part = (const float*)(ws + WS_RQ);
    const f32x4 b4 = *(const f32x4*)(p.router_bias + 4 * lane);
    float sc[RR][4], ch[RR][4];
#pragma unroll
    for (int q = 0; q < RR; ++q) {
        const size_t off = (size_t)(tok0 + q) * NEXP + 4 * lane;
        f32x4 l4 = *(const f32x4*)(part + off);
#pragma unroll
        for (int j = 1; j < 4; ++j) l4 += *(const f32x4*)(part + (size_t)j * NTOK * NEXP + off);
        float bi[4];
#pragma unroll
        for (int j = 0; j < 4; ++j) { sc[q][j] = 1.0f / (1.0f + __expf(-l4[j])); bi[j] = sc[q][j] + b4[j]; }
        float t1 = fmaxf(bi[0], bi[1]), t2 = fminf(bi[0], bi[1]);
        { const float a1 = fmaxf(bi[2], bi[3]), a2 = fminf(bi[2], bi[3]); const float n1 = fmaxf(t1, a1), n2 = fmaxf(fminf(t1, a1), fmaxf(t2, a2)); t1 = n1; t2 = n2; }
#pragma unroll
        for (int o = 1; o < 8; o <<= 1) {
            const float a1 = __shfl_xor(t1, o), a2 = __shfl_xor(t2, o);
            const float n1 = fmaxf(t1, a1), n2 = fmaxf(fminf(t1, a1), fmaxf(t2, a2)); t1 = n1; t2 = n2;
        }
        const float gs = t1 + t2; const int g = lane >> 3;
        int rank = 0;
#pragma unroll
        for (int j = 0; j < 8; ++j) { const float o = __uint_as_float(__builtin_amdgcn_readlane(__float_as_uint(gs), 8 * j)); rank += (o > gs || (o == gs && j < g)) ? 1 : 0; }
        const bool gsel = rank < 4;
#pragma unroll
        for (int j = 0; j < 4; ++j) ch[q][j] = gsel ? bi[j] : -INFINITY;
    }
    int me[RR]; float mw[RR], wsum[RR];
#pragma unroll
    for (int q = 0; q < RR; ++q) { me[q] = 0; mw[q] = 0.f; wsum[q] = 0.f; }
#pragma unroll
    for (int k = 0; k < 8; ++k) {
        float M[RR];
#pragma unroll
        for (int q = 0; q < RR; ++q) M[q] = fmaxf(fmaxf(ch[q][0], ch[q][1]), fmaxf(ch[q][2], ch[q][3]));
#pragma unroll
        for (int o = 1; o < 64; o <<= 1) {
#pragma unroll
            for (int q = 0; q < RR; ++q) M[q] = fmaxf(M[q], __shfl_xor(M[q], o));
        }
#pragma unroll
        for (int q = 0; q < RR; ++q) {
            const bool h0 = ch[q][0] == M[q], h1 = ch[q][1] == M[q], h2 = ch[q][2] == M[q], h3 = ch[q][3] == M[q];
            const unsigned long long bal = __builtin_amdgcn_ballot_w64(h0 || h1 || h2 || h3);
            const int wl = __builtin_amdgcn_readfirstlane((int)__builtin_ctzll(bal));
            const int sub = h0 ? 0 : (h1 ? 1 : (h2 ? 2 : 3));
            const float myscore = h0 ? sc[q][0] : (h1 ? sc[q][1] : (h2 ? sc[q][2] : sc[q][3]));
            const int wsub = __builtin_amdgcn_readlane(sub, wl);
            const float wsel = __uint_as_float(__builtin_amdgcn_readlane(__float_as_uint(myscore), wl));
            if (lane == wl) {
                if (sub == 0) ch[q][0] = -INFINITY; else if (sub == 1) ch[q][1] = -INFINITY; else if (sub == 2) ch[q][2] = -INFINITY; else ch[q][3] = -INFINITY;
            }
            wsum[q] += wsel;
            if (lane == k) { me[q] = 4 * wl + wsub; mw[q] = wsel; }
        }
    }
    if (lane < 8) {
        unsigned rk[RR];
#pragma unroll
        for (int q = 0; q < RR; ++q) rk[q] = __hip_atomic_fetch_add(&ctl[CW_CNT + 64 * me[q]], 1u, __ATOMIC_RELAXED, __HIP_MEMORY_SCOPE_AGENT);
#pragma unroll
        for (int q = 0; q < RR; ++q) {
            const int aid = (tok0 + q) * 8 + lane;
            ((float*)(ws + WS_TOPW))[aid] = mw[q] * (2.5f / wsum[q]);
            ((int*)(ws + WS_LIST))[(size_t)me[q] * LIST_CAP + rk[q]] = aid;
        }
    }
}

DEVI void phase6(const Params& p, LAS unsigned char* lds, int tid, int vcu, int G) {
    unsigned char* ws = p.ws;
    const bf16_t* Hh = (const bf16_t*)(ws + WS_H1); const bf16_t* Hl = (const bf16_t*)(ws + WS_H2LO);
    const bf16_t* Wh = (const bf16_t*)(ws + WS_WR); const bf16_t* Wl = Wh + (size_t)NEXP * DM;
    float* part = (float*)(ws + WS_RQ);
    for (int id = vcu; id < 4 * (NTOK / 256); id += G) {
        asm volatile("" : "+v"(tid));
        const int w = tid >> 6, lane = tid & 63, fr = lane & 15, fq = lane >> 4;
        const int pm = id >> 2, kq = id & 3;
        int aoff[4], boff[4];
#pragma unroll
        for (int i = 0; i < 4; ++i) { aoff[i] = (pm * 256 + i * 64 + (tid >> 3)) * DM + 256 * kq; boff[i] = (i * 64 + (tid >> 3)) * DM + 256 * kq; }
        f32x4 acc[4][8];
        gemm_tile<3>(acc, lds, Hl, Hh, Hh, Wh, Wl, Wh, aoff, boff, 256, tid);
        float* dst = part + (size_t)kq * NTOK * NEXP;
        const int wm = w >> 1, wn = w & 1;
#pragma unroll
        for (int mt = 0; mt < 4; ++mt) {
            const size_t tok = (size_t)pm * 256 + 64 * wm + 16 * mt + fr;
#pragma unroll
            for (int nt = 0; nt < 8; ++nt) *(f32x4*)(dst + tok * NEXP + 128 * wn + 16 * nt + 4 * fq) = acc[mt][nt];
        }
        __syncthreads();
    }
}

DEVI void phase_route(const Params& p, int tid, int vcu, int G, unsigned* ctl) {
    const int w = tid >> 6, lane = tid & 63;
    const int gw = vcu * NWAVES + w, NGW = G * NWAVES;
    for (int t0 = gw * RR; t0 < NTOK; t0 += NGW * RR) route_rows(p, p.ws, ctl, t0, lane);
}

DEVI void phase7(const Params& p, LAS unsigned char* lds, int tid, int vcu, int G, unsigned* ctl) {
    unsigned char* ws = p.ws;
    LAS int* pre = (LAS int*)(lds + LDS_MISC + MISC_PRE);
    LAS int* cnts = (LAS int*)lds;
    LAS int* scan = (LAS int*)(lds + 1024);
    if (tid < NEXP) { const int c = (int)xb_ld(&ctl[CW_CNT + 64 * tid]); cnts[tid] = c; scan[tid] = (c + 255) >> 8; }
    __syncthreads();
#pragma unroll 1
    for (int o = 1; o < NEXP; o <<= 1) {
        int v = 0;
        if (tid < NEXP && tid >= o) v = scan[tid - o];
        __syncthreads();
        if (tid < NEXP) scan[tid] += v;
        __syncthreads();
    }
    if (tid < NEXP) pre[tid + 1] = scan[tid];
    if (tid == 0) pre[0] = 0;
    __syncthreads();
    if (tid == 0) pre[NEXP + 1] = pre[NEXP] + NTOK / 256;
    __syncthreads();
    const int U = pre[NEXP + 1];
    LAS int* cntm = (LAS int*)(lds + LDS_MISC + MISC_KM);
    if (tid < NEXP) cntm[tid] = cnts[tid];
    __syncthreads();
    const bf16_t* Hh = (const bf16_t*)(ws + WS_H1);
    bf16_t* Hs = (bf16_t*)(ws + WS_MIX) + (size_t)blockIdx.x * 256 * 256;
    bf16_t* Y = (bf16_t*)(ws + WS_Y);
    const int* list = (const int*)(ws + WS_LIST); const float* topw = (const float*)(ws + WS_TOPW);
    auto unit_expert = [&](int uu) -> int { int lo = 0, hi = NEXP + 1; while (hi - lo > 1) { const int mid = (lo + hi) >> 1; if (pre[mid] <= uu) lo = mid; else hi = mid; } return lo; };
    auto stage1_base = [&](int ee, int ww) -> const float* {
        const float* Wg = (ee < NEXP) ? p.w_gate + (size_t)ee * DM * EFF : p.ws_gate;
        const float* Wu = (ee < NEXP) ? p.w_up + (size_t)ee * DM * EFF : p.ws_up;
        const int R = 32 * ww, within = R & 127;
        return ((within < 64) ? Wg : Wu) + 64 * (R >> 7) + (within & 63);
    };
    f32x4 breg[8];
    if (vcu < U) wf32_load_b(breg, stage1_base(unit_expert(vcu), tid >> 6), EFF, 0, tid);
    for (int u = vcu; u < U; u += G) {
        asm volatile("" : "+v"(tid));
        const int w = tid >> 6, lane = tid & 63, fr = lane & 15, fq = lane >> 4;
        const int e = unit_expert(u), mtile = u - pre[e];
        const int cnt = (e < NEXP) ? cntm[e] : NTOK;
        const int rbase = mtile * 256;
        int aoff[4];
#pragma unroll
        for (int i = 0; i < 4; ++i) {
            int r = rbase + i * 64 + (tid >> 3); r = r < cnt ? r : cnt - 1;
            const int tok = (e < NEXP) ? (list[(size_t)e * LIST_CAP + r] >> 3) : r;
            aoff[i] = tok * DM;
        }
        {
            LAS int* taid = (LAS int*)(lds + LDS_ROWTAB); LAS float* tw = (LAS float*)(lds + LDS_ROWTAB + 1024);
            if (tid < 256) {
                const int r = rbase + tid; int a = -1; float wv = 0.f;
                if (r < cnt) { if (e < NEXP) { a = list[(size_t)e * LIST_CAP + r]; wv = topw[a]; } else { a = NASSIGN + r; wv = 1.0f; } }
                taid[tid] = a; tw[tid] = wv;
            }
        }
        f32x4 acc[4][8];
        const float* Wdn = (e < NEXP) ? p.w_down + (size_t)e * EFF * DM : p.ws_down;
        const float* b1 = stage1_base(e, w);
        const float* b2 = Wdn + 32 * w;
        const float* bnext = (u + G < U) ? stage1_base(unit_expert(u + G), w) : b1;
#pragma unroll 1
        for (int nh = 0; nh < 2; ++nh) {
            const float* bcol = b1 + nh * 128;
            const float* nb = (nh == 0) ? b1 + 128 : b2;
            gemm_tile_wf32(acc, breg, lds, Hh, bcol, EFF, nb, (nh == 0) ? EFF : DM, aoff, DM, tid);
            const int w = tid >> 6, lane = tid & 63, fr = lane & 15, fq = lane >> 4, wm = w >> 1, wn = w & 1;
#pragma unroll
            for (int mt = 0; mt < 4; ++mt)
#pragma unroll
                for (int nt = 0; nt < 4; ++nt) {
                    const f32x4 g = acc[mt][nt], uu = acc[mt][nt + 4];
                    u32x2 o; o.x = pk2(siluf(g.x) * uu.x, siluf(g.y) * uu.y); o.y = pk2(siluf(g.z) * uu.z, siluf(g.w) * uu.w);
                    *(u32x2*)(Hs + (size_t)(64 * wm + 16 * mt + fr) * 256 + nh * 128 + 64 * wn + 16 * nt + 4 * fq) = o;
                    if (nt == 3) __builtin_amdgcn_sched_barrier(0);
                }
            __syncthreads();
        }
#pragma unroll 1
        for (int nq = 0; nq < 4; ++nq) {
#pragma unroll
            for (int i = 0; i < 4; ++i) aoff[i] = (i * 64 + (tid >> 3)) * 256;
            gemm_tile_wf32(acc, breg, lds, Hs, b2 + nq * 256, DM, (nq < 3) ? b2 + (nq + 1) * 256 : bnext, (nq < 3) ? DM : EFF, aoff, EFF, tid);
            const int w = tid >> 6, lane = tid & 63, fr = lane & 15, fq = lane >> 4, wm = w >> 1, wn = w & 1;
            __syncthreads();
            LAS unsigned char* wl = lds + w * EPI_WAVE;
#pragma unroll
            for (int hf = 0; hf < 2; ++hf) {
                u32x2 pk[2][8];
#pragma unroll
                for (int m2 = 0; m2 < 2; ++m2) {
                    const float wrow = ((LAS const float*)(lds + LDS_ROWTAB + 1024))[64 * wm + 32 * hf + 16 * m2 + fr];
#pragma unroll
                    for (int nt = 0; nt < 8; ++nt) { const f32x4 v = acc[2 * hf + m2][nt] * wrow; pk[m2][nt].x = pk2(v.x, v.y); pk[m2][nt].y = pk2(v.z, v.w); }
                }
                u32x4 rows8[8];
                epi_transpose(wl, pk, rows8, lane);
#pragma unroll
                for (int j = 0; j < 8; ++j) {
                    const int aid = ((LAS const int*)(lds + LDS_ROWTAB))[64 * wm + 32 * hf + 4 * j + fq];
                    if (aid >= 0) *(u32x4*)(Y + (size_t)aid * DM + nq * 256 + 128 * wn + 8 * fr) = rows8[j];
                }
            }
            __syncthreads();
        }
    }
}

DEVI void phase8(const Params& p, int tid, int vcu, int G) {
    unsigned char* ws = p.ws;
    const int w = tid >> 6, lane = tid & 63;
    const int gw = vcu * NWAVES + w, NGW = G * NWAVES;
    const bf16_t* Y = (const bf16_t*)(ws + WS_Y); const float* mod = (const float*)(ws + WS_MOD);
    for (int tok = gw; tok < NTOK; tok += NGW) {
        const int b = tok >> 11;
#pragma unroll
        for (int j = 0; j < 2; ++j) {
            const int col = 512 * j + 8 * lane;
            float a[8];
#pragma unroll
            for (int q = 0; q < 8; ++q) a[q] = 0.f;
#pragma unroll
            for (int k = 0; k < 9; ++k) {
                const size_t row = (k < 8) ? ((size_t)tok * 8 + k) : ((size_t)NASSIGN + tok);
                const u32x4 v = *(const u32x4*)(Y + row * DM + col);
                a[0] += bflo(v.x); a[1] += bfhi(v.x); a[2] += bflo(v.y); a[3] += bfhi(v.y); a[4] += bflo(v.z); a[5] += bfhi(v.z); a[6] += bflo(v.w); a[7] += bfhi(v.w);
            }
            float* o = p.out + (size_t)tok * DM + col;
            const float* xi = (const float*)(ws + WS_X1) + (size_t)tok * DM + col;
            const float* gt = mod + b * 6144 + 5120 + col;
            const f32x4 x0 = *(const f32x4*)xi, x1 = *(const f32x4*)(xi + 4);
            const f32x4 g0 = *(const f32x4*)gt, g1 = *(const f32x4*)(gt + 4);
            *(f32x4*)o = x0 + g0 * (f32x4){a[0], a[1], a[2], a[3]};
            *(f32x4*)(o + 4) = x1 + g1 * (f32x4){a[4], a[5], a[6], a[7]};
        }
    }
}

__global__ void __launch_bounds__(NTHREADS) hymba_fwd(Params p_in) {
    extern __shared__ __attribute__((aligned(16))) unsigned char smem[];
    LAS unsigned char* lds = (LAS unsigned char*)smem;
    int tid = threadIdx.x;
    const int G = gridDim.x;
    const int bx = blockIdx.x;
    const int vcu = (G % 8 == 0) ? (bx % 8) * (G / 8) + bx / 8 : bx;
    unsigned* ctl = (unsigned*)(p_in.ws + WS_CTL);
    if (tid < 4) ((LAS unsigned*)(lds + LDS_MISC + MISC_BAR))[tid] = 0u;
    __syncthreads();
    XcdBarrier bar; bar.bar = ctl + CW_BAR; bar.x = 0; bar.st = nullptr;
    const bool multi = (p_in.ph_hi - p_in.ph_lo) > 1;
    if (multi) bar = xcd_barrier_post(ctl + CW_BAR, (volatile LAS unsigned*)(lds + LDS_MISC + MISC_BAR));
    const float* mod = nullptr;
    Params p = p_in;
#pragma unroll 1
    for (int pi = p_in.ph_lo; pi < p_in.ph_hi; ++pi) {
        if (pi > p_in.ph_lo) xcd_barrier(bar);
        int ph = p_in.prog[0];
#pragma unroll
        for (int q = 1; q < 14; ++q) ph = (pi == q) ? p_in.prog[q] : ph;
        {
            int t = threadIdx.x; asm volatile("" : "+v"(t)); tid = t;
            unsigned char* wsl = p_in.ws; asm volatile("" : "+s"(wsl)); p.ws = wsl;
            float* ol = p_in.out; asm volatile("" : "+s"(ol)); p.out = ol;
            mod = (const float*)(wsl + WS_MOD);
        }
        switch (ph) {
#if !defined(ONLY_PH) || ONLY_PH == 0
        case 0: phase0(p, lds, tid, vcu, G, ctl); break;
        case 13: {
            phase0(p, lds, tid, vcu, G, ctl);
            if (tid == 0) {
                unsigned sp = 0;
                while (xb_ld(&ctl[CW_MOD]) < 192u && ++sp < (1u << 22)) __builtin_amdgcn_s_sleep(1);
                __builtin_amdgcn_fence(__ATOMIC_ACQUIRE, "agent");
                asm volatile("s_waitcnt vmcnt(0)" ::: "memory");
            }
            __syncthreads();
            rownorm_phase<false>(p.x, p.g_mix, mod, 0, 1024, (bf16_t*)(p.ws + WS_H1), nullptr, tid, vcu, G);
        } break;
#endif
#if !defined(ONLY_PH) || ONLY_PH == 1
        case 1: rownorm_phase<false>(p.x, p.g_mix, mod, 0, 1024, (bf16_t*)(p.ws + WS_H1), nullptr, tid, vcu, G); break;
#endif
#if !defined(ONLY_PH) || ONLY_PH == 2
        case 2: phase2(p, lds, tid, vcu, G); break;
#endif
#if !defined(ONLY_PH) || ONLY_PH == 3
        case 3: phase3(p, lds, tid, ctl + pi); break;
#endif
#if !defined(ONLY_PH) || ONLY_PH == 4
        case 4: phase4<false>(p, lds, tid, vcu, G, ctl); break;
        case 11: phase4<true>(p, lds, tid, vcu, G, ctl); break;
#endif
#if !defined(ONLY_PH) || ONLY_PH == 5
        case 5: rownorm_phase<true>((const float*)(p.ws + WS_X1), p.g_ffn, mod, 3072, 4096, (bf16_t*)(p.ws + WS_H1), (bf16_t*)(p.ws + WS_H2LO), tid, vcu, G); break;
#endif
#if !defined(ONLY_PH) || ONLY_PH == 6
        case 6: phase6(p, lds, tid, vcu, G); break;
#endif
#if !defined(ONLY_PH) || ONLY_PH == 7
        case 7: phase_route(p, tid, vcu, G, ctl); break;
#endif
#if !defined(ONLY_PH) || ONLY_PH == 8
        case 8: phase7(p, lds, tid, vcu, G, ctl); break;
#endif
#if !defined(ONLY_PH) || ONLY_PH == 9
        case 9: phase8(p, tid, vcu, G); break;
#endif
        default: break;
        }
    }
}

extern "C" void kernel_launch(void* const* d_in, const int* in_sizes, int n_in, void* d_out, int out_size, void* d_ws, size_t ws_size, hipStream_t stream) {
    static int grid = 0;
    if (grid == 0) {
        if (n_in != 18 || out_size != NTOK * DM || ws_size < WS_END) {
            fprintf(stderr, "kernel_launch: unexpected shapes (n_in %d, out %d, ws %zu, need %zu)\n", n_in, out_size, ws_size, (size_t)WS_END); grid = -1; return;
        }
        int dev = 0, cus = 0, per_cu = 0;
        hipGetDevice(&dev);
        hipDeviceGetAttribute(&cus, hipDeviceAttributeMultiprocessorCount, dev);
        hipFuncSetAttribute((const void*)hymba_fwd, hipFuncAttributeMaxDynamicSharedMemorySize, LDS_BYTES);
        hipOccupancyMaxActiveBlocksPerMultiprocessor(&per_cu, (const void*)hymba_fwd, NTHREADS, LDS_BYTES);
        if (per_cu < 1) { fprintf(stderr, "kernel_launch: occupancy query says %d blocks/CU\n", per_cu); grid = -1; return; }
        grid = cus < 256 ? cus : 256;
        (void)hipGetLastError();
    }
    if (grid < 0) return;
    hipMemsetAsync((char*)d_ws + WS_CTL, 0, CTL_BYTES, stream);
    Params p{};
    p.x = (const float*)d_in[0]; p.c = (const float*)d_in[1]; p.w_ada = (const float*)d_in[2]; p.b_ada = (const float*)d_in[3];
    p.g_mix = (const float*)d_in[4]; p.w_in = (const float*)d_in[5]; p.q_gain = (const float*)d_in[6]; p.k_gain = (const float*)d_in[7];
    p.w_out = (const float*)d_in[8]; p.g_ffn = (const float*)d_in[9]; p.w_router = (const float*)d_in[10]; p.router_bias = (const float*)d_in[11];
    p.w_gate = (const float*)d_in[12]; p.w_up = (const float*)d_in[13]; p.w_down = (const float*)d_in[14];
    p.ws_gate = (const float*)d_in[15]; p.ws_up = (const float*)d_in[16]; p.ws_down = (const float*)d_in[17];
    p.out = (float*)d_out; p.ws = (unsigned char*)d_ws;
    int np = 0;
    for (int ph = 0; ph < NPHASE; ++ph) {
        if (ph == 0) { p.prog[np++] = 13; continue; }
        if (ph == 1) continue;
        if (grid == 256 && ph == 4) { p.prog[np++] = 11; continue; }
        if (grid == 256 && (ph == 5 || ph == 6)) continue;
        p.prog[np++] = ph;
#ifdef PROBE_DUP
        if (ph == PROBE_DUP) p.prog[np++] = ph;
#endif
    }
#if MK_N_LAUNCHES == 1
    p.ph_lo = 0; p.ph_hi = np;
    hipLaunchKernelGGL(hymba_fwd, dim3(grid), dim3(NTHREADS), LDS_BYTES, stream, p);
#else
    for (int pi = 0; pi < np; ++pi) {
        p.ph_lo = pi; p.ph_hi = pi + 1;
        hipLaunchKernelGGL(hymba_fwd, dim3(grid), dim3(NTHREADS), LDS_BYTES, stream, p);
    }
#endif
}
```

```cpp
#include <hip/hip_runtime.h>
#include <stdint.h>
#include <stdio.h>

#ifndef MK_N_LAUNCHES
#define MK_N_LAUNCHES 1
#endif

#define DEVI __device__ __forceinline__
#define LAS __attribute__((address_space(3)))

typedef unsigned short bf16_t;
typedef short bf16x8 __attribute__((ext_vector_type(8)));
typedef float f32x4 __attribute__((ext_vector_type(4)));
typedef unsigned u32x4 __attribute__((ext_vector_type(4)));
typedef unsigned u32x2 __attribute__((ext_vector_type(2)));

constexpr int BATCH = 8, SEQ = 2048, DM = 1024, NTOK = BATCH * SEQ;
constexpr int INC = 3584;
constexpr int NEXP = 256, TOPK = 8, EFF = 256;
constexpr int NASSIGN = NTOK * TOPK;
constexpr int LIST_CAP = NTOK;
constexpr float EPS = 1e-6f;
constexpr int NTHREADS = 512, NWAVES = 8;
constexpr int NPHASE = 10;

constexpr int LDS_STAGE = 131072;
constexpr int LDS_MISC = LDS_STAGE;
constexpr int LDS_EPI7 = LDS_STAGE + 4096 + 2048;
constexpr int LDS_BYTES = LDS_EPI7 + 8704;
constexpr int LDS_ROWTAB = LDS_STAGE + 4096;
constexpr int MISC_BAR = 0, MISC_PRE = 64, MISC_SEL = 1280, MISC_KM = 1536, MISC_SCAL = 3400;

constexpr size_t al256(size_t x) { return (x + 255) & ~(size_t)255; }
constexpr size_t WS_CTL = 0;
constexpr size_t CTL_BYTES = 131072;
constexpr size_t WS_MOD = WS_CTL + CTL_BYTES;
constexpr size_t WS_ROPE = WS_MOD + al256((size_t)BATCH * 6144 * 4);
constexpr size_t WS_KMEAN = WS_ROPE + (size_t)2 * SEQ * 64 * 4;
constexpr size_t WS_WIN = WS_KMEAN + (size_t)8 * 8 * 8 * 64 * 4;
constexpr size_t WS_WOUT = WS_WIN + (size_t)INC * DM * 2;
constexpr size_t WS_WR = WS_WOUT + (size_t)DM * DM * 2;
constexpr size_t WS_WGU = WS_WR + (size_t)2 * NEXP * DM * 2;
constexpr size_t WS_WD = WS_WGU + (size_t)257 * 512 * DM * 2;
constexpr size_t WS_H1 = WS_WD + (size_t)257 * DM * 256 * 2;
constexpr size_t WS_H2LO = WS_H1 + (size_t)NTOK * DM * 2;
constexpr size_t WS_RQ = WS_H2LO + (size_t)NTOK * DM * 2;
constexpr size_t WS_RK = WS_RQ + (size_t)NTOK * 512 * 2;
constexpr size_t WS_RVT = WS_RK + (size_t)NTOK * 512 * 2;
constexpr size_t WS_RG = WS_RVT + (size_t)NTOK * 512 * 2;
constexpr size_t WS_MQ = WS_RG + (size_t)NTOK * 512 * 2;
constexpr size_t WS_MK = WS_MQ + (size_t)NTOK * 512 * 2;
constexpr size_t WS_MVT = WS_MK + (size_t)NTOK * 512 * 2;
constexpr size_t WS_MIX = WS_MVT + (size_t)NTOK * 512 * 2;
constexpr size_t WS_LOGIT = WS_MIX + (size_t)NTOK * DM * 2;
constexpr size_t WS_TOPW = WS_LOGIT + (size_t)NTOK * NEXP * 4;
constexpr size_t WS_LIST = WS_TOPW + (size_t)NASSIGN * 4;
constexpr size_t WS_Y = WS_LIST + (size_t)NEXP * LIST_CAP * 4;
constexpr size_t WS_STATS = WS_Y + (size_t)(NASSIGN + NTOK) * DM * 2;
constexpr size_t WS_END = WS_STATS + (size_t)64 * 4 * 256 * 4;

constexpr size_t WS_KVT = WS_Y;
constexpr size_t WS_X1 = WS_WGU;


constexpr int CW_BAR = 0;
constexpr int CW_CNT = 4096;
constexpr int CW_QATT = 4096 + 64 * 256;
constexpr int CW_QMOE = CW_QATT + 64;
constexpr int CW_KV = 25088;
constexpr int CW_MOD = 24832;
constexpr int CW_P4 = CW_QMOE + 128;

struct Params {
    const float* x; const float* c; const float* w_ada; const float* b_ada; const float* g_mix; const float* w_in;
    const float* q_gain; const float* k_gain; const float* w_out; const float* g_ffn; const float* w_router; const float* router_bias;
    const float* w_gate; const float* w_up; const float* w_down; const float* ws_gate; const float* ws_up; const float* ws_down;
    float* out; unsigned char* ws;
    int ph_lo, ph_hi;
    int prog[14];
};

typedef float f32x2 __attribute__((ext_vector_type(2)));
typedef __bf16 bf16x2_t __attribute__((ext_vector_type(2)));
DEVI unsigned pk2(float lo, float hi) { unsigned r; asm("v_cvt_pk_bf16_f32 %0, %1, %2" : "=v"(r) : "v"(lo), "v"(hi)); return r; }
DEVI unsigned pk2t(float lo, float hi) { const f32x2 v = {lo, hi}; return __builtin_bit_cast(unsigned, __builtin_convertvector(v, bf16x2_t)); }
DEVI float bf2f(unsigned short b) { return __uint_as_float((unsigned)b << 16); }
DEVI float bflo(unsigned u) { return __uint_as_float(u << 16); }
DEVI float bfhi(unsigned u) { return __uint_as_float(u & 0xffff0000u); }
DEVI float siluf(float v) { return v / (1.0f + __expf(-v)); }
DEVI float wave_sum(float v) {
#pragma unroll
    for (int o = 1; o < 64; o <<= 1) v += __shfl_xor(v, o);
    return v;
}
DEVI void glds16(const void* g, LAS unsigned char* l) {
    __builtin_amdgcn_global_load_lds((const __attribute__((address_space(1))) unsigned*)g, (LAS unsigned*)l, 16, 0, 0);
}
DEVI void glds16o(const void* base, unsigned off, LAS unsigned char* l) {
    __builtin_amdgcn_global_load_lds((const __attribute__((address_space(1))) unsigned*)((const __attribute__((address_space(1))) char*)base + off), (LAS unsigned*)l, 16, 0, 0);
}
DEVI bf16x8 lds128(LAS const unsigned char* p) { return *(LAS const bf16x8*)p; }
DEVI u32x2 lds64(LAS const unsigned char* p) { return *(LAS const u32x2*)p; }
#define VM_WAIT() asm volatile("s_waitcnt vmcnt(0)" ::: "memory")
DEVI const float* uniform_ptr(const float* p) {
    const unsigned long long v = (unsigned long long)p;
    const unsigned lo = __builtin_amdgcn_readfirstlane((unsigned)v), hi = __builtin_amdgcn_readfirstlane((unsigned)(v >> 32));
    return (const float*)(((unsigned long long)hi << 32) | lo);
}


#define XB_TMO      128
#define XB_XCNT(j)  (256  + 64 * (j))
#define XB_XSUB(j)  (1280 + 64 * (j))
#define XB_XGEN(j)  (2304 + 64 * (j))
#define XB_TOP      3328
#define XB_TOPGEN   3392
#define XCD_BAR_WORDS 3456
#define XB_SPIN_CAP (1u << 22)
DEVI unsigned xb_ld(unsigned* p) { return __hip_atomic_load(p, __ATOMIC_RELAXED, __HIP_MEMORY_SCOPE_AGENT); }
DEVI unsigned xb_add(unsigned* p, unsigned v) { return __hip_atomic_fetch_add(p, v, __ATOMIC_RELAXED, __HIP_MEMORY_SCOPE_AGENT); }
DEVI unsigned xb_xcc_id() { return (unsigned)__builtin_amdgcn_s_getreg((3 << 11) | 20) & 0xFu; }
#define XB_SPIN(cond, bar) do { unsigned _sp = 0; while (cond) { __builtin_amdgcn_s_sleep(1); \
    if ((++_sp & 255u) == 0u) { if (xb_ld(&(bar)[XB_TMO])) break; if (_sp > XB_SPIN_CAP) { atomicAdd(&(bar)[XB_TMO], 1u); break; } } } } while (0)
struct XcdBarrier { unsigned* bar; unsigned x; volatile LAS unsigned* st; };
DEVI XcdBarrier xcd_barrier_post(unsigned* bar, volatile LAS unsigned* st) {
    XcdBarrier b; b.bar = bar; b.x = xb_xcc_id(); b.st = st;
    if (threadIdx.x == 0) (void)xb_add(&bar[XB_XCNT(b.x)], 1u);
    return b;
}
DEVI void xcd_barrier_complete(unsigned* bar, unsigned x, unsigned& nloc, unsigned& nx) {
    const unsigned G = gridDim.x * gridDim.y * gridDim.z;
    unsigned sum, cnt, mine, sp = 0u;
    for (;;) {
        sum = 0u; cnt = 0u; mine = 0u;
#pragma unroll
        for (unsigned j = 0; j < 16; ++j) { const unsigned c = xb_ld(&bar[XB_XCNT(j)]); sum += c; cnt += (c > 0u) ? 1u : 0u; mine = (j == x) ? c : mine; }
        if (sum == G) break;
        __builtin_amdgcn_s_sleep(1);
        if ((++sp & 255u) == 0u) { if (xb_ld(&bar[XB_TMO])) break; if (sp > XB_SPIN_CAP) { atomicAdd(&bar[XB_TMO], 1u); break; } }
    }
    nloc = mine > 0u ? mine : 1u; nx = cnt > 0u ? cnt : 1u;
}
DEVI void xcd_barrier(const XcdBarrier& b) {
    asm volatile("s_waitcnt vmcnt(0)" ::: "memory");
    __syncthreads();
    if (threadIdx.x == 0) {
        unsigned* bar = b.bar;
        __builtin_amdgcn_s_waitcnt(0);
        unsigned nloc = b.st[0], nx = b.st[1];
        if (nloc == 0u) { xcd_barrier_complete(bar, b.x, nloc, nx); b.st[0] = nloc; b.st[1] = nx; }
        const unsigned old = xb_add(&bar[XB_XSUB(b.x)], 1u);
        const unsigned gen = old / nloc;
        if (old + 1u == (gen + 1u) * nloc) {
            __builtin_amdgcn_fence(__ATOMIC_RELEASE, "agent");
            asm volatile("s_waitcnt vmcnt(0)" ::: "memory");
            asm volatile("buffer_inv sc1" ::: "memory");
            const unsigned og = xb_add(&bar[XB_TOP], 1u);
            const unsigned tg = og / nx;
            if (og + 1u == (tg + 1u) * nx) xb_add(&bar[XB_TOPGEN], 1u);
            else XB_SPIN(xb_ld(&bar[XB_TOPGEN]) == tg, bar);
            xb_add(&bar[XB_XGEN(b.x)], 1u);
            asm volatile("s_waitcnt vmcnt(0)" ::: "memory");
        } else {
            asm volatile("buffer_inv sc1" ::: "memory");
            XB_SPIN(xb_ld(&bar[XB_XGEN(b.x)]) == gen, bar);
            asm volatile("s_waitcnt vmcnt(0)" ::: "memory");
        }
        __builtin_amdgcn_fence(__ATOMIC_ACQUIRE, "workgroup");
    }
    __syncthreads();
}

template <bool SWAP, int BH = 1, bool BSWZ = false, bool SCHEDB = false>
DEVI void mma_step(f32x4 (&acc)[4][8], LAS const unsigned char* Ab, LAS const unsigned char* Bb, const int fr, const int fq) {
#pragma unroll
    for (int kk = 0; kk < 2; ++kk) {
        const int co = ((kk * 4 + fq) ^ (fr & 7)) * 16;
        const int cob0 = BSWZ ? ((kk * 4 + fq) ^ (((fr >> 2) & 3) | (((fr >> 1) & 1) << 2))) * 16 : co;
        const int cob1 = BSWZ ? (cob0 ^ 64) : co;
        bf16x8 a[4];
#pragma unroll
        for (int mt = 0; mt < 4; ++mt) a[mt] = lds128(Ab + mt * 2048 + co);
#pragma unroll
        for (int h = 0; h < BH; ++h) {
            constexpr int NB = 8 / BH;
            bf16x8 b[NB];
#pragma unroll
            for (int nt = 0; nt < NB; ++nt) b[nt] = lds128(Bb + (h * NB + nt) * 2048 + ((nt & 1) ? cob1 : cob0));
#pragma unroll
            for (int nt = 0; nt < NB; ++nt)
#pragma unroll
                for (int mt = 0; mt < 4; ++mt) {
                    if (SWAP) acc[mt][h * NB + nt] = __builtin_amdgcn_mfma_f32_16x16x32_bf16(b[nt], a[mt], acc[mt][h * NB + nt], 0, 0, 0);
                    else acc[mt][h * NB + nt] = __builtin_amdgcn_mfma_f32_16x16x32_bf16(a[mt], b[nt], acc[mt][h * NB + nt], 0, 0, 0);
                }
            if (SCHEDB) __builtin_amdgcn_sched_barrier(0);
        }
    }
}

template <bool BSWZ, bool SWAP> DEVI void mma_step_pipe(f32x4 (&acc)[4][8], LAS const unsigned char* Ab, LAS const unsigned char* Bb, const int fr, const int fq);
template <bool SWAP>
DEVI void mma_step_pipe2(f32x4 (&acc)[4][8], LAS const unsigned char* Ab, LAS const unsigned char* Bb, const int fr, const int fq) {
    const int co0 = ((0 * 4 + fq) ^ (fr & 7)) * 16, co1 = ((1 * 4 + fq) ^ (fr & 7)) * 16;
    bf16x8 a0[4], a1[4], b[3];
    b[0] = lds128(Bb + co0);
#pragma unroll
    for (int mt = 0; mt < 4; ++mt) a0[mt] = lds128(Ab + mt * 2048 + co0);
    b[1] = lds128(Bb + 2048 + co0);
#pragma unroll
    for (int g = 0; g < 16; ++g) {
        const int nt = g & 7;
        if (g + 2 < 16) b[(g + 2) % 3] = lds128(Bb + ((g + 2) & 7) * 2048 + (((g + 2) >> 3) ? co1 : co0));
        if (g >= 4 && g < 8) a1[g - 4] = lds128(Ab + (g - 4) * 2048 + co1);
#pragma unroll
        for (int mt = 0; mt < 4; ++mt) {
            const bf16x8 av = (g < 8) ? a0[mt] : a1[mt];
            if (SWAP) acc[mt][nt] = __builtin_amdgcn_mfma_f32_16x16x32_bf16(b[g % 3], av, acc[mt][nt], 0, 0, 0);
            else acc[mt][nt] = __builtin_amdgcn_mfma_f32_16x16x32_bf16(av, b[g % 3], acc[mt][nt], 0, 0, 0);
        }
    }
    __builtin_amdgcn_sched_group_barrier(0x100, 6, 0);
#pragma unroll
    for (int g = 0; g < 16; ++g) {
        if (g + 2 < 16) __builtin_amdgcn_sched_group_barrier(0x100, 1, 0);
        if (g >= 4 && g < 8) __builtin_amdgcn_sched_group_barrier(0x100, 1, 0);
        __builtin_amdgcn_sched_group_barrier(0x008, 4, 0);
    }
}
template <int NSEG, bool SWAP = true>
DEVI void gemm_tile(f32x4 (&acc)[4][8], LAS unsigned char* lds, const bf16_t* A0, const bf16_t* A1, const bf16_t* A2,
                    const bf16_t* B0, const bf16_t* B1, const bf16_t* B2,
                    const int (&aoff)[4], const int (&boff)[4], const int K, const int tid, const int nra = 4) {
    const int w = tid >> 6, lane = tid & 63, fr = lane & 15, fq = lane >> 4, wm = w >> 1, wn = w & 1;
    const int lch = ((tid & 7) ^ ((tid >> 3) & 7)) * 8;
    const int kper = K >> 6;
#pragma unroll
    for (int mt = 0; mt < 4; ++mt)
#pragma unroll
        for (int nt = 0; nt < 8; ++nt) acc[mt][nt] = (f32x4){0.f, 0.f, 0.f, 0.f};
    auto stage = [&](int buf, const bf16_t* Ab, const bf16_t* Bb, int ks) {
        const int k0 = ks * 64 + lch;
        LAS unsigned char* base = lds + buf * 65536 + tid * 16;
#pragma unroll
        for (int i = 0; i < 4; ++i) if (i < nra) glds16o(Ab, (unsigned)(aoff[i] + k0) * 2u, base + i * 8192);
#pragma unroll
        for (int i = 0; i < 4; ++i) glds16o(Bb, (unsigned)(boff[i] + k0) * 2u, base + 32768 + i * 8192);
    };
    stage(0, A0, B0, 0);
    int buf = 0;
#pragma unroll
    for (int seg = 0; seg < NSEG; ++seg) {
        const bf16_t* Ac = (seg == 0) ? A0 : (seg == 1) ? A1 : A2;
        const bf16_t* Bc = (seg == 0) ? B0 : (seg == 1) ? B1 : B2;
        const bf16_t* An = (seg == 0) ? A1 : A2;
        const bf16_t* Bn = (seg == 0) ? B1 : B2;
#pragma unroll 1
        for (int ks = 0; ks < kper; ++ks) {
            VM_WAIT();
            __syncthreads();
            if (ks + 1 < kper) stage(buf ^ 1, Ac, Bc, ks + 1);
            else if (seg + 1 < NSEG) stage(buf ^ 1, An, Bn, 0);
            if (wm < nra) mma_step_pipe2<SWAP>(acc, lds + buf * 65536 + (64 * wm + fr) * 128, lds + buf * 65536 + 32768 + (128 * wn + fr) * 128, fr, fq);
            buf ^= 1;
        }
    }
}

template <bool BSWZ, bool SWAP>
DEVI void mma_step_pipe(f32x4 (&acc)[4][8], LAS const unsigned char* Ab, LAS const unsigned char* Bb, const int fr, const int fq) {
#pragma unroll
    for (int kk = 0; kk < 2; ++kk) {
        const int co = ((kk * 4 + fq) ^ (fr & 7)) * 16;
        const int cob0 = BSWZ ? ((kk * 4 + fq) ^ (((fr >> 2) & 3) | (((fr >> 1) & 1) << 2))) * 16 : co;
        const int cob1 = BSWZ ? (cob0 ^ 64) : co;
        bf16x8 a[4], b[3];
        b[0] = lds128(Bb + cob0);
#pragma unroll
        for (int mt = 0; mt < 4; ++mt) a[mt] = lds128(Ab + mt * 2048 + co);
        b[1] = lds128(Bb + 2048 + cob1);
#pragma unroll
        for (int nt = 0; nt < 8; ++nt) {
            if (nt + 2 < 8) b[(nt + 2) % 3] = lds128(Bb + (nt + 2) * 2048 + (((nt + 2) & 1) ? cob1 : cob0));
#pragma unroll
            for (int mt = 0; mt < 4; ++mt) {
                if (SWAP) acc[mt][nt] = __builtin_amdgcn_mfma_f32_16x16x32_bf16(b[nt % 3], a[mt], acc[mt][nt], 0, 0, 0);
                else acc[mt][nt] = __builtin_amdgcn_mfma_f32_16x16x32_bf16(a[mt], b[nt % 3], acc[mt][nt], 0, 0, 0);
            }
        }
        __builtin_amdgcn_sched_group_barrier(0x100, 6, 0);
#pragma unroll
        for (int nt = 0; nt < 8; ++nt) {
            if (nt + 2 < 8) __builtin_amdgcn_sched_group_barrier(0x100, 1, 0);
            __builtin_amdgcn_sched_group_barrier(0x008, 4, 0);
        }
    }
}

DEVI void wf32_load_b(f32x4 (&breg)[8], const float* wbase_in, const int ldb, const int ks, const int t) {
    const float* wbase = uniform_ptr(wbase_in);
    const unsigned toff = (unsigned)((8 * ((t >> 3) & 7)) * ldb + 4 * (t & 7)) * 4u;
    const float* s = wbase + (size_t)(ks * 64) * ldb;
#pragma unroll
    for (int i = 0; i < 8; ++i) breg[i] = *(const __attribute__((address_space(1))) f32x4*)((const __attribute__((address_space(1))) char*)(s + (size_t)i * ldb) + toff);
}
DEVI void gemm_tile_wf32(f32x4 (&acc)[4][8], f32x4 (&breg)[8], LAS unsigned char* lds, const bf16_t* A0, const float* wbase_in, const int ldb,
                         const float* nbase, const int nldb, const unsigned (&apk)[4], const int ashift, const int K, int& tid, const bool pre = false, const bool tailpre = false) {
    const int kper = K >> 6;
#pragma unroll
    for (int mt = 0; mt < 4; ++mt)
#pragma unroll
        for (int nt = 0; nt < 8; ++nt) acc[mt][nt] = (f32x4){0.f, 0.f, 0.f, 0.f};
    auto stage_a = [&](int buf, int ks, int t) {
        const int lch = ((t & 7) ^ ((t >> 3) & 7)) * 8;
        const int k0 = ks * 64 + lch;
        LAS unsigned char* base = lds + buf * 65536 + t * 16;
#pragma unroll
        for (int j = 0; j < 8; ++j) {
            const unsigned row = (j & 1) ? (apk[j >> 1] >> 16) : (apk[j >> 1] & 0xffffu);
            glds16o(A0, ((row << ashift) + (unsigned)k0) * 2u, base + (j >> 1) * 8192 + (j & 1) * 4096);
        }
    };
    auto write_b = [&](int buf, int t) {
        const int kg = (t >> 3) & 7, n4 = t & 7;
        LAS unsigned char* base = lds + buf * 65536 + 32768 + (32 * (t >> 6) + 4 * n4) * 128;
#pragma unroll
        for (int j = 0; j < 4; ++j) {
            u32x4 o;
            o.x = pk2(breg[0][j], breg[1][j]); o.y = pk2(breg[2][j], breg[3][j]); o.z = pk2(breg[4][j], breg[5][j]); o.w = pk2(breg[6][j], breg[7][j]);
            const int swz = (n4 & 3) | ((((j >> 1) ^ (n4 >> 2)) & 1) << 2);
            *(LAS u32x4*)(base + j * 128 + ((kg ^ swz) * 16)) = o;
        }
    };
    const bool cvtfirst = __builtin_amdgcn_readfirstlane(tid >> 6) >= 4;
    if (!pre) {
        if (!cvtfirst) stage_a(0, 0, tid);
        write_b(0, tid);
        wf32_load_b(breg, (kper > 1) ? wbase_in : nbase, (kper > 1) ? ldb : nldb, (kper > 1) ? 1 : 0, tid);
    }
    int buf = 0;
#pragma unroll 1
    for (int ks = 0; ks < kper; ++ks) {
        asm volatile("" : "+v"(tid));
        if (ks == 0 && pre) {
            if (cvtfirst) asm volatile("s_waitcnt vmcnt(16)" ::: "memory"); else asm volatile("s_waitcnt vmcnt(24)" ::: "memory");
        } else {
            if (cvtfirst) asm volatile("s_waitcnt vmcnt(0)" ::: "memory"); else asm volatile("s_waitcnt vmcnt(8)" ::: "memory");
        }
        asm volatile("s_waitcnt lgkmcnt(0)" ::: "memory");
        __builtin_amdgcn_s_barrier();
        asm volatile("" ::: "memory");
        const bool more = ks + 1 < kper;
        const bool more2 = ks + 2 < kper;
        if (more && cvtfirst) {
            write_b(buf ^ 1, tid);
            wf32_load_b(breg, more2 ? wbase_in : nbase, more2 ? ldb : nldb, more2 ? ks + 2 : 0, tid);
        }
        if (more && !cvtfirst) stage_a(buf ^ 1, ks + 1, tid);
        {
            const int w = tid >> 6, lane = tid & 63, fr = lane & 15, fq = lane >> 4, wm = w >> 1, wn = w & 1;
            mma_step_pipe<true, true>(acc, lds + buf * 65536 + (64 * wm + fr) * 128, lds + buf * 65536 + 32768 + (128 * wn + fr) * 128, fr, fq);
        }
        if (more && !cvtfirst) {
            write_b(buf ^ 1, tid);
            wf32_load_b(breg, more2 ? wbase_in : nbase, more2 ? ldb : nldb, more2 ? ks + 2 : 0, tid);
        }
        buf ^= 1;
    }
    if (tailpre) {
        write_b(0, tid);
        if (!cvtfirst) stage_a(0, 0, tid);
        wf32_load_b(breg, nbase, nldb, 1, tid);
    }
}

constexpr int EPI_RS = 272, EPI_WAVE = 32 * EPI_RS;
DEVI void epi_transpose(LAS unsigned char* wl, const u32x2 (&pk)[2][8], u32x4 (&rows8)[8], const int lane) {
    const int fr = lane & 15, fq = lane >> 4;
#pragma unroll
    for (int m2 = 0; m2 < 2; ++m2)
#pragma unroll
        for (int nt = 0; nt < 8; ++nt) *(LAS u32x2*)(wl + (16 * m2 + fr) * EPI_RS + (16 * nt + 4 * fq) * 2) = pk[m2][nt];
    asm volatile("s_waitcnt lgkmcnt(0)" ::: "memory");
#pragma unroll
    for (int j = 0; j < 8; ++j) rows8[j] = *(LAS const u32x4*)(wl + (4 * j + fq) * EPI_RS + fr * 16);
    asm volatile("s_waitcnt lgkmcnt(0)" ::: "memory");
}

constexpr int EPV_RS = 144, EPV_WAVE = 64 * EPV_RS;
DEVI void epi_transpose_vt(LAS unsigned char* wl, const u32x2 (&pk)[4][4], u32x4 (&rows8)[8], const int lane) {
    const int fr = lane & 15, fq = lane >> 4;
#pragma unroll
    for (int mt = 0; mt < 4; ++mt)
#pragma unroll
        for (int n4 = 0; n4 < 4; ++n4) *(LAS u32x2*)(wl + (16 * n4 + fr) * EPV_RS + (32 * (mt >> 1) + 8 * fq + 4 * (mt & 1)) * 2) = pk[mt][n4];
    asm volatile("s_waitcnt lgkmcnt(0)" ::: "memory");
#pragma unroll
    for (int j = 0; j < 8; ++j) rows8[j] = *(LAS const u32x4*)(wl + (8 * j + (lane >> 3)) * EPV_RS + (lane & 7) * 16);
    asm volatile("s_waitcnt lgkmcnt(0)" ::: "memory");
}
constexpr int EPF_RS = 528, EPF_WAVE = 16 * EPF_RS;
DEVI void epi_transpose_f32(LAS unsigned char* wl, const f32x4 (&v)[8], f32x4 (&o)[8], const int lane) {
    const int fr = lane & 15, fq = lane >> 4;
#pragma unroll
    for (int nt = 0; nt < 8; ++nt) *(LAS f32x4*)(wl + fr * EPF_RS + (16 * nt + 4 * fq) * 4) = v[nt];
    asm volatile("s_waitcnt lgkmcnt(0)" ::: "memory");
#pragma unroll
    for (int j = 0; j < 8; ++j) o[j] = *(LAS const f32x4*)(wl + (2 * j + (lane >> 5)) * EPF_RS + (lane & 31) * 16);
    asm volatile("s_waitcnt lgkmcnt(0)" ::: "memory");
}

DEVI void transpose_item(const float* W, int N, int k0, int n0, bf16_t* dst_row0  , bf16_t* dst_lo_row0, int K, LAS float* scr, int lane) {
#pragma unroll 8
    for (int i = 0; i < 32; ++i) { const int kk = 2 * i + (lane >> 5); scr[kk * 33 + (lane & 31)] = W[(size_t)(k0 + kk) * N + n0 + (lane & 31)]; }
    asm volatile("s_waitcnt lgkmcnt(0)" ::: "memory");
    const int c = lane & 7;
#pragma unroll
    for (int j = 0; j < 4; ++j) {
        const int n = (lane >> 3) + 8 * j; const LAS float* s = scr + (8 * c) * 33 + n;
        float v[8];
#pragma unroll
        for (int q = 0; q < 8; ++q) v[q] = s[q * 33];
        unsigned ow[4];
#pragma unroll
        for (int q = 0; q < 4; ++q) ow[q] = pk2(v[2 * q], v[2 * q + 1]);
        u32x4 o; o.x = ow[0]; o.y = ow[1]; o.z = ow[2]; o.w = ow[3];
        *(u32x4*)(dst_row0 + (size_t)n * K + k0 + 8 * c) = o;
        if (dst_lo_row0) {
            unsigned lw[4];
#pragma unroll
            for (int q = 0; q < 4; ++q) lw[q] = pk2(v[2 * q] - bflo(ow[q]), v[2 * q + 1] - bfhi(ow[q]));
            u32x4 ol; ol.x = lw[0]; ol.y = lw[1]; ol.z = lw[2]; ol.w = lw[3];
            *(u32x4*)(dst_lo_row0 + (size_t)n * K + k0 + 8 * c) = ol;
        }
    }
    asm volatile("s_waitcnt lgkmcnt(0)" ::: "memory");
}

DEVI void phase0(const Params& p, LAS unsigned char* lds, int tid, int vcu, int G, unsigned* ctl) {
    unsigned char* ws = p.ws;
    const int w = tid >> 6, lane = tid & 63;
    {
        LAS float* sc = (LAS float*)lds;
        LAS float* red = (LAS float*)(lds + 32768);
        float* mod = (float*)(ws + WS_MOD);
        for (int item = vcu; item < 192; item += G) {
            for (int i = tid; i < BATCH * DM; i += NTHREADS) sc[i] = siluf(p.c[i]);
            __syncthreads();
            const int cc = tid & 31, g = tid >> 5, col = item * 32 + cc;
            float a[8];
#pragma unroll
            for (int b = 0; b < 8; ++b) a[b] = 0.f;
            const float* wp = p.w_ada + (size_t)(g * 64) * 6144 + col;
#pragma unroll 1
            for (int k0 = 0; k0 < 64; k0 += 16) {
                float wv[16];
#pragma unroll
                for (int i = 0; i < 16; ++i) wv[i] = wp[(size_t)(k0 + i) * 6144];
#pragma unroll
                for (int i = 0; i < 16; ++i)
#pragma unroll
                    for (int b = 0; b < 8; ++b) a[b] += sc[b * DM + g * 64 + k0 + i] * wv[i];
            }
#pragma unroll
            for (int b = 0; b < 8; ++b) red[(g * 8 + b) * 32 + cc] = a[b];
            __syncthreads();
            if (tid < 256) {
                const int b = tid >> 5, c2 = tid & 31;
                float s = 0.f;
#pragma unroll
                for (int gg = 0; gg < 16; ++gg) s += red[(gg * 8 + b) * 32 + c2];
                __hip_atomic_store((__attribute__((address_space(1))) float*)(mod + b * 6144 + item * 32 + c2), s + p.b_ada[item * 32 + c2], __ATOMIC_RELAXED, __HIP_MEMORY_SCOPE_AGENT);
            }
            asm volatile("s_waitcnt vmcnt(0)" ::: "memory");
            __syncthreads();
            if (tid == 0) (void)xb_add(&ctl[CW_MOD], 1u);
        }
    }
    {
        float* kmz = (float*)(ws + WS_KMEAN);
        for (int i = vcu * NTHREADS + tid; i < 8 * 8 * 8 * 64; i += G * NTHREADS) kmz[i] = 0.f;
        float* cosT = (float*)(ws + WS_ROPE); float* sinT = cosT + SEQ * 64;
        for (int i = vcu * NTHREADS + tid; i < SEQ * 64; i += G * NTHREADS) {
            const int pos = i >> 6, j = i & 63;
            const float inv = powf(10000.0f, -(float)j / 64.0f);
            const float ang = (float)pos * inv;
            cosT[i] = cosf(ang); sinT[i] = sinf(ang);
        }
    }
    {
        LAS float* scr = (LAS float*)(lds + w * 8448);
        const int gw = vcu * NWAVES + w, NGW = G * NWAVES;
        constexpr int I_IN = 16 * (INC / 32), I_OUT = 16 * 32, I_R = 16 * 8;
        constexpr int I_TOTAL = I_IN + I_OUT + I_R;
        bf16_t* win = (bf16_t*)(ws + WS_WIN); bf16_t* wout = (bf16_t*)(ws + WS_WOUT); bf16_t* wr = (bf16_t*)(ws + WS_WR);
        for (int it = gw; it < I_TOTAL; it += NGW) {
            int r = it;
            if (r < I_IN) { const int nb = INC / 32, kb = r / nb, n0 = (r % nb) * 32; transpose_item(p.w_in, INC, kb * 64, n0, win + (size_t)n0 * DM, nullptr, DM, scr, lane); continue; } r -= I_IN;
            if (r < I_OUT) { const int kb = r / 32, n0 = (r % 32) * 32; transpose_item(p.w_out, DM, kb * 64, n0, wout + (size_t)n0 * DM, nullptr, DM, scr, lane); continue; } r -= I_OUT;
            { const int kb = r / 8, n0 = (r % 8) * 32; transpose_item(p.w_router, NEXP, kb * 64, n0, wr + (size_t)n0 * DM, wr + (size_t)(NEXP + n0) * DM, DM, scr, lane); }
        }
    }
}

template <bool LO>
DEVI void rownorm_phase(const float* X, const float* g, const float* mod, int sh_off, int sc_off, bf16_t* Hhi, bf16_t* Hlo, int tid, int vcu, int G) {
    const int w = tid >> 6, lane = tid & 63;
    const int gw = vcu * NWAVES + w, NGW = G * NWAVES;
    for (int row = gw; row < NTOK; row += NGW) {
        const int b = row >> 11;
        const f32x4* xr = (const f32x4*)(X + (size_t)row * DM) + lane;
        f32x4 v[4]; float s = 0.f;
#pragma unroll
        for (int j = 0; j < 4; ++j) { v[j] = xr[64 * j]; s += (v[j].x * v[j].x + v[j].y * v[j].y) + (v[j].z * v[j].z + v[j].w * v[j].w); }
        const float rstd = rsqrtf(wave_sum(s) * (1.0f / DM) + EPS);
#pragma unroll
        for (int j = 0; j < 4; ++j) {
            const int col = 4 * lane + 256 * j;
            const f32x4 gg = *(const f32x4*)(g + col);
            const f32x4 sc = *(const f32x4*)(mod + b * 6144 + sc_off + col);
            const f32x4 sh = *(const f32x4*)(mod + b * 6144 + sh_off + col);
            f32x4 h = v[j] * rstd * gg * (sc + 1.0f) + sh;
            u32x2 o; o.x = pk2(h.x, h.y); o.y = pk2(h.z, h.w);
            *(u32x2*)(Hhi + (size_t)row * DM + col) = o;
            if (LO) {
                u32x2 ol; ol.x = pk2(h.x - bflo(o.x), h.y - bfhi(o.x)); ol.y = pk2(h.z - bflo(o.y), h.w - bfhi(o.y));
                *(u32x2*)(Hlo + (size_t)row * DM + col) = ol;
            }
        }
    }
}

DEVI void phase2(const Params& p, LAS unsigned char* lds, int tid, int vcu, int G) {
    unsigned char* ws = p.ws;
    const bf16_t* H = (const bf16_t*)(ws + WS_H1); const bf16_t* WT = (const bf16_t*)(ws + WS_WIN);
    const float* cosT = (const float*)(ws + WS_ROPE); const float* sinT = cosT + SEQ * 64;
    for (int it = vcu; it < 768 + 256; it += G) {
        asm volatile("" : "+v"(tid));
        const int w = tid >> 6, lane = tid & 63, fr = lane & 15, fq = lane >> 4;
        const bool halfm = it >= 768;
        const int id = halfm ? 768 + ((it - 768) >> 1) : it, rh = halfm ? ((it - 768) & 1) : 0, nra = halfm ? 2 : 4;
        const int pm = id / 14, pn = id % 14;
        int aoff[4], boff[4];
#pragma unroll
        for (int i = 0; i < 4; ++i) { aoff[i] = (pm * 256 + 128 * rh + (i & (nra - 1)) * 64 + (tid >> 3)) * DM; boff[i] = (pn * 256 + i * 64 + (tid >> 3)) * DM; }
        f32x4 acc[4][8];
        const int cat = pn >> 1, half = pn & 1;
        const int wm = w >> 1, wn = w & 1;
        const bool wact = wm < nra;
        if (cat == 2 || cat == 6) gemm_tile<1, false>(acc, lds, H, H, H, WT, WT, WT, aoff, boff, DM, tid, nra);
        else gemm_tile<1, true>(acc, lds, H, H, H, WT, WT, WT, aoff, boff, DM, tid, nra);
        const int b = pm >> 3, s0 = (pm & 7) * 256 + 128 * rh + 64 * wm;
        const bool isk = (cat == 5);
        LAS float* red = (LAS float*)(lds + 98304);
        __syncthreads();
        if (!wact) {
        } else if (cat == 2 || cat == 6) {
            bf16_t* dst = (bf16_t*)(ws + (cat == 2 ? WS_RVT : WS_MVT));
            LAS unsigned char* wl = lds + w * EPV_WAVE;
#pragma unroll
            for (int hf = 0; hf < 2; ++hf) {
                u32x2 pk[4][4];
#pragma unroll
                for (int mt = 0; mt < 4; ++mt)
#pragma unroll
                    for (int n4 = 0; n4 < 4; ++n4) { const f32x4 v = acc[mt][4 * hf + n4]; pk[mt][n4].x = pk2(v.x, v.y); pk[mt][n4].y = pk2(v.z, v.w); }
                u32x4 rows8[8];
                epi_transpose_vt(wl, pk, rows8, lane);
                const size_t rowbase = (size_t)b * 512 + 256 * half + 128 * wn + 64 * hf + (lane >> 3);
#pragma unroll
                for (int j = 0; j < 8; ++j) *(u32x4*)(dst + (rowbase + 8 * j) * SEQ + s0 + 8 * (lane & 7)) = rows8[j];
            }
        } else {
            LAS unsigned char* wl = lds + w * EPI_WAVE;
            const float* gain = isk ? p.k_gain : p.q_gain;
#pragma unroll
            for (int hf = 0; hf < 2; ++hf) {
                u32x2 pk[2][8];
                if (cat <= 1) {
                    const float lgh = log2f(1.0f - exp2f(-5.0f - (float)(2 * half + wn)));
                    const float sclb = (cat == 1) ? 0.08838834764831845f : 1.0f, lgs = (cat == 1) ? -lgh : lgh;
#pragma unroll
                    for (int m2 = 0; m2 < 2; ++m2) {
                        const int s = s0 + 32 * hf + 16 * m2 + fr;
                        const float scl = sclb * exp2f(lgs * (float)(s - 1024));
#pragma unroll
                        for (int np = 0; np < 4; ++np) {
                            const f32x4 cs = *(const f32x4*)(cosT + s * 64 + 16 * np + 4 * fq) * scl;
                            const f32x4 sn = *(const f32x4*)(sinT + s * 64 + 16 * np + 4 * fq) * scl;
                            const f32x4 x1 = acc[2 * hf + m2][np], x2 = acc[2 * hf + m2][np + 4];
                            const f32x4 o1 = x1 * cs - x2 * sn, o2 = x1 * sn + x2 * cs;
                            pk[m2][np].x = pk2(o1.x, o1.y); pk[m2][np].y = pk2(o1.z, o1.w);
                            pk[m2][np + 4].x = pk2(o2.x, o2.y); pk[m2][np + 4].y = pk2(o2.z, o2.w);
                        }
                    }
                } else if (cat == 3) {
#pragma unroll
                    for (int m2 = 0; m2 < 2; ++m2)
#pragma unroll
                        for (int nt = 0; nt < 8; ++nt) { const f32x4 v = acc[2 * hf + m2][nt]; pk[m2][nt].x = pk2(siluf(v.x), siluf(v.y)); pk[m2][nt].y = pk2(siluf(v.z), siluf(v.w)); }
                } else {
#pragma unroll
                    for (int hh = 0; hh < 2; ++hh) {
                        float rstd[2];
#pragma unroll
                        for (int m2 = 0; m2 < 2; ++m2) {
                            float ss = 0.f;
#pragma unroll
                            for (int np = 0; np < 4; ++np) { const f32x4 v = acc[2 * hf + m2][4 * hh + np]; ss += (v.x * v.x + v.y * v.y) + (v.z * v.z + v.w * v.w); }
                            ss += __shfl_xor(ss, 16); ss += __shfl_xor(ss, 32);
                            rstd[m2] = rsqrtf(ss * (1.0f / 64.0f) + EPS);
                        }
#pragma unroll
                        for (int np = 0; np < 4; ++np) {
                            const f32x4 gn = *(const f32x4*)(gain + 16 * np + 4 * fq) * (isk ? 1.0f : 0.125f * 1.4426950408889634f);
                            f32x4 cs = (f32x4){0.f, 0.f, 0.f, 0.f};
#pragma unroll
                            for (int m2 = 0; m2 < 2; ++m2) {
                                const f32x4 v = acc[2 * hf + m2][4 * hh + np] * rstd[m2] * gn;
                                cs += v;
                                pk[m2][4 * hh + np].x = pk2(v.x, v.y); pk[m2][4 * hh + np].y = pk2(v.z, v.w);
                            }
                            if (isk) {
#pragma unroll
                                for (int r = 0; r < 4; ++r) {
                                    float v = cs[r];
                                    v += __shfl_xor(v, 1); v += __shfl_xor(v, 2); v += __shfl_xor(v, 4); v += __shfl_xor(v, 8);
                                    if (fr == 0) { LAS float* rp = red + wm * 256 + 128 * wn + 64 * hh + 16 * np + 4 * fq + r; if (hf == 0) *rp = v; else *rp += v; }
                                }
                            }
                        }
                    }
                }
                u32x4 rows8[8];
                epi_transpose(wl, pk, rows8, lane);
#pragma unroll
                for (int j = 0; j < 8; ++j) {
                    const int s = s0 + 32 * hf + 4 * j + fq;
                    bf16_t* d;
                    if (cat <= 1) d = (bf16_t*)(ws + (cat == 0 ? WS_RQ : WS_RK)) + ((size_t)((b * 4 + 2 * half + wn) * SEQ + s)) * 128 + 8 * fr;
                    else if (cat == 3) d = (bf16_t*)(ws + WS_RG) + ((size_t)b * SEQ + s) * 512 + 256 * half + 128 * wn + 8 * fr;
                    else d = (bf16_t*)(ws + (isk ? WS_MK : WS_MQ)) + ((size_t)((b * 8 + 4 * half + 2 * wn + (fr >> 3)) * SEQ + s)) * 64 + 8 * (fr & 7);
                    *(u32x4*)d = rows8[j];
                }
            }
        }
        if (isk) {
            __syncthreads();
            if (tid < 256) {
                float* km = (float*)(ws + WS_KMEAN) + ((size_t)((b * 8 + 4 * half + (tid >> 6)) * 8 + (pm & 7))) * 64 + (tid & 63);
                if (halfm) atomicAdd(km, (red[tid] + red[256 + tid]) * (1.0f / 256.0f));
                else *km = ((red[tid] + red[256 + tid]) + (red[512 + tid] + red[768 + tid])) * (1.0f / 256.0f);
            }
        }
        __syncthreads();
    }
}

DEVI void retkv_compute(unsigned char* ws, LAS const unsigned char* lds, int bh, int c, int tid) {
    constexpr int TILE = 64 * 256;
    const int w = tid >> 6, lane = tid & 63, fr = lane & 15, fq = lane >> 4;
    f32x4 acc[8];
#pragma unroll
    for (int dvt = 0; dvt < 8; ++dvt) acc[dvt] = (f32x4){0.f, 0.f, 0.f, 0.f};
#pragma unroll 1
    for (int t = 0; t < 4; ++t) {
        LAS const unsigned char* Kb = lds + t * (2 * TILE);
        LAS const unsigned char* Vb = Kb + TILE;
#pragma unroll
        for (int sh = 0; sh < 2; ++sh) {
            u32x4 kw;
#pragma unroll
            for (int j2 = 0; j2 < 4; ++j2) {
                const int k0 = 32 * sh + 16 * (j2 >> 1) + 4 * fq + 2 * (j2 & 1), k1 = k0 + 1;
                const unsigned lo = *(LAS const unsigned short*)(Kb + k0 * 256 + (((2 * w + (fr >> 3)) ^ (k0 & 15)) * 16) + (fr & 7) * 2);
                const unsigned hi = *(LAS const unsigned short*)(Kb + k1 * 256 + (((2 * w + (fr >> 3)) ^ (k1 & 15)) * 16) + (fr & 7) * 2);
                kw[j2] = lo | (hi << 16);
            }
            const bf16x8 kf = __builtin_bit_cast(bf16x8, kw);
#pragma unroll
            for (int dvt = 0; dvt < 8; ++dvt) {
                const bf16x8 vf = lds128(Vb + (16 * dvt + fr) * 128 + (((4 * sh + fq) ^ ((fr >> 1) & 7)) * 16));
                acc[dvt] = __builtin_amdgcn_mfma_f32_16x16x32_bf16(kf, vf, acc[dvt], 0, 0, 0);
            }
        }
    }
    __attribute__((address_space(1))) unsigned long long* dst = (__attribute__((address_space(1))) unsigned long long*)(ws + WS_KVT) + ((size_t)(bh * 8 + c) * 128 * 128) / 4;
#pragma unroll
    for (int dvt = 0; dvt < 8; ++dvt) {
        const unsigned long long v = (unsigned long long)pk2(acc[dvt].x, acc[dvt].y) | ((unsigned long long)pk2(acc[dvt].z, acc[dvt].w) << 32);
        __hip_atomic_store(dst + ((16 * dvt + fr) * 128 + 16 * w + 4 * fq) / 4, v, __ATOMIC_RELAXED, __HIP_MEMORY_SCOPE_AGENT);
    }
}

template <int D, bool MOBA>
DEVI int attn_unit(const Params& p, LAS unsigned char* lds, int b, int h, int qb, int tid, unsigned* qctr) {
    unsigned char* ws = p.ws;
    int nxt = -1;
    constexpr int H = MOBA ? 8 : 4, KK = D / 32, DT = D / 16, RB = D * 2, TILE = 64 * RB, MASK = (D == 64) ? 7 : 15, ROUNDS = TILE / 8192;
    const int w = tid >> 6, lane = tid & 63, fr = lane & 15, fq = lane >> 4;
    const bf16_t* Q = (const bf16_t*)(ws + (MOBA ? WS_MQ : WS_RQ));
    const bf16_t* Kp = (const bf16_t*)(ws + (MOBA ? WS_MK : WS_RK));
    const bf16_t* VT = (const bf16_t*)(ws + (MOBA ? WS_MVT : WS_RVT));
    const size_t qk_base = (size_t)(b * H + h) * SEQ * D, vt_base = (size_t)(b * H + h) * D * SEQ;
    const int q0 = qb * 256 + 32 * w;
    LAS unsigned char* misc = lds + LDS_MISC;
    unsigned selm[2] = {0u, 0u};
    if (MOBA) {
        LAS float* km = (LAS float*)(misc + MISC_KM);
        LAS unsigned char* sel = misc + MISC_SEL;
        const float* kmg = (const float*)(ws + WS_KMEAN) + (size_t)((b * 8 + h) * 8) * 64;
        if (tid < 448 && (tid >> 6) < qb) km[tid] = kmg[tid];
        __syncthreads();
        if (tid < 256) {
            unsigned m = 0u;
            if (qb <= 3) m = (1u << qb) - 1u;
            else {
                float t0 = -INFINITY, t1 = -INFINITY, t2 = -INFINITY; int i0 = 0, i1 = 0, i2 = 0;
                const u32x4* qr = (const u32x4*)(Q + qk_base + (size_t)(qb * 256 + tid) * 64);
                u32x4 qv[8];
#pragma unroll
                for (int c = 0; c < 8; ++c) qv[c] = qr[c];
#pragma unroll 1
                for (int kb = 0; kb < qb; ++kb) {
                    const LAS f32x4* kr = (const LAS f32x4*)(km + kb * 64);
                    float g = 0.f;
#pragma unroll
                    for (int c = 0; c < 8; ++c) {
                        const f32x4 k0 = kr[2 * c], k1 = kr[2 * c + 1];
                        g += bflo(qv[c].x) * k0.x + bfhi(qv[c].x) * k0.y + bflo(qv[c].y) * k0.z + bfhi(qv[c].y) * k0.w
                           + bflo(qv[c].z) * k1.x + bfhi(qv[c].z) * k1.y + bflo(qv[c].w) * k1.z + bfhi(qv[c].w) * k1.w;
                    }
                    if (g > t0) { t2 = t1; i2 = i1; t1 = t0; i1 = i0; t0 = g; i0 = kb; }
                    else if (g > t1) { t2 = t1; i2 = i1; t1 = g; i1 = kb; }
                    else if (g > t2) { t2 = g; i2 = kb; }
                }
                m = (1u << i0) | (1u << i1) | (1u << i2);
            }
            sel[tid] = (unsigned char)m;
        }
        __syncthreads();
        selm[0] = sel[32 * w + fr]; selm[1] = sel[32 * w + 16 + fr];
    }
    bf16x8 qf[2][KK];
#pragma unroll
    for (int qt = 0; qt < 2; ++qt)
#pragma unroll
        for (int kk = 0; kk < KK; ++kk) qf[qt][kk] = *(const bf16x8*)(Q + qk_base + (size_t)(q0 + 16 * qt + fr) * D + kk * 32 + fq * 8);
    f32x4 o[DT][2];
#pragma unroll
    for (int dt = 0; dt < DT; ++dt) { o[dt][0] = (f32x4){0.f, 0.f, 0.f, 0.f}; o[dt][1] = (f32x4){0.f, 0.f, 0.f, 0.f}; }
    float mrun[2] = {-INFINITY, -INFINITY}, lrun[2] = {0.f, 0.f};
    float mfix = 0.f; bool usefix = false;
    if (MOBA) {
        float gq = fabsf(p.q_gain[lane]), gk = fabsf(p.k_gain[lane]);
#pragma unroll
        for (int o = 1; o < 64; o <<= 1) { gq = fmaxf(gq, __shfl_xor(gq, o)); gk = fmaxf(gk, __shfl_xor(gk, o)); }
        const float smax = 8.0f * gq * gk * 1.02f;
        mfix = smax * 1.4426950408889634f;
        usefix = __builtin_amdgcn_readfirstlane((int)(smax < 40.0f)) != 0;
    }
    const int ntiles = MOBA ? 4 * (qb + 1) : (qb + 4);
    const bf16_t* KVT = (const bf16_t*)(ws + WS_KVT) + (size_t)((b * H + h) * 8) * (128 * 128);
    auto tile_ks = [&](int i) -> int {
        if (MOBA) { const int kb = (i < 4) ? qb : ((i - 4) >> 2); return kb * 256 + (i & 3) * 64; }
        return (4 * qb + i) * 64;
    };
    auto stage = [&](int buf, int i) {
        LAS unsigned char* base = lds + buf * (2 * TILE);
        if (!MOBA && i >= 4) {
#pragma unroll
            for (int r = 0; r < 4; ++r) {
                const int row = r * 32 + (tid >> 4), lchunk = (tid & 15) ^ (row & 15);
                glds16(KVT + (size_t)(i - 4) * (128 * 128) + row * 128 + lchunk * 8, base + r * 8192 + tid * 16);
            }
            return;
        }
        const int ks = tile_ks(i);
#pragma unroll
        for (int r = 0; r < ROUNDS; ++r) {
            int row, lchunk;
            if (D == 64) { row = tid >> 3; lchunk = (tid & 7) ^ (row & 7); }
            else { row = r * 32 + (tid >> 4); lchunk = (tid & 15) ^ (row & 15); }
            glds16(Kp + qk_base + (size_t)(ks + row) * D + lchunk * 8, base + r * 8192 + tid * 16);
            const int d = r * 64 + (tid >> 3), lc2 = (tid & 7) ^ ((d >> 1) & 7);
            glds16(VT + vt_base + (size_t)d * SEQ + ks + lc2 * 8, base + TILE + r * 8192 + tid * 16);
        }
    };
    const int npairs = (ntiles + 1) >> 1;
    stage(0, 0); stage(1, 1);
    if (!MOBA) {
        stage(2, 2); stage(3, 3);
        VM_WAIT();
        __syncthreads();
        if (qb < 7) retkv_compute(ws, lds, b * H + h, qb, tid);
    } else {
        stage(2, 2); stage(3, 3);
        if (npairs > 2) { stage(4, 4); stage(5, 5); }
    }
    for (int jp = 0; jp < npairs; ++jp) {
        if (MOBA) {
            const int rem = npairs - 1 - jp;
            if (rem >= 2) asm volatile("s_waitcnt vmcnt(8)" ::: "memory"); else if (rem == 1) asm volatile("s_waitcnt vmcnt(4)" ::: "memory"); else VM_WAIT();
            asm volatile("s_waitcnt lgkmcnt(0)" ::: "memory");
            __builtin_amdgcn_s_barrier();
            asm volatile("" ::: "memory");
            if (jp + 3 < npairs) { stage(((jp + 3) & 3) * 2, 2 * jp + 6); stage(((jp + 3) & 3) * 2 + 1, 2 * jp + 7); }
        } else if (jp > 0) { VM_WAIT(); __syncthreads(); }
        if (!MOBA && jp == 1) {
            if (tid == 0) {
                unsigned* fl = (unsigned*)(ws + WS_CTL) + CW_KV + (b * H + h) * 8;
                if (qb < 7) (void)xb_add(&fl[qb], 1u);
                if (qb > 0) {
                    for (int j = 0; j < qb; ++j) { unsigned sp = 0; while (xb_ld(&fl[j]) == 0u && ++sp < (1u << 22)) __builtin_amdgcn_s_sleep(1); }
                    __builtin_amdgcn_fence(__ATOMIC_ACQUIRE, "agent");
                    asm volatile("s_waitcnt vmcnt(0)" ::: "memory");
                }
            }
            if (qb > 0) __syncthreads();
        }
        if (!MOBA && jp + 1 < npairs && jp > 0) { stage(((jp + 1) & 1) * 2, 2 * jp + 2); if (2 * jp + 3 < ntiles) stage(((jp + 1) & 1) * 2 + 1, 2 * jp + 3); }
        if (jp == npairs - 1 && tid == 0) nxt = (int)atomicAdd(qctr, 1u);
#pragma unroll 1
      for (int hp = 0; hp < 2; ++hp) {
        const int i = 2 * jp + hp;
        if (i >= ntiles) continue;
        if (!MOBA && i >= 4) {
            LAS const unsigned char* Sb = lds + ((jp & 1) * 2 + hp) * (2 * TILE);
            auto sld = [&](int idx) -> bf16x8 { const int kk = idx >> 3, dt = idx & 7; return lds128(Sb + (16 * dt + fr) * 256 + (((kk * 4 + fq) ^ fr) * 16)); };
            bf16x8 c0 = sld(0), c1 = sld(1), c2 = sld(2), c3 = sld(3);
#pragma unroll
            for (int g = 0; g < 32; g += 4) {
                bf16x8 n0 = c0, n1 = c1, n2 = c2, n3 = c3;
                if (g + 4 < 32) { n0 = sld(g + 4); n1 = sld(g + 5); n2 = sld(g + 6); n3 = sld(g + 7); }
                const int kk = g >> 3, d0 = g & 7;
                o[d0 + 0][0] = __builtin_amdgcn_mfma_f32_16x16x32_bf16(c0, qf[0][kk], o[d0 + 0][0], 0, 0, 0);
                o[d0 + 0][1] = __builtin_amdgcn_mfma_f32_16x16x32_bf16(c0, qf[1][kk], o[d0 + 0][1], 0, 0, 0);
                o[d0 + 1][0] = __builtin_amdgcn_mfma_f32_16x16x32_bf16(c1, qf[0][kk], o[d0 + 1][0], 0, 0, 0);
                o[d0 + 1][1] = __builtin_amdgcn_mfma_f32_16x16x32_bf16(c1, qf[1][kk], o[d0 + 1][1], 0, 0, 0);
                o[d0 + 2][0] = __builtin_amdgcn_mfma_f32_16x16x32_bf16(c2, qf[0][kk], o[d0 + 2][0], 0, 0, 0);
                o[d0 + 2][1] = __builtin_amdgcn_mfma_f32_16x16x32_bf16(c2, qf[1][kk], o[d0 + 2][1], 0, 0, 0);
                o[d0 + 3][0] = __builtin_amdgcn_mfma_f32_16x16x32_bf16(c3, qf[0][kk], o[d0 + 3][0], 0, 0, 0);
                o[d0 + 3][1] = __builtin_amdgcn_mfma_f32_16x16x32_bf16(c3, qf[1][kk], o[d0 + 3][1], 0, 0, 0);
                c0 = n0; c1 = n1; c2 = n2; c3 = n3;
            }
            {
                __builtin_amdgcn_sched_group_barrier(0x100, 4, 0);
#pragma unroll
                for (int g = 0; g < 32; g += 4) { if (g + 4 < 32) __builtin_amdgcn_sched_group_barrier(0x100, 4, 0); __builtin_amdgcn_sched_group_barrier(0x008, 8, 0); }
            }
            continue;
        }
        const int ks = tile_ks(i);
        const int kb = ks >> 8;
        const bool own = (kb == qb);
        if (ks > q0 + 31) continue;
        LAS const unsigned char* Kb = lds + ((jp & (MOBA ? 3 : 1)) * 2 + hp) * (2 * TILE);
        LAS const unsigned char* Vb = Kb + TILE;
        float bi0 = 0.f, bi1 = 0.f;
        if (MOBA) {
            const float bsel = usefix ? -mfix : 0.f;
            bi0 = (own || ((selm[0] >> kb) & 1u)) ? bsel : -1.0e30f;
            bi1 = (own || ((selm[1] >> kb) & 1u)) ? bsel : -1.0e30f;
        }
        f32x4 s[2][4];
#pragma unroll
        for (int kt = 0; kt < 4; ++kt) {
            s[0][kt] = (f32x4){bi0, bi0, bi0, bi0}; s[1][kt] = (f32x4){bi1, bi1, bi1, bi1};
#pragma unroll
            for (int kk = 0; kk < KK; ++kk) {
                const bf16x8 kf = lds128(Kb + (16 * kt + fr) * RB + (((kk * 4 + fq) ^ (fr & MASK)) * 16));
                s[0][kt] = __builtin_amdgcn_mfma_f32_16x16x32_bf16(kf, qf[0][kk], s[0][kt], 0, 0, 0);
                s[1][kt] = __builtin_amdgcn_mfma_f32_16x16x32_bf16(kf, qf[1][kk], s[1][kt], 0, 0, 0);
            }
        }
        {
            constexpr int NF = 4 * KK;
            __builtin_amdgcn_sched_group_barrier(0x100, 4, 0);
#pragma unroll
            for (int i = 0; i < NF; ++i) { __builtin_amdgcn_sched_group_barrier(0x008, 2, 0); if (i + 4 < NF) __builtin_amdgcn_sched_group_barrier(0x100, 1, 0); }
        }
        bf16x8 vfa[2][MOBA ? DT : 1];
        if (MOBA) {
#pragma unroll
            for (int sh = 0; sh < 2; ++sh)
#pragma unroll
                for (int dt = 0; dt < DT; ++dt) vfa[sh][dt] = lds128(Vb + (16 * dt + fr) * 128 + (((4 * sh + fq) ^ ((fr >> 1) & 7)) * 16));
        }
        unsigned pw[2][2][4];
        if (MOBA) {
            const bool diag = own && (ks + 63 > q0);
            if (usefix) {
#pragma unroll
                for (int qt = 0; qt < 2; ++qt) {
                    const int qpos = q0 + 16 * qt + fr;
                    f32x2 ls2 = (f32x2){0.f, 0.f};
                    if (diag) {
#pragma unroll
                        for (int kt = 0; kt < 4; ++kt) {
                            float pv[4];
#pragma unroll
                            for (int r = 0; r < 4; ++r) pv[r] = __builtin_amdgcn_exp2f((ks + 16 * kt + 4 * fq + r <= qpos) ? s[qt][kt][r] : -INFINITY);
                            ls2 += (f32x2){pv[0], pv[1]}; ls2 += (f32x2){pv[2], pv[3]};
                            pw[qt][kt >> 1][(kt & 1) * 2 + 0] = pk2t(pv[0], pv[1]);
                            pw[qt][kt >> 1][(kt & 1) * 2 + 1] = pk2t(pv[2], pv[3]);
                        }
                    } else {
#pragma unroll
                        for (int kt = 0; kt < 4; ++kt) {
                            float pv[4];
#pragma unroll
                            for (int r = 0; r < 4; ++r) pv[r] = __builtin_amdgcn_exp2f(s[qt][kt][r]);
                            ls2 += (f32x2){pv[0], pv[1]}; ls2 += (f32x2){pv[2], pv[3]};
                            pw[qt][kt >> 1][(kt & 1) * 2 + 0] = pk2t(pv[0], pv[1]);
                            pw[qt][kt >> 1][(kt & 1) * 2 + 1] = pk2t(pv[2], pv[3]);
                        }
                    }
                    lrun[qt] += ls2.x + ls2.y;
                }
            } else
#pragma unroll
            for (int qt = 0; qt < 2; ++qt) {
                const int qpos = q0 + 16 * qt + fr;
                float sv[4][4]; float mx = -INFINITY;
                if (diag) {
#pragma unroll
                    for (int kt = 0; kt < 4; ++kt)
#pragma unroll
                        for (int r = 0; r < 4; ++r) {
                            const int kpos = ks + 16 * kt + 4 * fq + r;
                            sv[kt][r] = (kpos <= qpos) ? s[qt][kt][r] : -INFINITY;
                            mx = fmaxf(mx, sv[kt][r]);
                        }
                } else {
#pragma unroll
                    for (int kt = 0; kt < 4; ++kt)
#pragma unroll
                        for (int r = 0; r < 4; ++r) { sv[kt][r] = s[qt][kt][r]; mx = fmaxf(mx, sv[kt][r]); }
                }
                mx = fmaxf(mx, __shfl_xor(mx, 16)); mx = fmaxf(mx, __shfl_xor(mx, 32));
                const float mnew = fmaxf(mrun[qt], mx);
                const float msub = (mnew == -INFINITY) ? 0.f : mnew;
                if (__builtin_amdgcn_ballot_w64(mnew != mrun[qt]) != 0ull) {
                    const float alpha = (mnew == -INFINITY) ? 1.0f : __builtin_amdgcn_exp2f(mrun[qt] - mnew);
                    lrun[qt] *= alpha;
#pragma unroll
                    for (int dt = 0; dt < DT; ++dt) o[dt][qt] *= alpha;
                }
                mrun[qt] = mnew;
                float ls = 0.f;
#pragma unroll
                for (int kt = 0; kt < 4; ++kt) {
                    float pv[4];
#pragma unroll
                    for (int r = 0; r < 4; ++r) { pv[r] = __builtin_amdgcn_exp2f(sv[kt][r] - msub); ls += pv[r]; }
                    pw[qt][kt >> 1][(kt & 1) * 2 + 0] = pk2t(pv[0], pv[1]);
                    pw[qt][kt >> 1][(kt & 1) * 2 + 1] = pk2t(pv[2], pv[3]);
                }
                lrun[qt] += ls;
            }
        } else {
#pragma unroll
            for (int qt = 0; qt < 2; ++qt) {
                const int qpos = q0 + 16 * qt + fr;
#pragma unroll
                for (int kt = 0; kt < 4; ++kt) {
                    float pv[4];
#pragma unroll
                    for (int r = 0; r < 4; ++r) {
                        const int kpos = ks + 16 * kt + 4 * fq + r;
                        pv[r] = (kpos <= qpos) ? s[qt][kt][r] : 0.f;
                    }
                    pw[qt][kt >> 1][(kt & 1) * 2 + 0] = pk2(pv[0], pv[1]);
                    pw[qt][kt >> 1][(kt & 1) * 2 + 1] = pk2(pv[2], pv[3]);
                }
            }
        }
#pragma unroll
        for (int sh = 0; sh < 2; ++sh) {
            bf16x8 pb[2];
#pragma unroll
            for (int qt = 0; qt < 2; ++qt) { u32x4 t; t.x = pw[qt][sh][0]; t.y = pw[qt][sh][1]; t.z = pw[qt][sh][2]; t.w = pw[qt][sh][3]; pb[qt] = __builtin_bit_cast(bf16x8, t); }
#pragma unroll
            for (int dt = 0; dt < DT; ++dt) {
                bf16x8 vf;
                if (MOBA) vf = vfa[sh][dt];
                else vf = lds128(Vb + (16 * dt + fr) * 128 + (((4 * sh + fq) ^ ((fr >> 1) & 7)) * 16));
                o[dt][0] = __builtin_amdgcn_mfma_f32_16x16x32_bf16(vf, pb[0], o[dt][0], 0, 0, 0);
                o[dt][1] = __builtin_amdgcn_mfma_f32_16x16x32_bf16(vf, pb[1], o[dt][1], 0, 0, 0);
            }
        }
        if (!MOBA) {
            constexpr int NV = 2 * DT;
            __builtin_amdgcn_sched_group_barrier(0x100, 4, 0);
#pragma unroll
            for (int i = 0; i < NV; ++i) { __builtin_amdgcn_sched_group_barrier(0x008, 2, 0); if (i + 4 < NV) __builtin_amdgcn_sched_group_barrier(0x100, 1, 0); }
        }
      }
    }
    bf16_t* mix = (bf16_t*)(ws + WS_MIX);
#pragma unroll
    for (int qt = 0; qt < 2; ++qt) {
        const size_t tok = (size_t)b * SEQ + q0 + 16 * qt + fr;
        if (MOBA) {
            float l = lrun[qt]; l += __shfl_xor(l, 16); l += __shfl_xor(l, 32);
            const float inv = 1.0f / l;
#pragma unroll
            for (int dt = 0; dt < DT; ++dt) {
                const f32x4 v = o[dt][qt] * inv;
                u32x2 ov; ov.x = pk2(v.x, v.y); ov.y = pk2(v.z, v.w);
                *(u32x2*)(mix + tok * DM + 512 + h * 64 + 16 * dt + 4 * fq) = ov;
            }
        } else {
            float ss = 0.f;
#pragma unroll
            for (int dt = 0; dt < DT; ++dt) { const f32x4 v = o[dt][qt]; ss += (v.x * v.x + v.y * v.y) + (v.z * v.z + v.w * v.w); }
            ss += __shfl_xor(ss, 16); ss += __shfl_xor(ss, 32);
            const float rstd = rsqrtf(ss * (1.0f / 128.0f) + EPS);
            const bf16_t* rg = (const bf16_t*)(ws + WS_RG);
#pragma unroll
            for (int dt = 0; dt < DT; ++dt) {
                const u32x2 gv = *(const u32x2*)(rg + tok * 512 + h * 128 + 16 * dt + 4 * fq);
                const f32x4 v = o[dt][qt] * rstd;
                u32x2 ov; ov.x = pk2(v.x * bflo(gv.x), v.y * bfhi(gv.x)); ov.y = pk2(v.z * bflo(gv.y), v.w * bfhi(gv.y));
                *(u32x2*)(mix + tok * DM + h * 128 + 16 * dt + 4 * fq) = ov;
            }
        }
    }
    return nxt;
}

DEVI void phase3(const Params& p, LAS unsigned char* lds, int tid, unsigned* ctl) {
    LAS int* scal = (LAS int*)(lds + LDS_MISC + MISC_SCAL);
    int nxt = -1;
    for (;;) {
        asm volatile("" : "+v"(tid));
        __syncthreads();
        if (tid == 0) scal[0] = (nxt >= 0) ? nxt : (int)atomicAdd(&ctl[CW_QATT], 1u);
        __syncthreads();
        const int u = scal[0];
        if (u >= 768) break;
        if (u < 256) {
            const int qb = u >> 5, bh = u & 31;
            nxt = attn_unit<128, false>(p, lds, bh >> 2, bh & 3, qb, tid, &ctl[CW_QATT]);
        } else {
            const int v = u - 256, qb = 7 - (v >> 6), bh = v & 63;
            nxt = attn_unit<64, true>(p, lds, bh >> 3, bh & 7, qb, tid, &ctl[CW_QATT]);
        }
    }
}

template <bool FUSE>
DEVI void phase4(const Params& p, LAS unsigned char* lds, int tid, int vcu, int G, unsigned* ctl) {
    unsigned char* ws = p.ws;
    const bf16_t* A = (const bf16_t*)(ws + WS_MIX); const bf16_t* WT = (const bf16_t*)(ws + WS_WOUT);
    const float* mod = (const float*)(ws + WS_MOD);
    float* x1 = (float*)(ws + WS_X1);
    for (int id = vcu; id < 256; id += G) {
        asm volatile("" : "+v"(tid));
        const int w = tid >> 6, lane = tid & 63, fr = lane & 15, fq = lane >> 4;
        const int pm = id >> 2, pn = id & 3;
        int aoff[4], boff[4];
#pragma unroll
        for (int i = 0; i < 4; ++i) { aoff[i] = (pm * 256 + i * 64 + (tid >> 3)) * DM; boff[i] = (pn * 256 + i * 64 + (tid >> 3)) * DM; }
        f32x4 acc[4][8];
        gemm_tile<1>(acc, lds, A, A, A, WT, WT, WT, aoff, boff, DM, tid);
        const int b = pm >> 3, wm = w >> 1, wn = w & 1;
        f32x4 xn[8];
        {
            const int colp = pn * 256 + 128 * wn + 4 * (lane & 31);
#pragma unroll
            for (int j = 0; j < 8; ++j) xn[j] = *(const f32x4*)(p.x + ((size_t)pm * 256 + 64 * wm + 2 * j + (lane >> 5)) * DM + colp);
        }
        __syncthreads();
        LAS unsigned char* wl = lds + w * EPF_WAVE;
        LAS float* rowss = (LAS float*)(lds + 98304);
#pragma unroll
        for (int mt = 0; mt < 4; ++mt) {
            f32x4 o[8];
            epi_transpose_f32(wl, acc[mt], o, lane);
            const int col = pn * 256 + 128 * wn + 4 * (lane & 31);
            const f32x4 gt = *(const f32x4*)(mod + b * 6144 + 2048 + col);
#pragma unroll
            for (int j = 0; j < 8; ++j) {
                const int row = 64 * wm + 16 * mt + 2 * j + (lane >> 5);
                const size_t tok = (size_t)pm * 256 + row;
                const f32x4 xv = xn[j];
                if (mt < 3) xn[j] = *(const f32x4*)(p.x + (tok + 16) * DM + col);
                const f32x4 v = xv + gt * o[j];
                *(f32x4*)(x1 + tok * DM + col) = v;
                if (FUSE) {
                    float ss = (v.x * v.x + v.y * v.y) + (v.z * v.z + v.w * v.w);
                    ss += __shfl_xor(ss, 1); ss += __shfl_xor(ss, 2); ss += __shfl_xor(ss, 4); ss += __shfl_xor(ss, 8); ss += __shfl_xor(ss, 16);
                    if ((lane & 31) == 0) rowss[wn * 256 + row] = ss;
                }
            }
        }
        if (FUSE) {
            __attribute__((address_space(1))) float* stats = (__attribute__((address_space(1))) float*)(ws + WS_STATS) + (size_t)pm * 1024;
            __syncthreads();
            if (tid < 256) __hip_atomic_store(stats + pn * 256 + tid, rowss[tid] + rowss[256 + tid], __ATOMIC_RELAXED, __HIP_MEMORY_SCOPE_AGENT);
            asm volatile("s_waitcnt vmcnt(0)" ::: "memory");
            __syncthreads();
            if (tid == 0) {
                unsigned* cw = ctl + CW_P4 + 64 * pm;
                (void)xb_add(cw, 1u);
                unsigned sp = 0;
                while (xb_ld(cw) < 4u && ++sp < (1u << 20)) __builtin_amdgcn_s_sleep(1);
                __builtin_amdgcn_fence(__ATOMIC_ACQUIRE, "agent");
                asm volatile("s_waitcnt vmcnt(0)" ::: "memory");
            }
            __syncthreads();
            if (tid < 256) {
                float s = 0.f;
#pragma unroll
                for (int q = 0; q < 4; ++q) s += __hip_atomic_load(stats + q * 256 + tid, __ATOMIC_RELAXED, __HIP_MEMORY_SCOPE_AGENT);
                rowss[512 + tid] = rsqrtf(s * (1.0f / DM) + EPS);
            }
            __syncthreads();
            bf16_t* Hhi = (bf16_t*)(ws + WS_H1); bf16_t* Hlo = (bf16_t*)(ws + WS_H2LO);
            const int col = pn * 256 + 128 * wn + 4 * (lane & 31);
            const f32x4 gg = *(const f32x4*)(p.g_ffn + col);
            const f32x4 sc = *(const f32x4*)(mod + b * 6144 + 4096 + col) + 1.0f;
            const f32x4 sh = *(const f32x4*)(mod + b * 6144 + 3072 + col);
            {
                auto ld4 = [&](f32x4 (&d)[4], int bt) {
#pragma unroll
                    for (int j = 0; j < 4; ++j) d[j] = *(const f32x4*)(x1 + ((size_t)pm * 256 + 64 * wm + 2 * (4 * bt + j) + (lane >> 5)) * DM + col);
                };
                auto st4 = [&](const f32x4 (&d)[4], int bt) {
#pragma unroll
                    for (int j = 0; j < 4; ++j) {
                        const int row = 64 * wm + 2 * (4 * bt + j) + (lane >> 5);
                        const size_t tok = (size_t)pm * 256 + row;
                        const f32x4 h = d[j] * rowss[512 + row] * gg * sc + sh;
                        u32x2 o; o.x = pk2(h.x, h.y); o.y = pk2(h.z, h.w);
                        *(u32x2*)(Hhi + tok * DM + col) = o;
                        u32x2 ol; ol.x = pk2(h.x - bflo(o.x), h.y - bfhi(o.x)); ol.y = pk2(h.z - bflo(o.y), h.w - bfhi(o.y));
                        *(u32x2*)(Hlo + tok * DM + col) = ol;
                    }
                };
                f32x4 va[4], vb[4];
                ld4(va, 0);
#pragma unroll 1
                for (int b2 = 0; b2 < 4; ++b2) {
                    ld4(vb, 2 * b2 + 1);
                    st4(va, 2 * b2);
                    if (b2 < 3) ld4(va, 2 * b2 + 2);
                    st4(vb, 2 * b2 + 1);
                }
            }
            asm volatile("s_waitcnt vmcnt(0)" ::: "memory");
            __syncthreads();
            {
                const bf16_t* Wh = (const bf16_t*)(ws + WS_WR); const bf16_t* Wl = Wh + (size_t)NEXP * DM;
#pragma unroll
                for (int i = 0; i < 4; ++i) { aoff[i] = (pm * 256 + i * 64 + (tid >> 3)) * DM + 256 * pn; boff[i] = (i * 64 + (tid >> 3)) * DM + 256 * pn; }
                gemm_tile<3>(acc, lds, Hlo, Hhi, Hhi, Wh, Wl, Wh, aoff, boff, 256, tid);
                float* dst = (float*)(ws + WS_RQ) + (size_t)pn * NTOK * NEXP;
                __syncthreads();
#pragma unroll
                for (int mt = 0; mt < 4; ++mt) {
                    f32x4 o[8];
                    epi_transpose_f32(wl, acc[mt], o, lane);
#pragma unroll
                    for (int j = 0; j < 8; ++j) {
                        const size_t tok = (size_t)pm * 256 + 64 * wm + 16 * mt + 2 * j + (lane >> 5);
                        *(f32x4*)(dst + tok * NEXP + 128 * wn + 4 * (lane & 31)) = o[j];
                    }
                }
            }
        }
        __syncthreads();
    }
}

constexpr int RR = 8;
DEVI float wave_max(float v) {
#pragma unroll
    for (int o = 1; o < 64; o <<= 1) v = fmaxf(v, __shfl_xor(v, o));
    return v;
}
DEVI void route_rows(const Params& p, unsigned char* ws, unsigned* ctl, int tok0, int lane) {
    const float* part = (const float*)(ws + WS_RQ);
    const f32x4 b4 = *(const f32x4*)(p.router_bias + 4 * lane);
    float sc[RR][4], ch[RR][4];
#pragma unroll
    for (int q = 0; q < RR; ++q) {
        const size_t off = (size_t)(tok0 + q) * NEXP + 4 * lane;
        f32x4 l4 = *(const f32x4*)(part + off);
#pragma unroll
        for (int j = 1; j < 4; ++j) l4 += *(const f32x4*)(part + (size_t)j * NTOK * NEXP + off);
        float bi[4];
#pragma unroll
        for (int j = 0; j < 4; ++j) { sc[q][j] = 1.0f / (1.0f + __expf(-l4[j])); bi[j] = sc[q][j] + b4[j]; }
        float t1 = fmaxf(bi[0], bi[1]), t2 = fminf(bi[0], bi[1]);
        { const float a1 = fmaxf(bi[2], bi[3]), a2 = fminf(bi[2], bi[3]); const float n1 = fmaxf(t1, a1), n2 = fmaxf(fminf(t1, a1), fmaxf(t2, a2)); t1 = n1; t2 = n2; }
#pragma unroll
        for (int o = 1; o < 8; o <<= 1) {
            const float a1 = __shfl_xor(t1, o), a2 = __shfl_xor(t2, o);
            const float n1 = fmaxf(t1, a1), n2 = fmaxf(fminf(t1, a1), fmaxf(t2, a2)); t1 = n1; t2 = n2;
        }
        const float gs = t1 + t2; const int g = lane >> 3;
        int rank = 0;
#pragma unroll
        for (int j = 0; j < 8; ++j) { const float o = __uint_as_float(__builtin_amdgcn_readlane(__float_as_uint(gs), 8 * j)); rank += (o > gs || (o == gs && j < g)) ? 1 : 0; }
        const bool gsel = rank < 4;
#pragma unroll
        for (int j = 0; j < 4; ++j) ch[q][j] = gsel ? bi[j] : -INFINITY;
    }
    int me[RR]; float mw[RR], wsum[RR];
#pragma unroll
    for (int q = 0; q < RR; ++q) { me[q] = 0; mw[q] = 0.f; wsum[q] = 0.f; }
#pragma unroll
    for (int k = 0; k < 8; ++k) {
        float M[RR];
#pragma unroll
        for (int q = 0; q < RR; ++q) M[q] = fmaxf(fmaxf(ch[q][0], ch[q][1]), fmaxf(ch[q][2], ch[q][3]));
#pragma unroll
        for (int o = 1; o < 64; o <<= 1) {
#pragma unroll
            for (int q = 0; q < RR; ++q) M[q] = fmaxf(M[q], __shfl_xor(M[q], o));
        }
#pragma unroll
        for (int q = 0; q < RR; ++q) {
            const bool h0 = ch[q][0] == M[q], h1 = ch[q][1] == M[q], h2 = ch[q][2] == M[q], h3 = ch[q][3] == M[q];
            const unsigned long long bal = __builtin_amdgcn_ballot_w64(h0 || h1 || h2 || h3);
            const int wl = __builtin_amdgcn_readfirstlane((int)__builtin_ctzll(bal));
            const int sub = h0 ? 0 : (h1 ? 1 : (h2 ? 2 : 3));
            const float myscore = h0 ? sc[q][0] : (h1 ? sc[q][1] : (h2 ? sc[q][2] : sc[q][3]));
            const int wsub = __builtin_amdgcn_readlane(sub, wl);
            const float wsel = __uint_as_float(__builtin_amdgcn_readlane(__float_as_uint(myscore), wl));
            if (lane == wl) {
                if (sub == 0) ch[q][0] = -INFINITY; else if (sub == 1) ch[q][1] = -INFINITY; else if (sub == 2) ch[q][2] = -INFINITY; else ch[q][3] = -INFINITY;
            }
            wsum[q] += wsel;
            if (lane == k) { me[q] = 4 * wl + wsub; mw[q] = wsel; }
        }
    }
    if (lane < 8) {
        unsigned rk[RR];
#pragma unroll
        for (int q = 0; q < RR; ++q) rk[q] = __hip_atomic_fetch_add(&ctl[CW_CNT + 64 * me[q]], 1u, __ATOMIC_RELAXED, __HIP_MEMORY_SCOPE_AGENT);
#pragma unroll
        for (int q = 0; q < RR; ++q) {
            const int aid = (tok0 + q) * 8 + lane;
            ((float*)(ws + WS_TOPW))[aid] = mw[q] * (2.5f / wsum[q]);
            ((int*)(ws + WS_LIST))[(size_t)me[q] * LIST_CAP + rk[q]] = aid;
        }
    }
}

DEVI void phase6(const Params& p, LAS unsigned char* lds, int tid, int vcu, int G) {
    unsigned char* ws = p.ws;
    const bf16_t* Hh = (const bf16_t*)(ws + WS_H1); const bf16_t* Hl = (const bf16_t*)(ws + WS_H2LO);
    const bf16_t* Wh = (const bf16_t*)(ws + WS_WR); const bf16_t* Wl = Wh + (size_t)NEXP * DM;
    float* part = (float*)(ws + WS_RQ);
    for (int id = vcu; id < 4 * (NTOK / 256); id += G) {
        asm volatile("" : "+v"(tid));
        const int w = tid >> 6, lane = tid & 63, fr = lane & 15, fq = lane >> 4;
        const int pm = id >> 2, kq = id & 3;
        int aoff[4], boff[4];
#pragma unroll
        for (int i = 0; i < 4; ++i) { aoff[i] = (pm * 256 + i * 64 + (tid >> 3)) * DM + 256 * kq; boff[i] = (i * 64 + (tid >> 3)) * DM + 256 * kq; }
        f32x4 acc[4][8];
        gemm_tile<3>(acc, lds, Hl, Hh, Hh, Wh, Wl, Wh, aoff, boff, 256, tid);
        float* dst = part + (size_t)kq * NTOK * NEXP;
        const int wm = w >> 1, wn = w & 1;
#pragma unroll
        for (int mt = 0; mt < 4; ++mt) {
            const size_t tok = (size_t)pm * 256 + 64 * wm + 16 * mt + fr;
#pragma unroll
            for (int nt = 0; nt < 8; ++nt) *(f32x4*)(dst + tok * NEXP + 128 * wn + 16 * nt + 4 * fq) = acc[mt][nt];
        }
        __syncthreads();
    }
}

DEVI void phase_route(const Params& p, int tid, int vcu, int G, unsigned* ctl) {
    const int w = tid >> 6, lane = tid & 63;
    const int gw = vcu * NWAVES + w, NGW = G * NWAVES;
    for (int t0 = gw * RR; t0 < NTOK; t0 += NGW * RR) route_rows(p, p.ws, ctl, t0, lane);
}

DEVI void phase7(const Params& p, LAS unsigned char* lds, int tid, int vcu, int G, unsigned* ctl) {
    unsigned char* ws = p.ws;
    LAS int* pre = (LAS int*)(lds + LDS_MISC + MISC_PRE);
    LAS int* cnts = (LAS int*)lds;
    LAS int* scan = (LAS int*)(lds + 1024);
    if (tid < NEXP) { const int c = (int)xb_ld(&ctl[CW_CNT + 64 * tid]); cnts[tid] = c; scan[tid] = (c + 255) >> 8; }
    __syncthreads();
#pragma unroll 1
    for (int o = 1; o < NEXP; o <<= 1) {
        int v = 0;
        if (tid < NEXP && tid >= o) v = scan[tid - o];
        __syncthreads();
        if (tid < NEXP) scan[tid] += v;
        __syncthreads();
    }
    if (tid < NEXP) pre[tid + 1] = scan[tid];
    if (tid == 0) pre[0] = 0;
    __syncthreads();
    if (tid == 0) pre[NEXP + 1] = pre[NEXP] + NTOK / 256;
    __syncthreads();
    const int U = pre[NEXP + 1];
    LAS int* cntm = (LAS int*)(lds + LDS_MISC + MISC_KM);
    if (tid < NEXP) cntm[tid] = cnts[tid];
    __syncthreads();
    const bf16_t* Hh = (const bf16_t*)(ws + WS_H1);
    bf16_t* Hs = (bf16_t*)(ws + WS_MIX) + (size_t)blockIdx.x * 256 * 256;
    bf16_t* Y = (bf16_t*)(ws + WS_Y);
    const int* list = (const int*)(ws + WS_LIST); const float* topw = (const float*)(ws + WS_TOPW);
    auto unit_expert = [&](int uu) -> int { int lo = 0, hi = NEXP + 1; while (hi - lo > 1) { const int mid = (lo + hi) >> 1; if (pre[mid] <= uu) lo = mid; else hi = mid; } return lo; };
    auto stage1_base = [&](int ee, int ww) -> const float* {
        const float* Wg = (ee < NEXP) ? p.w_gate + (size_t)ee * DM * EFF : p.ws_gate;
        const float* Wu = (ee < NEXP) ? p.w_up + (size_t)ee * DM * EFF : p.ws_up;
        const int R = 32 * ww, within = R & 127;
        return ((within < 64) ? Wg : Wu) + 64 * (R >> 7) + (within & 63);
    };
    f32x4 breg[8];
    if (vcu < U) wf32_load_b(breg, stage1_base(unit_expert(vcu), tid >> 6), EFF, 0, tid);
    for (int u = vcu; u < U; u += G) {
        asm volatile("" : "+v"(tid));
        const int w = tid >> 6, lane = tid & 63, fr = lane & 15, fq = lane >> 4;
        const int e = unit_expert(u), mtile = u - pre[e];
        const int cnt = (e < NEXP) ? cntm[e] : NTOK;
        const int rbase = mtile * 256;
        unsigned apk[4];
#pragma unroll
        for (int i = 0; i < 4; ++i) {
            int r0 = rbase + i * 64 + ((tid >> 3) & 31), r1 = r0 + 32;
            r0 = r0 < cnt ? r0 : cnt - 1; r1 = r1 < cnt ? r1 : cnt - 1;
            const int t0 = (e < NEXP) ? (list[(size_t)e * LIST_CAP + r0] >> 3) : r0;
            const int t1 = (e < NEXP) ? (list[(size_t)e * LIST_CAP + r1] >> 3) : r1;
            apk[i] = (unsigned)t0 | ((unsigned)t1 << 16);
        }
        {
            LAS int* taid = (LAS int*)(lds + LDS_ROWTAB); LAS float* tw = (LAS float*)(lds + LDS_ROWTAB + 1024);
            if (tid < 256) {
                const int r = rbase + tid; int a = -1;
                if (e < NEXP) {
                    if (r < cnt) a = list[(size_t)e * LIST_CAP + r];
                    __builtin_amdgcn_global_load_lds((const __attribute__((address_space(1))) unsigned*)(topw + (a >= 0 ? a : 0)), (LAS unsigned*)(tw + (tid & ~63)), 4, 0, 0);
                } else {
                    if (r < cnt) a = NASSIGN + r;
                    tw[tid] = 1.0f;
                }
                taid[tid] = a;
            }
        }
        f32x4 acc[4][8];
        const float* Wdn = (e < NEXP) ? p.w_down + (size_t)e * EFF * DM : p.ws_down;
        const float* b1 = stage1_base(e, w);
        const float* b2 = Wdn + 32 * w;
        const float* bnext = (u + G < U) ? stage1_base(unit_expert(u + G), w) : b1;
#pragma unroll 1
        for (int nh = 0; nh < 2; ++nh) {
            const float* bcol = b1 + nh * 128;
            const float* nb = (nh == 0) ? b1 + 128 : b2;
            gemm_tile_wf32(acc, breg, lds, Hh, bcol, EFF, nb, (nh == 0) ? EFF : DM, apk, 10, DM, tid, nh == 1, nh == 0);
            const int w = tid >> 6, lane = tid & 63, fr = lane & 15, fq = lane >> 4, wm = w >> 1, wn = w & 1;
#pragma unroll
            for (int mt = 0; mt < 4; ++mt)
#pragma unroll
                for (int nt = 0; nt < 4; ++nt) {
                    const f32x4 g = acc[mt][nt], uu = acc[mt][nt + 4];
                    u32x2 o; o.x = pk2(siluf(g.x) * uu.x, siluf(g.y) * uu.y); o.y = pk2(siluf(g.z) * uu.z, siluf(g.w) * uu.w);
                    *(u32x2*)(Hs + (size_t)(64 * wm + 16 * mt + fr) * 256 + nh * 128 + 64 * wn + 16 * nt + 4 * fq) = o;
                    if (nt == 3) __builtin_amdgcn_sched_barrier(0);
                }
            if (nh == 1) __syncthreads();
        }
#pragma unroll 1
        for (int nq = 0; nq < 4; ++nq) {
#pragma unroll
            for (int i = 0; i < 4; ++i) { const unsigned r0 = (unsigned)(i * 64 + ((tid >> 3) & 31)); apk[i] = r0 | ((r0 + 32u) << 16); }
            gemm_tile_wf32(acc, breg, lds, Hs, b2 + nq * 256, DM, (nq < 3) ? b2 + (nq + 1) * 256 : bnext, (nq < 3) ? DM : EFF, apk, 8, EFF, tid, nq > 0, nq < 3);
            const int w = tid >> 6, lane = tid & 63, fr = lane & 15, fq = lane >> 4, wm = w >> 1, wn = w & 1;
            if (nq < 3) { asm volatile("s_waitcnt lgkmcnt(0)" ::: "memory"); __builtin_amdgcn_s_barrier(); asm volatile("" ::: "memory"); }
            else __syncthreads();
            LAS unsigned char* wl = (w < 7) ? lds + 65536 + w * EPI_WAVE : lds + LDS_EPI7;
#pragma unroll
            for (int hf = 0; hf < 2; ++hf) {
                u32x2 pk[2][8];
#pragma unroll
                for (int m2 = 0; m2 < 2; ++m2) {
                    const float wrow = ((LAS const float*)(lds + LDS_ROWTAB + 1024))[64 * wm + 32 * hf + 16 * m2 + fr];
#pragma unroll
                    for (int nt = 0; nt < 8; ++nt) { const f32x4 v = acc[2 * hf + m2][nt] * wrow; pk[m2][nt].x = pk2(v.x, v.y); pk[m2][nt].y = pk2(v.z, v.w); }
                }
                u32x4 rows8[8];
                epi_transpose(wl, pk, rows8, lane);
#pragma unroll
                for (int j = 0; j < 8; ++j) {
                    const int aid = ((LAS const int*)(lds + LDS_ROWTAB))[64 * wm + 32 * hf + 4 * j + fq];
                    bf16_t* yrow = (aid >= 0) ? Y + (size_t)aid * DM : (bf16_t*)(ws + WS_STATS);
                    *(u32x4*)(yrow + nq * 256 + 128 * wn + 8 * fr) = rows8[j];
                }
            }
            if (nq == 3) __syncthreads();
        }
    }
}

DEVI void phase8(const Params& p, int tid, int vcu, int G) {
    unsigned char* ws = p.ws;
    const int w = tid >> 6, lane = tid & 63;
    const int gw = vcu * NWAVES + w, NGW = G * NWAVES;
    const bf16_t* Y = (const bf16_t*)(ws + WS_Y); const float* mod = (const float*)(ws + WS_MOD);
    for (int tok = gw; tok < NTOK; tok += NGW) {
        const int b = tok >> 11;
#pragma unroll
        for (int j = 0; j < 2; ++j) {
            const int col = 512 * j + 8 * lane;
            float a[8];
#pragma unroll
            for (int q = 0; q < 8; ++q) a[q] = 0.f;
#pragma unroll
            for (int k = 0; k < 9; ++k) {
                const size_t row = (k < 8) ? ((size_t)tok * 8 + k) : ((size_t)NASSIGN + tok);
                const u32x4 v = *(const u32x4*)(Y + row * DM + col);
                a[0] += bflo(v.x); a[1] += bfhi(v.x); a[2] += bflo(v.y); a[3] += bfhi(v.y); a[4] += bflo(v.z); a[5] += bfhi(v.z); a[6] += bflo(v.w); a[7] += bfhi(v.w);
            }
            float* o = p.out + (size_t)tok * DM + col;
            const float* xi = (const float*)(ws + WS_X1) + (size_t)tok * DM + col;
            const float* gt = mod + b * 6144 + 5120 + col;
            const f32x4 x0 = *(const f32x4*)xi, x1 = *(const f32x4*)(xi + 4);
            const f32x4 g0 = *(const f32x4*)gt, g1 = *(const f32x4*)(gt + 4);
            *(f32x4*)o = x0 + g0 * (f32x4){a[0], a[1], a[2], a[3]};
            *(f32x4*)(o + 4) = x1 + g1 * (f32x4){a[4], a[5], a[6], a[7]};
        }
    }
}

__global__ void __launch_bounds__(NTHREADS) hymba_fwd(Params p_in) {
    extern __shared__ __attribute__((aligned(16))) unsigned char smem[];
    LAS unsigned char* lds = (LAS unsigned char*)smem;
    int tid = threadIdx.x;
    const int G = gridDim.x;
    const int bx = blockIdx.x;
    const int vcu = (G % 8 == 0) ? (bx % 8) * (G / 8) + bx / 8 : bx;
    unsigned* ctl = (unsigned*)(p_in.ws + WS_CTL);
    if (tid < 4) ((LAS unsigned*)(lds + LDS_MISC + MISC_BAR))[tid] = 0u;
    __syncthreads();
    XcdBarrier bar; bar.bar = ctl + CW_BAR; bar.x = 0; bar.st = nullptr;
    const bool multi = (p_in.ph_hi - p_in.ph_lo) > 1;
    if (multi) bar = xcd_barrier_post(ctl + CW_BAR, (volatile LAS unsigned*)(lds + LDS_MISC + MISC_BAR));
    const float* mod = nullptr;
    Params p = p_in;
#pragma unroll 1
    for (int pi = p_in.ph_lo; pi < p_in.ph_hi; ++pi) {
        if (pi > p_in.ph_lo) xcd_barrier(bar);
        int ph = p_in.prog[0];
#pragma unroll
        for (int q = 1; q < 14; ++q) ph = (pi == q) ? p_in.prog[q] : ph;
        {
            int t = threadIdx.x; asm volatile("" : "+v"(t)); tid = t;
            unsigned char* wsl = p_in.ws; asm volatile("" : "+s"(wsl)); p.ws = wsl;
            float* ol = p_in.out; asm volatile("" : "+s"(ol)); p.out = ol;
            mod = (const float*)(wsl + WS_MOD);
        }
        switch (ph) {
#if !defined(ONLY_PH) || ONLY_PH == 0
        case 0: phase0(p, lds, tid, vcu, G, ctl); break;
        case 13: {
            phase0(p, lds, tid, vcu, G, ctl);
            if (tid == 0) {
                unsigned sp = 0;
                while (xb_ld(&ctl[CW_MOD]) < 192u && ++sp < (1u << 22)) __builtin_amdgcn_s_sleep(1);
                __builtin_amdgcn_fence(__ATOMIC_ACQUIRE, "agent");
                asm volatile("s_waitcnt vmcnt(0)" ::: "memory");
            }
            __syncthreads();
            rownorm_phase<false>(p.x, p.g_mix, mod, 0, 1024, (bf16_t*)(p.ws + WS_H1), nullptr, tid, vcu, G);
        } break;
#endif
#if !defined(ONLY_PH) || ONLY_PH == 1
        case 1: rownorm_phase<false>(p.x, p.g_mix, mod, 0, 1024, (bf16_t*)(p.ws + WS_H1), nullptr, tid, vcu, G); break;
#endif
#if !defined(ONLY_PH) || ONLY_PH == 2
        case 2: phase2(p, lds, tid, vcu, G); break;
#endif
#if !defined(ONLY_PH) || ONLY_PH == 3
        case 3: phase3(p, lds, tid, ctl + pi); break;
#endif
#if !defined(ONLY_PH) || ONLY_PH == 4
        case 4: phase4<false>(p, lds, tid, vcu, G, ctl); break;
        case 11: phase4<true>(p, lds, tid, vcu, G, ctl); break;
#endif
#if !defined(ONLY_PH) || ONLY_PH == 5
        case 5: rownorm_phase<true>((const float*)(p.ws + WS_X1), p.g_ffn, mod, 3072, 4096, (bf16_t*)(p.ws + WS_H1), (bf16_t*)(p.ws + WS_H2LO), tid, vcu, G); break;
#endif
#if !defined(ONLY_PH) || ONLY_PH == 6
        case 6: phase6(p, lds, tid, vcu, G); break;
#endif
#if !defined(ONLY_PH) || ONLY_PH == 7
        case 7: phase_route(p, tid, vcu, G, ctl); break;
#endif
#if !defined(ONLY_PH) || ONLY_PH == 8
        case 8: phase7(p, lds, tid, vcu, G, ctl); break;
#endif
#if !defined(ONLY_PH) || ONLY_PH == 9
        case 9: phase8(p, tid, vcu, G); break;
#endif
        default: break;
        }
    }
}

extern "C" void kernel_launch(void* const* d_in, const int* in_sizes, int n_in, void* d_out, int out_size, void* d_ws, size_t ws_size, hipStream_t stream) {
    static int grid = 0;
    if (grid == 0) {
        if (n_in != 18 || out_size != NTOK * DM || ws_size < WS_END) {
            fprintf(stderr, "kernel_launch: unexpected shapes (n_in %d, out %d, ws %zu, need %zu)\n", n_in, out_size, ws_size, (size_t)WS_END); grid = -1; return;
        }
        int dev = 0, cus = 0, per_cu = 0;
        hipGetDevice(&dev);
        hipDeviceGetAttribute(&cus, hipDeviceAttributeMultiprocessorCount, dev);
        hipFuncSetAttribute((const void*)hymba_fwd, hipFuncAttributeMaxDynamicSharedMemorySize, LDS_BYTES);
        hipOccupancyMaxActiveBlocksPerMultiprocessor(&per_cu, (const void*)hymba_fwd, NTHREADS, LDS_BYTES);
        if (per_cu < 1) { fprintf(stderr, "kernel_launch: occupancy query says %d blocks/CU\n", per_cu); grid = -1; return; }
        grid = cus < 256 ? cus : 256;
        (void)hipGetLastError();
    }
    if (grid < 0) return;
    hipMemsetAsync((char*)d_ws + WS_CTL, 0, CTL_BYTES, stream);
    Params p{};
    p.x = (const float*)d_in[0]; p.c = (const float*)d_in[1]; p.w_ada = (const float*)d_in[2]; p.b_ada = (const float*)d_in[3];
    p.g_mix = (const float*)d_in[4]; p.w_in = (const float*)d_in[5]; p.q_gain = (const float*)d_in[6]; p.k_gain = (const float*)d_in[7];
    p.w_out = (const float*)d_in[8]; p.g_ffn = (const float*)d_in[9]; p.w_router = (const float*)d_in[10]; p.router_bias = (const float*)d_in[11];
    p.w_gate = (const float*)d_in[12]; p.w_up = (const float*)d_in[13]; p.w_down = (const float*)d_in[14];
    p.ws_gate = (const float*)d_in[15]; p.ws_up = (const float*)d_in[16]; p.ws_down = (const float*)d_in[17];
    p.out = (float*)d_out; p.ws = (unsigned char*)d_ws;
    int np = 0;
    for (int ph = 0; ph < NPHASE; ++ph) {
        if (ph == 0) { p.prog[np++] = 13; continue; }
        if (ph == 1) continue;
        if (grid == 256 && ph == 4) { p.prog[np++] = 11; continue; }
        if (grid == 256 && (ph == 5 || ph == 6)) continue;
        p.prog[np++] = ph;
#ifdef PROBE_DUP
        if (ph == PROBE_DUP) p.prog[np++] = ph;
#endif
    }
#if MK_N_LAUNCHES == 1
    p.ph_lo = 0; p.ph_hi = np;
    hipLaunchKernelGGL(hymba_fwd, dim3(grid), dim3(NTHREADS), LDS_BYTES, stream, p);
#else
    for (int pi = 0; pi < np; ++pi) {
        p.ph_lo = pi; p.ph_hi = pi + 1;
        hipLaunchKernelGGL(hymba_fwd, dim3(grid), dim3(NTHREADS), LDS_BYTES, stream, p);
    }
#endif
}
```
